# Optimizing an MI355X kernel written in HIP

```python
import math
import jax, jax.numpy as jnp
from jax import lax
import numpy as np

D_MODEL = 1024
BATCH = 8
SEQ = 4096
DEPTH = 4

HG_HEADS = 8
HG_DK = 128
HG_DV = 128
HG_WIDTH = HG_HEADS * HG_DK
HG_CHUNK = 64
LOG_FLOOR = 1e-30
FOX_HEADS = 16
FOX_DH = 64
FOX_WIDTH = FOX_HEADS * FOX_DH
FOX_QBLOCK = 128
FOX_F_BIAS_INIT = 2.0
MASK_VALUE = -1e30
N_EXPERTS = 32
TOP_K = 4
D_EXPERT = 1024
SWIGLU_LIMIT = 7.0
SWIGLU_ALPHA = 1.702
MOE_BLOCK = 256
LN_EPS = 1e-5
RMS_EPS = 1e-6
DEEPNORM_ALPHA = (2 * DEPTH) ** 0.25
DEEPNORM_BETA = (8 * DEPTH) ** -0.25
IN_SIZES = (HG_WIDTH, HG_WIDTH, HG_WIDTH, HG_WIDTH, FOX_WIDTH, FOX_WIDTH, FOX_WIDTH, FOX_HEADS, D_MODEL, D_MODEL)
P_IN = sum(IN_SIZES)

kernel_name = "hgrn2_fox_gated_moe_deepnorm_adaln"


def layer_norm(x, g, b):
    xf = x.astype(jnp.float32)
    mu = jnp.mean(xf, -1, keepdims=True)
    var = jnp.mean(jnp.square(xf - mu), -1, keepdims=True)
    return ((xf - mu) * lax.rsqrt(var + LN_EPS) * g + b).astype(x.dtype)


def in_projection(h, w):
    outs, off = [], 0
    for n in IN_SIZES:
        outs.append(jnp.einsum('bsd,de->bse', h, w[:, off:off + n]))
        off += n
    return outs


def hgrn2_mixer(q, f_raw, i, g_out, lb, norm_w):
    B, S, _ = q.shape
    f32 = jnp.float32
    n_chunks = S // HG_CHUNK
    lb = lb.astype(f32)
    fr = f_raw.astype(f32)
    sig = jax.nn.sigmoid(fr)
    f = lb + (1.0 - lb) * sig
    log_f = jnp.log(jnp.maximum(f, LOG_FLOOR))
    k = (1.0 - lb) * (1.0 - sig)

    def to_chunks(t, d):
        return t.reshape(B, n_chunks, HG_CHUNK, HG_HEADS, d).transpose(1, 0, 3, 2, 4)

    qc = to_chunks(jax.nn.silu(q.astype(f32)), HG_DK)
    kc = to_chunks(k, HG_DK)
    gc = to_chunks(log_f, HG_DK)
    ic = to_chunks(i.astype(f32), HG_DV)
    causal = jnp.tril(jnp.ones((HG_CHUNK, HG_CHUNK), bool))[:, :, None]

    def step(state, inp):
        qb, kb, gb, ib = inp
        b = jnp.cumsum(gb, axis=2)
        diff = b[:, :, :, None, :] - b[:, :, None, :, :]
        decay = jnp.where(causal, jnp.exp(jnp.where(causal, diff, 0.0)), 0.0)
        scores = jnp.einsum('bhtd,bhsd,bhtsd->bhts', qb, kb, decay)
        o = (jnp.einsum('bhts,bhsv->bhtv', scores, ib)
             + jnp.einsum('bhtd,bhdv->bhtv', qb * jnp.exp(b), state))
        b_last = b[:, :, -1:, :]
        new_state = (state * jnp.exp(b[:, :, -1])[..., None]
                     + jnp.einsum('bhsd,bhsv->bhdv', kb * jnp.exp(b_last - b), ib))
        return new_state, o

    state0 = jnp.zeros((B, HG_HEADS, HG_DK, HG_DV), f32)
    _, oc = lax.scan(step, state0, (qc, kc, gc, ic))
    o = oc.transpose(1, 0, 3, 2, 4).reshape(B, S, HG_HEADS, HG_DV)
    o = o * lax.rsqrt(jnp.mean(o * o, -1, keepdims=True) + RMS_EPS) * norm_w.astype(f32)
    o = o.reshape(B, S, HG_WIDTH) * jax.nn.silu(g_out.astype(f32))
    return o.astype(q.dtype)


def fox_mixer(q, k, v, f_logit):
    B, S, _ = q.shape
    f32 = jnp.float32
    heads = lambda t: t.reshape(B, S, FOX_HEADS, FOX_DH).transpose(0, 2, 1, 3)
    qh, kh, vh = heads(q), heads(k), heads(v)
    F = jnp.cumsum(jax.nn.log_sigmoid(f_logit.astype(f32)), axis=1).transpose(0, 2, 1)
    n_blocks = S // FOX_QBLOCK
    q_blocks = qh.reshape(B, FOX_HEADS, n_blocks, FOX_QBLOCK, FOX_DH).transpose(2, 0, 1, 3, 4)
    F_blocks = F.reshape(B, FOX_HEADS, n_blocks, FOX_QBLOCK).transpose(2, 0, 1, 3)
    starts = jnp.arange(n_blocks, dtype=jnp.int32) * FOX_QBLOCK
    key_pos = jnp.arange(S, dtype=jnp.int32)
    scale = FOX_DH ** -0.5

    def block(args):
        q_blk, F_blk, start = args
        logits = jnp.einsum('bhqd,bhkd->bhqk', q_blk, kh, preferred_element_type=f32) * scale
        logits = logits + (F_blk[..., :, None] - F[..., None, :])
        q_pos = start + jnp.arange(FOX_QBLOCK, dtype=jnp.int32)
        logits = jnp.where(key_pos[None, :] <= q_pos[:, None], logits, MASK_VALUE)
        p = jax.nn.softmax(logits, axis=-1)
        return jnp.einsum('bhqk,bhkd->bhqd', p.astype(vh.dtype), vh)

    o = lax.map(block, (q_blocks, F_blocks, starts))
    return o.transpose(1, 0, 3, 2, 4).reshape(B, S, FOX_WIDTH)


def moe_ffn(h, w_router, b_router, w_gate, b_gate, w_up, b_up, w_down, b_down):
    B, S, D = h.shape
    N = B * S
    f32 = jnp.float32
    xt = h.reshape(N, D)
    logits = (xt @ w_router + b_router).astype(f32)
    top_vals, top_idx = lax.top_k(logits, TOP_K)
    top_w = jax.nn.softmax(top_vals, axis=-1)
    n_assign = N * TOP_K
    e_flat = top_idx.reshape(-1).astype(jnp.int32)
    tok_flat = jnp.arange(n_assign, dtype=jnp.int32) // TOP_K
    w_flat = top_w.reshape(-1)
    order = jnp.argsort(e_flat)
    e_sorted = e_flat[order]
    counts = jnp.bincount(e_flat, length=N_EXPERTS)
    padded = ((counts + MOE_BLOCK - 1) // MOE_BLOCK) * MOE_BLOCK
    start = jnp.cumsum(counts) - counts
    pad_end = jnp.cumsum(padded)
    pad_start = pad_end - padded
    dest = pad_start[e_sorted] + (jnp.arange(n_assign, dtype=jnp.int32) - start[e_sorted])
    cap = ((n_assign + MOE_BLOCK - 1) // MOE_BLOCK) * MOE_BLOCK + N_EXPERTS * MOE_BLOCK
    n_blocks = cap // MOE_BLOCK
    row_tok = jnp.full((cap,), N, jnp.int32).at[dest].set(tok_flat[order])
    row_w = jnp.zeros((cap,), f32).at[dest].set(w_flat[order])
    block_start = jnp.arange(n_blocks, dtype=jnp.int32) * MOE_BLOCK
    block_expert = jnp.minimum(jnp.searchsorted(pad_end, block_start, side='right'), N_EXPERTS - 1)
    x_pad = jnp.concatenate([xt, jnp.zeros((1, D), xt.dtype)], axis=0)
    x_rows = x_pad[row_tok].reshape(n_blocks, MOE_BLOCK, D)

    def expert_block(args):
        xb, e = args
        g = jnp.minimum(xb @ w_gate[e] + b_gate[e], SWIGLU_LIMIT)
        u = jnp.clip(xb @ w_up[e] + b_up[e], -SWIGLU_LIMIT, SWIGLU_LIMIT)
        a = (u + 1.0) * (g * jax.nn.sigmoid(SWIGLU_ALPHA * g))
        return a @ w_down[e] + b_down[e]

    y_rows = lax.map(expert_block, (x_rows, block_expert)).reshape(cap, D)
    y = jax.ops.segment_sum(y_rows * row_w[:, None], row_tok, num_segments=N + 1)[:N]
    return y.reshape(B, S, D).astype(h.dtype)


def setup_inputs(seed: int = 0) -> dict:
    key = jax.random.key(seed)
    ks = jax.random.split(key, 22)
    f32 = jnp.float32
    nrm = lambda k, shape, s: jax.random.normal(k, shape, f32) * s
    beta = DEEPNORM_BETA
    col_scales = (1.0, 1.0, beta, 1.0, 1.0, 1.0, beta, 1.0, 1.0, 1.0)
    col_scale = jnp.concatenate([jnp.full((n,), s, f32) for n, s in zip(IN_SIZES, col_scales)])
    D = D_MODEL
    return {
        "x": nrm(ks[0], (BATCH, SEQ, D), 1.0),
        "c": nrm(ks[1], (BATCH, D), 1.0),
        "w_in": nrm(ks[2], (DEPTH, D, P_IN), D ** -0.5) * col_scale,
        "fox_f_bias": FOX_F_BIAS_INIT + nrm(ks[3], (DEPTH, FOX_HEADS), 0.1),
        "hg_lb_logits": nrm(ks[4], (DEPTH, HG_WIDTH), 0.1),
        "hg_norm_w": 1.0 + nrm(ks[5], (DEPTH, HG_DV), 0.02),
        "w_branch": nrm(ks[6], (DEPTH, HG_WIDTH + FOX_WIDTH, D), HG_WIDTH ** -0.5),
        "w_out": nrm(ks[7], (DEPTH, D, D), D ** -0.5 * beta),
        "ada_w": nrm(ks[8], (DEPTH, D, 6 * D), 0.1 * D ** -0.5),
        "ada_b": nrm(ks[9], (DEPTH, 6 * D), 0.01),
        "ln1_g": 1.0 + nrm(ks[10], (DEPTH, D), 0.02),
        "ln1_b": nrm(ks[11], (DEPTH, D), 0.02),
        "w_router": nrm(ks[12], (DEPTH, D, N_EXPERTS), D ** -0.5),
        "b_router": nrm(ks[13], (DEPTH, N_EXPERTS), 0.01),
        "w_gate": nrm(ks[14], (DEPTH, N_EXPERTS, D, D_EXPERT), D ** -0.5 * beta),
        "b_gate": nrm(ks[15], (DEPTH, N_EXPERTS, D_EXPERT), 0.02),
        "w_up": nrm(ks[16], (DEPTH, N_EXPERTS, D, D_EXPERT), D ** -0.5 * beta),
        "b_up": nrm(ks[17], (DEPTH, N_EXPERTS, D_EXPERT), 0.02),
        "w_down": nrm(ks[18], (DEPTH, N_EXPERTS, D_EXPERT, D), D_EXPERT ** -0.5 * beta),
        "b_down": nrm(ks[19], (DEPTH, N_EXPERTS, D), 0.02),
        "ln2_g": 1.0 + nrm(ks[20], (DEPTH, D), 0.02),
        "ln2_b": nrm(ks[21], (DEPTH, D), 0.02),
    }


def reference(x, c, w_in, fox_f_bias, hg_lb_logits, hg_norm_w, w_branch, w_out, ada_w, ada_b,
              ln1_g, ln1_b, w_router, b_router, w_gate, b_gate, w_up, b_up, w_down, b_down,
              ln2_g, ln2_b):
    p_lb = jax.nn.softmax(hg_lb_logits.astype(jnp.float32), axis=0)
    lb_all = jnp.clip(jnp.cumsum(p_lb, axis=0) - p_lb[0], 0.0, 1.0)
    c_act = jax.nn.silu(c)
    for l in range(DEPTH):
        mod = c_act @ ada_w[l] + ada_b[l]
        shift1, scale1, gate1, shift2, scale2, gate2 = [m[:, None, :] for m in jnp.split(mod, 6, axis=-1)]
        h = x * (1.0 + scale1) + shift1
        hq, hf, hi, hg, aq, ak, av, af, ga, gb = in_projection(h, w_in[l])
        o_a = hgrn2_mixer(hq, hf, hi, hg, lb_all[l], hg_norm_w[l])
        o_b = fox_mixer(aq, ak, av, af + fox_f_bias[l])
        p_a = jnp.einsum('bse,ed->bsd', o_a, w_branch[l, :HG_WIDTH])
        p_b = jnp.einsum('bse,ed->bsd', o_b, w_branch[l, HG_WIDTH:])
        merged = jax.nn.sigmoid(ga) * p_a + jax.nn.sigmoid(gb) * p_b
        y = jnp.einsum('bsd,de->bse', merged, w_out[l])
        x = layer_norm(DEEPNORM_ALPHA * x + (1.0 + gate1) * y, ln1_g[l], ln1_b[l])
        h2 = x * (1.0 + scale2) + shift2
        y2 = moe_ffn(h2, w_router[l], b_router[l], w_gate[l], b_gate[l], w_up[l], b_up[l], w_down[l], b_down[l])
        x = layer_norm(DEEPNORM_ALPHA * x + (1.0 + gate2) * y2, ln2_g[l], ln2_b[l])
    return x
```

```cpp
#include <hip/hip_runtime.h>
#include <hip/hip_bf16.h>
#include <cstdio>
#include <cstdint>
#include <cmath>

constexpr int NTOK = 32768, DM = 1024, NB = 8, SEQL = 4096, NLAYER = 4;
constexpr int NEXP = 32, TOPK = 4;
constexpr int PIN = 9232;
constexpr int NPROJ = 9216;
constexpr float DN_ALPHA = 1.6817928305074290f;
constexpr float LOG2E = 1.4426950408889634f;

namespace pg8 {
#define PG8_LAS __attribute__((address_space(3)))
typedef unsigned short bf16_t;
typedef short bf16x8 __attribute__((ext_vector_type(8)));
typedef float f32x4 __attribute__((ext_vector_type(4)));
typedef unsigned u32x4 __attribute__((ext_vector_type(4)));
constexpr int BM = 256, BK = 64, HALF = 128, HTB = HALF * BK * 2  , STAGE_BYTES = 8 * HTB, NXCD = 8, WGM = 8;

__host__ __device__ __forceinline__ int lds_byte(int r, int c) { const int st = (r >> 4) * 2 + (c >> 5), rr = r & 15, cc = c & 31, ob = rr * 64 + cc * 2; return st * 1024 + (ob ^ (((ob >> 9) & 1) << 5)); }
__host__ __device__ __forceinline__ void stage_rc(int b, int& R, int& C) { const int st = b / 1024, sb = b % 1024, swz = sb ^ (((sb >> 9) & 1) << 5); R = (st >> 1) * 16 + swz / 64; C = (st & 1) * 32 + (swz % 64) / 2; }
__host__ __device__ __forceinline__ int perm32(int rho) { const int n = rho >> 4, i = rho & 15; return 8 * (i >> 2) + 4 * n + (i & 3); }

struct Unit { int pm, pn; };
struct Gemm { const bf16_t* A; const bf16_t* Bt; int M, N, K; };

struct StaticOrder {
    int nM, nN, nwg, G, c;
    __host__ __device__ void init(int M, int N, int G_, int c_) { nM = M / BM; nN = N / BM; nwg = nM * nN; G = G_; c = c_; }
    __host__ __device__ bool map(long L, Unit& u) const {
        if (L >= nwg) return false;
        int wgid = (int)L; { const int q = nwg / NXCD, r = nwg % NXCD, xcd = wgid % NXCD, off = wgid / NXCD; wgid = (xcd < r ? xcd * (q + 1) : r * (q + 1) + (xcd - r) * q) + off; }
        const int nig = WGM * nN, gid = wgid / nig, fm = gid * WGM, gsz = (nM - fm) < WGM ? (nM - fm) : WGM;
        u.pm = fm + ((wgid % nig) % gsz); u.pn = (wgid % nig) / gsz; return true;
    }
    __host__ __device__ bool next(int i, Unit& u) const { return map((long)i * G + c, u); }
    __device__ __forceinline__ int arow(const Unit&, int) const { return 0; }
};
struct PairOrder {
    StaticOrder so;
    __device__ void init(int G_, int c_) { so.init(NTOK, DM, G_, c_); }
    __device__ bool next(int i, Unit& u) const { Unit t; if (!so.map((long)(i >> 1) * so.G + so.c, t)) return false; const int half = i & 1; u.pm = half * (NTOK / BM) + t.pm; u.pn = half * (DM / BM) + t.pn; return true; }
    __device__ __forceinline__ int arow(const Unit&, int) const { return 0; }
};
struct MoeOrder {
    int G, c, ntile, ncol;
    const PG8_LAS unsigned char* rt2e; const PG8_LAS int* tbase; const PG8_LAS int* cnt; const int* list;
    __device__ bool next(int i, Unit& u) const { const long L = (long)i * G + c; if (L >= (long)ntile * ncol) return false; const int rt = (int)(L / ncol), pl = (int)(L % ncol); u.pm = rt; u.pn = (int)rt2e[rt] * ncol + pl; return true; }
    __device__ __forceinline__ int arow(const Unit& u, int r) const { const int e = u.pn / ncol; const int pos = (u.pm - tbase[e]) * BM + r; return pos < cnt[e] ? list[e * NTOK + pos] : 0; }
};

__device__ __forceinline__ unsigned cvt_pk_bf16(float lo, float hi) { unsigned r; asm volatile("v_cvt_pk_bf16_f32 %0, %1, %2" : "=v"(r) : "v"(lo), "v"(hi)); return r; }
__device__ __forceinline__ float bf_lo(unsigned w) { return __uint_as_float(w << 16); }
__device__ __forceinline__ float bf_hi(unsigned w) { return __uint_as_float(w & 0xffff0000u); }
__device__ __forceinline__ float fast_sigmoid(float x) { return __builtin_amdgcn_rcpf(1.0f + __expf(-x)); }


struct EpiInProj {
    static constexpr bool PERM = true, AFTER_DRAIN = false;
    bf16_t* proj; float* lf; const float* lb; float qscale;
    __device__ __forceinline__ void operator()(const f32x4 (&acc)[2][2][4][2], const Unit& u, int wr, int wc, int fr, int fq) const {
        const int grp = u.pn >> 2, row0 = u.pm * BM + wr * 64 + fr, col0 = (u.pn & 3) * BM + wc * 32 + 8 * fq;
        bf16_t* base = proj + (size_t)grp * ((size_t)NTOK * DM);
        if (grp == 1) {
#pragma unroll
            for (int bj = 0; bj < 2; ++bj) {
                const f32x4 l0 = *(const f32x4*)(lb + col0 + bj * HALF), l1 = *(const f32x4*)(lb + col0 + bj * HALF + 4);
#pragma unroll
                for (int ai = 0; ai < 2; ++ai)
#pragma unroll
                    for (int m = 0; m < 4; ++m) {
                        const size_t off = (size_t)(row0 + ai * HALF + m * 16) * DM + col0 + bj * HALF;
                        float lg[8], kk[8];
#pragma unroll
                        for (int j = 0; j < 8; ++j) {
                            float x = j < 4 ? acc[ai][bj][m][0][j & 3] : acc[ai][bj][m][1][j & 3];
                            const float lbv = j < 4 ? l0[j & 3] : l1[j & 3];
                            x = fminf(fmaxf(x, -30.f), 30.f);
                            const float e = __expf(-x), inv = __builtin_amdgcn_rcpf(1.0f + e), sig = inv, oms = e * inv;
                            const float f = lbv + (1.0f - lbv) * sig;
                            lg[j] = __logf(fmaxf(f, 1e-30f)); kk[j] = (1.0f - lbv) * oms;
                        }
                        *(f32x4*)(lf + off) = (f32x4){lg[0], lg[1], lg[2], lg[3]}; *(f32x4*)(lf + off + 4) = (f32x4){lg[4], lg[5], lg[6], lg[7]};
                        u32x4 w; w.x = cvt_pk_bf16(kk[0], kk[1]); w.y = cvt_pk_bf16(kk[2], kk[3]); w.z = cvt_pk_bf16(kk[4], kk[5]); w.w = cvt_pk_bf16(kk[6], kk[7]);
                        *(u32x4*)(base + off) = w;
                    }
            }
            return;
        }
        const int mode = (grp == 0 || grp == 3) ? 1 : (grp >= 7 ? 2 : 0);
        const float sc = grp == 4 ? qscale : 1.0f;
#pragma unroll
        for (int ai = 0; ai < 2; ++ai)
#pragma unroll
            for (int m = 0; m < 4; ++m) { bf16_t* rowp = base + (size_t)(row0 + ai * HALF + m * 16) * DM + col0;
#pragma unroll
                for (int bj = 0; bj < 2; ++bj) { f32x4 v0 = acc[ai][bj][m][0], v1 = acc[ai][bj][m][1];
                    if (mode != 0) {
#pragma unroll
                        for (int j = 0; j < 4; ++j) { const float s0 = fast_sigmoid(v0[j]), s1 = fast_sigmoid(v1[j]); v0[j] = mode == 1 ? v0[j] * s0 : s0; v1[j] = mode == 1 ? v1[j] * s1 : s1; }
                    } else { v0 = v0 * sc; v1 = v1 * sc; }
                    u32x4 w; w.x = cvt_pk_bf16(v0[0], v0[1]); w.y = cvt_pk_bf16(v0[2], v0[3]); w.z = cvt_pk_bf16(v1[0], v1[1]); w.w = cvt_pk_bf16(v1[2], v1[3]);
                    *(u32x4*)(rowp + bj * HALF) = w; } }
    }
};
struct EpiBranch {
    static constexpr bool PERM = true, AFTER_DRAIN = false;
    const bf16_t* ga; const bf16_t* gb; bf16_t* mg;
    __device__ __forceinline__ void operator()(const f32x4 (&acc)[2][2][4][2], const Unit& u, int wr, int wc, int fr, int fq) const {
        const int half = u.pm >= (NTOK / BM) ? 1 : 0, pm = u.pm - half * (NTOK / BM), pn = u.pn - half * (DM / BM);
        const int row0 = pm * BM + wr * 64 + fr, col0 = pn * BM + wc * 32 + 8 * fq;
        const bf16_t* gp = half ? gb : ga;
#pragma unroll
        for (int ai = 0; ai < 2; ++ai)
#pragma unroll
            for (int m = 0; m < 4; ++m) { const size_t ro = (size_t)(row0 + ai * HALF + m * 16) * DM + col0;
#pragma unroll
                for (int bj = 0; bj < 2; ++bj) { const f32x4 v0 = acc[ai][bj][m][0], v1 = acc[ai][bj][m][1];
                    const u32x4 gw = *(const u32x4*)(gp + ro + bj * HALF);
                    float o[8];
                    o[0] = bf_lo(gw.x) * v0[0]; o[1] = bf_hi(gw.x) * v0[1]; o[2] = bf_lo(gw.y) * v0[2]; o[3] = bf_hi(gw.y) * v0[3];
                    o[4] = bf_lo(gw.z) * v1[0]; o[5] = bf_hi(gw.z) * v1[1]; o[6] = bf_lo(gw.w) * v1[2]; o[7] = bf_hi(gw.w) * v1[3];
                    if (half) { const u32x4 pw = *(const u32x4*)(mg + ro + bj * HALF);
                        o[0] += bf_lo(pw.x); o[1] += bf_hi(pw.x); o[2] += bf_lo(pw.y); o[3] += bf_hi(pw.y); o[4] += bf_lo(pw.z); o[5] += bf_hi(pw.z); o[6] += bf_lo(pw.w); o[7] += bf_hi(pw.w); }
                    u32x4 w; w.x = cvt_pk_bf16(o[0], o[1]); w.y = cvt_pk_bf16(o[2], o[3]); w.z = cvt_pk_bf16(o[4], o[5]); w.w = cvt_pk_bf16(o[6], o[7]);
                    *(u32x4*)(mg + ro + bj * HALF) = w; } }
    }
};
struct EpiF32 {
    static constexpr bool PERM = true, AFTER_DRAIN = false;
    float* O; int ldc;
    __device__ __forceinline__ void operator()(const f32x4 (&acc)[2][2][4][2], const Unit& u, int wr, int wc, int fr, int fq) const {
        const int row0 = u.pm * BM + wr * 64 + fr, col0 = u.pn * BM + wc * 32 + 8 * fq;
#pragma unroll
        for (int ai = 0; ai < 2; ++ai)
#pragma unroll
            for (int m = 0; m < 4; ++m) { float* rowp = O + (size_t)(row0 + ai * HALF + m * 16) * ldc + col0;
#pragma unroll
                for (int bj = 0; bj < 2; ++bj) { *(f32x4*)(rowp + bj * HALF) = acc[ai][bj][m][0]; *(f32x4*)(rowp + bj * HALF + 4) = acc[ai][bj][m][1]; } }
    }
};
struct EpiMoe1 {
    static constexpr bool PERM = true, AFTER_DRAIN = false;
    bf16_t* act; const float* bg; const float* bu;
    __device__ __forceinline__ void operator()(const f32x4 (&acc)[2][2][4][2], const Unit& u, int wr, int wc, int fr, int fq) const {
        const int row0 = u.pm * BM + wr * 64 + fr, cl = wc * 32 + 8 * fq, colo = (u.pn & 7) * HALF + cl;
        const size_t bo = (size_t)u.pn * HALF + cl;
        const f32x4 g0 = *(const f32x4*)(bg + bo), g1 = *(const f32x4*)(bg + bo + 4), u0 = *(const f32x4*)(bu + bo), u1 = *(const f32x4*)(bu + bo + 4);
#pragma unroll
        for (int ai = 0; ai < 2; ++ai)
#pragma unroll
            for (int m = 0; m < 4; ++m) {
                float o[8];
#pragma unroll
                for (int j = 0; j < 8; ++j) {
                    float gv = (j < 4 ? acc[ai][0][m][0][j & 3] : acc[ai][0][m][1][j & 3]) + (j < 4 ? g0[j & 3] : g1[j & 3]);
                    float uv = (j < 4 ? acc[ai][1][m][0][j & 3] : acc[ai][1][m][1][j & 3]) + (j < 4 ? u0[j & 3] : u1[j & 3]);
                    gv = fminf(gv, 7.0f); uv = fminf(fmaxf(uv, -7.0f), 7.0f);
                    o[j] = (uv + 1.0f) * (gv * fast_sigmoid(1.702f * gv));
                }
                u32x4 w; w.x = cvt_pk_bf16(o[0], o[1]); w.y = cvt_pk_bf16(o[2], o[3]); w.z = cvt_pk_bf16(o[4], o[5]); w.w = cvt_pk_bf16(o[6], o[7]);
                *(u32x4*)(act + (size_t)(row0 + ai * HALF + m * 16) * DM + colo) = w;
            }
    }
};
struct EpiMoe2 {
    static constexpr bool PERM = true, AFTER_DRAIN = false;
    bf16_t* yr; const float* bd;
    __device__ __forceinline__ void operator()(const f32x4 (&acc)[2][2][4][2], const Unit& u, int wr, int wc, int fr, int fq) const {
        const int row0 = u.pm * BM + wr * 64 + fr, cl = wc * 32 + 8 * fq, colo = (u.pn & 3) * BM + cl;
        const size_t bo = (size_t)u.pn * BM + cl;
        f32x4 bv[2][2];
#pragma unroll
        for (int bj = 0; bj < 2; ++bj) { bv[bj][0] = *(const f32x4*)(bd + bo + bj * HALF); bv[bj][1] = *(const f32x4*)(bd + bo + bj * HALF + 4); }
#pragma unroll
        for (int ai = 0; ai < 2; ++ai)
#pragma unroll
            for (int m = 0; m < 4; ++m) { bf16_t* rowp = yr + (size_t)(row0 + ai * HALF + m * 16) * DM + colo;
#pragma unroll
                for (int bj = 0; bj < 2; ++bj) { const f32x4 v0 = acc[ai][bj][m][0] + bv[bj][0], v1 = acc[ai][bj][m][1] + bv[bj][1];
                    u32x4 w; w.x = cvt_pk_bf16(v0[0], v0[1]); w.y = cvt_pk_bf16(v0[2], v0[3]); w.z = cvt_pk_bf16(v1[0], v1[1]); w.w = cvt_pk_bf16(v1[2], v1[3]);
                    *(u32x4*)(rowp + bj * HALF) = w; } }
    }
};
template <class Epi, class Sched, bool ALIGN_EPI = false, bool SP2 = false, bool GATHER = false>
__device__ __forceinline__ void gemm_phase(PG8_LAS unsigned char* lds, const Gemm g, const Sched& S, const Epi& E) {
    int tid_ = threadIdx.x; asm volatile("" : "+v"(tid_));
    const int tid = tid_, wid = __builtin_amdgcn_readfirstlane(tid >> 6), lane = tid & 63, wr = wid >> 2, wc = wid & 3, fr = lane & 15, fq = lane >> 4;
    const int K = g.K, nt = K / BK;
    unsigned voffA[2], voffB[2]; int rA[2], cA2[2];
#pragma unroll
    for (int i = 0; i < 2; ++i) { int R, C; stage_rc(tid * 16 + i * 8192, R, C); const int Rb = Epi::PERM ? ((R & ~31) + perm32(R & 31)) : R;
        voffA[i] = (unsigned)(R * K + C) * 2u; voffB[i] = (unsigned)(Rb * K + C) * 2u; rA[i] = R; cA2[i] = C * 2; }
    unsigned cvo[2][2], nvo[2][2];
#define PG8_GVO(dst, un) do { _Pragma("unroll") for (int _h = 0; _h < 2; ++_h) _Pragma("unroll") for (int _i = 0; _i < 2; ++_i) \
        dst[_h][_i] = (unsigned)S.arow(un, _h * HALF + rA[_i]) * (unsigned)(K * 2) + (unsigned)cA2[_i]; } while (0)
    const size_t kstep = (size_t)(BK * 2);
    const size_t hstep = (size_t)HALF * K * 2;
    const size_t tstep = 2 * hstep;
    const unsigned ldsw = (unsigned)wid * 1024u;
    const int aoff = lds_byte(wr * 64 + fr, fq * 8), boff = lds_byte(wc * 32 + fr, fq * 8);
#define PG8_SA(b, h) (((b) * 2 + (h)) * HTB)
#define PG8_SB(b, h) ((4 + (b) * 2 + (h)) * HTB)
#define PG8_STAGE(bufoff, gbase, voff) do { _Pragma("unroll") for (int _i = 0; _i < 2; ++_i) \
        __builtin_amdgcn_global_load_lds((const unsigned*)((const char*)(gbase) + (voff)[_i]), (PG8_LAS unsigned*)(lds + (bufoff) + ldsw + _i * 8192), 16, 0, 0); } while (0)
#define PG8_STAGE_A(bufoff, gbase, hh, nx) do { if constexpr (GATHER) { _Pragma("unroll") for (int _i = 0; _i < 2; ++_i) { const unsigned _vo = (nx) ? nvo[hh][_i] : cvo[hh][_i]; \
        __builtin_amdgcn_global_load_lds((const unsigned*)((const char*)(gbase) + _vo), (PG8_LAS unsigned*)(lds + (bufoff) + ldsw + _i * 8192), 16, 0, 0); } } \
        else { PG8_STAGE(bufoff, (gbase) + (hh) * hstep, voffA); } } while (0)
#define PG8_LDA(dst, b, h) do { _Pragma("unroll") for (int m = 0; m < 4; ++m) _Pragma("unroll") for (int k = 0; k < 2; ++k) dst[m][k] = *(const PG8_LAS bf16x8*)(lds + PG8_SA(b, h) + aoff + m * 2048 + k * 1024); } while (0)
#define PG8_LDB(dst, b, h) do { _Pragma("unroll") for (int n = 0; n < 2; ++n) _Pragma("unroll") for (int k = 0; k < 2; ++k) dst[n][k] = *(const PG8_LAS bf16x8*)(lds + PG8_SB(b, h) + boff + n * 2048 + k * 1024); } while (0)
#define PG8_MMA(ai, bj, At, Bt) do { __builtin_amdgcn_s_setprio(1); _Pragma("unroll") for (int m = 0; m < 4; ++m) _Pragma("unroll") for (int n = 0; n < 2; ++n) _Pragma("unroll") for (int k = 0; k < 2; ++k) \
        acc[ai][bj][m][n] = __builtin_amdgcn_mfma_f32_16x16x32_bf16(Bt[n][k], At[m][k], acc[ai][bj][m][n], 0, 0, 0); __builtin_amdgcn_s_setprio(0); } while (0)
#define PG8_WAIT_V(n) asm volatile("s_waitcnt vmcnt(" #n ")" ::: "memory")
#define PG8_WAIT_L(n) asm volatile("s_waitcnt lgkmcnt(" #n ")" ::: "memory")
#define PG8_BAR __builtin_amdgcn_s_barrier()
#define PG8_SCHED __builtin_amdgcn_sched_barrier(0)
    Unit cur, nxt; int ui = 0;
    if (!S.next(0, cur)) return;
    f32x4 acc[2][2][4][2];
#pragma unroll
    for (int a = 0; a < 2; ++a)
#pragma unroll
        for (int b = 0; b < 2; ++b)
#pragma unroll
            for (int m = 0; m < 4; ++m)
#pragma unroll
                for (int n = 0; n < 2; ++n) acc[a][b][m][n] = (f32x4){0.f, 0.f, 0.f, 0.f};
    bf16x8 At[4][2], B0[2][2], B1[2][2];
    const char* cA = (const char*)g.A + (GATHER ? (size_t)0 : (size_t)cur.pm * tstep); const char* cB = (const char*)g.Bt + (size_t)cur.pn * tstep;
    if constexpr (GATHER) { PG8_GVO(cvo, cur); }
    if constexpr (SP2) {
        PG8_STAGE(PG8_SB(0, 0), cB, voffB); PG8_STAGE(PG8_SB(0, 1), cB + hstep, voffB); PG8_STAGE_A(PG8_SA(0, 0), cA, 0, false); PG8_STAGE_A(PG8_SA(0, 1), cA, 1, false);
        if (wr == 1) PG8_BAR;
        PG8_WAIT_V(2); PG8_BAR;
        PG8_STAGE(PG8_SB(1, 0), cB + kstep, voffB); PG8_STAGE_A(PG8_SA(1, 0), cA + kstep, 0, false); PG8_STAGE(PG8_SB(1, 1), cB + hstep + kstep, voffB);
        PG8_WAIT_V(6); PG8_BAR;
    } else {
        PG8_STAGE(PG8_SB(0, 0), cB, voffB); PG8_STAGE_A(PG8_SA(0, 0), cA, 0, false); PG8_STAGE(PG8_SB(0, 1), cB + hstep, voffB); PG8_STAGE_A(PG8_SA(0, 1), cA, 1, false);
        if (wr == 1) PG8_BAR;
        PG8_WAIT_V(4); PG8_BAR;
        PG8_STAGE(PG8_SB(1, 0), cB + kstep, voffB); PG8_STAGE_A(PG8_SA(1, 0), cA + kstep, 0, false); PG8_STAGE(PG8_SB(1, 1), cB + hstep + kstep, voffB);
        PG8_WAIT_V(6); PG8_BAR;
    }
    for (;;) {
        const bool has_next = S.next(ui + 1, nxt);
        const char* nA = GATHER ? cA : (has_next ? (const char*)g.A + (size_t)nxt.pm * tstep : cA); const char* nB = has_next ? (const char*)g.Bt + (size_t)nxt.pn * tstep : cB;
        if constexpr (GATHER) { if (has_next) { PG8_GVO(nvo, nxt); } else { _Pragma("unroll") for (int _h = 0; _h < 2; ++_h) _Pragma("unroll") for (int _i = 0; _i < 2; ++_i) nvo[_h][_i] = cvo[_h][_i]; } }
        for (int t = 0; t < nt; t += 2) {
            const bool last = (t == nt - 2);
            const char* a1 = cA + (size_t)(t + 1) * kstep;
            const char* a2 = last ? nA : cA + (size_t)(t + 2) * kstep; const char* b2 = last ? nB : cB + (size_t)(t + 2) * kstep;
            const char* a3 = a2 + kstep; const char* b3 = b2 + kstep;
            if constexpr (SP2) {
            PG8_LDB(B0, 0, 0); PG8_LDB(B1, 0, 1); PG8_SCHED; PG8_LDA(At, 0, 0); PG8_STAGE_A(PG8_SA(1, 1), a1, 1, false);
            PG8_WAIT_V(8); PG8_WAIT_L(0); PG8_BAR; PG8_MMA(0, 0, At, B0); PG8_MMA(0, 1, At, B1); PG8_BAR; PG8_SCHED;
            PG8_LDA(At, 0, 1); PG8_STAGE(PG8_SB(0, 0), b2, voffB); PG8_STAGE(PG8_SB(0, 1), b2 + hstep, voffB); PG8_STAGE_A(PG8_SA(0, 0), a2, 0, last);
            PG8_WAIT_V(8); PG8_WAIT_L(0); PG8_BAR; PG8_MMA(1, 0, At, B0); PG8_MMA(1, 1, At, B1); PG8_BAR; PG8_SCHED;
            PG8_LDB(B0, 1, 0); PG8_LDB(B1, 1, 1); PG8_SCHED; PG8_LDA(At, 1, 0); PG8_STAGE_A(PG8_SA(0, 1), a2, 1, last);
            PG8_WAIT_V(8); PG8_WAIT_L(0); PG8_BAR; PG8_MMA(0, 0, At, B0); PG8_MMA(0, 1, At, B1); PG8_BAR; PG8_SCHED;
            PG8_LDA(At, 1, 1); PG8_STAGE(PG8_SB(1, 0), b3, voffB); PG8_STAGE(PG8_SB(1, 1), b3 + hstep, voffB); PG8_STAGE_A(PG8_SA(1, 0), a3, 0, last);
            PG8_WAIT_V(8); PG8_WAIT_L(0); PG8_BAR; PG8_MMA(1, 0, At, B0); PG8_MMA(1, 1, At, B1); PG8_BAR; PG8_SCHED;
            } else {
            PG8_LDB(B0, 0, 0); PG8_SCHED; PG8_LDA(At, 0, 0); PG8_STAGE_A(PG8_SA(1, 1), a1, 1, false);
            PG8_WAIT_L(8); PG8_BAR; PG8_WAIT_L(0); PG8_MMA(0, 0, At, B0); PG8_BAR; PG8_SCHED;
            PG8_LDB(B1, 0, 1); PG8_STAGE(PG8_SB(0, 0), b2, voffB);
            PG8_BAR; PG8_WAIT_L(0); PG8_MMA(0, 1, At, B1); PG8_BAR;
            PG8_LDA(At, 0, 1); PG8_STAGE_A(PG8_SA(0, 0), a2, 0, last);
            PG8_BAR; PG8_WAIT_L(0); PG8_MMA(1, 0, At, B0); PG8_BAR; PG8_SCHED;
            PG8_STAGE(PG8_SB(0, 1), b2 + hstep, voffB);
            PG8_WAIT_V(6); PG8_BAR; PG8_MMA(1, 1, At, B1); PG8_BAR;
            PG8_LDB(B0, 1, 0); PG8_SCHED; PG8_LDA(At, 1, 0); PG8_STAGE_A(PG8_SA(0, 1), a2, 1, last);
            PG8_WAIT_L(8); PG8_BAR; PG8_WAIT_L(0); PG8_MMA(0, 0, At, B0); PG8_BAR; PG8_SCHED;
            PG8_LDB(B1, 1, 1); PG8_STAGE(PG8_SB(1, 0), b3, voffB);
            PG8_BAR; PG8_WAIT_L(0); PG8_MMA(0, 1, At, B1); PG8_BAR;
            PG8_LDA(At, 1, 1); PG8_STAGE_A(PG8_SA(1, 0), a3, 0, last);
            PG8_BAR; PG8_WAIT_L(0); PG8_MMA(1, 0, At, B0); PG8_BAR; PG8_SCHED;
            PG8_STAGE(PG8_SB(1, 1), b3 + hstep, voffB);
            PG8_WAIT_V(6); PG8_BAR; PG8_MMA(1, 1, At, B1); PG8_BAR;
            }
        }
        if constexpr (ALIGN_EPI) { if (wr == 0) PG8_BAR; }
        if constexpr (!Epi::AFTER_DRAIN) { E(acc, cur, wr, wc, fr, fq); }
        if (!has_next) break;
#pragma unroll
        for (int a = 0; a < 2; ++a)
#pragma unroll
            for (int b = 0; b < 2; ++b)
#pragma unroll
                for (int m = 0; m < 4; ++m)
#pragma unroll
                    for (int n = 0; n < 2; ++n) acc[a][b][m][n] = (f32x4){0.f, 0.f, 0.f, 0.f};
        cur = nxt; cA = nA; cB = nB; ++ui;
        if constexpr (GATHER) { _Pragma("unroll") for (int _h = 0; _h < 2; ++_h) _Pragma("unroll") for (int _i = 0; _i < 2; ++_i) cvo[_h][_i] = nvo[_h][_i]; }
        if constexpr (ALIGN_EPI) { if (wr == 1) PG8_BAR; }
    }
    PG8_WAIT_V(0);
    if constexpr (!ALIGN_EPI) { if (wr == 0) PG8_BAR; }
    PG8_BAR;
#undef PG8_SA
#undef PG8_SB
#undef PG8_STAGE
#undef PG8_STAGE_A
#undef PG8_GVO
#undef PG8_LDA
#undef PG8_LDB
#undef PG8_MMA
#undef PG8_WAIT_V
#undef PG8_WAIT_L
#undef PG8_BAR
#undef PG8_SCHED
}
}

namespace attn_body {
using bf16=__hip_bfloat16;
using bf16x8=__attribute__((ext_vector_type(8)))short;
using s16x4=__attribute__((ext_vector_type(4)))short;
using f32x16=__attribute__((ext_vector_type(16)))float;
using u32x4=__attribute__((ext_vector_type(4)))unsigned;
constexpr int BATCH=8,NHEAD=16,SEQ=4096,D=64,DM=NHEAD*D;
constexpr int NW=8,QBLK=32,QB=QBLK*NW,KVBLK=64,NQB=SEQ/QB;
constexpr int ATTN_PITCH=DM, ATTN_UNIT_ROWS=QB;
__device__ __forceinline__ int crow(int r,int hi){return (r&3)+8*(r>>2)+4*hi;}
#define SBAR() __builtin_amdgcn_sched_barrier(0)
__device__ __forceinline__ void cmask(f32x16&p0,f32x16&p1,int jb,int qrel,int hi){
  const float NEG=-INFINITY; int kb=64*jb+4*hi;
  #pragma unroll
  for(int r=0;r<16;++r){int kv=kb+(r&3)+8*(r>>2); if(kv>qrel)p0[r]=NEG; if(kv+32>qrel)p1[r]=NEG;}
}

constexpr int NSLOT=3, SLOTB=8192;
constexpr int LDS_K=0, LDS_V=NSLOT*SLOTB, LDS_WS=2*NSLOT*SLOTB, LDS_OST=LDS_WS+NW*64*4, LDS_FK=LDS_OST+NW*4096, LDS_BYTES=LDS_FK+SEQ*4;
constexpr float C2=0.125f*1.4426950408889634f;
__device__ __forceinline__ void glds16(const void*gsrc,unsigned lds_dst){unsigned keep;
  asm volatile("s_mov_b32 %0, m0\n\ts_mov_b32 m0, %2\n\ts_nop 0\n\tglobal_load_lds_dwordx4 %1, off\n\ts_mov_b32 m0, %0":"=&s"(keep):"v"(gsrc),"s"(lds_dst):"memory");}
__device__ __forceinline__ float max3f(float a,float b,float c){float r;asm("v_max3_f32 %0, %1, %2, %3":"=v"(r):"v"(a),"v"(b),"v"(c));return r;}
__device__ __forceinline__ float max2f(float a,float b){float r;asm("v_max_f32_e32 %0, %1, %2":"=v"(r):"v"(a),"v"(b));return r;}
__device__ __forceinline__ float fadd_s(float a,float b){float r;asm("v_add_f32_e32 %0, %1, %2":"=v"(r):"v"(a),"v"(b));return r;}
__device__ __forceinline__ float fsub_s(float a,float b){float r;asm("v_sub_f32_e32 %0, %1, %2":"=v"(r):"v"(a),"v"(b));return r;}
typedef float f32x2_t __attribute__((ext_vector_type(2))); typedef __bf16 bf16x2_t __attribute__((ext_vector_type(2)));
__device__ __forceinline__ unsigned cvtpk_s(float lo,float hi){f32x2_t v={lo,hi};bf16x2_t b=__builtin_convertvector(v,bf16x2_t);return __builtin_bit_cast(unsigned,b);}
#define WAIT_BAR(N) asm volatile("s_waitcnt vmcnt(" #N ") lgkmcnt(0)\n\ts_barrier":::"memory")

__device__ __forceinline__ void qkt(f32x16&p0,f32x16&p1,const char*Kslot,const bf16x8*qr,int r32,int hi){
  const char*kb=Kslot+hi*1024+r32*16;
  #pragma unroll
  for(int d0=0;d0<4;++d0){
    const bf16x8 b0=*reinterpret_cast<const bf16x8*>(kb+d0*2048);
    const bf16x8 b1=*reinterpret_cast<const bf16x8*>(kb+d0*2048+512);
    p0=__builtin_amdgcn_mfma_f32_32x32x16_bf16(b0,qr[d0],p0,0,0,0);p1=__builtin_amdgcn_mfma_f32_32x32x16_bf16(b1,qr[d0],p1,0,0,0);}
}
typedef __attribute__((address_space(3))) const char* lds_cptr;
typedef short v4i16_t __attribute__((ext_vector_type(4)));
__device__ __forceinline__ void kload8(bf16x8*kf,lds_cptr kp){
  kf[0]=*(const __attribute__((address_space(3))) bf16x8*)(kp);      kf[1]=*(const __attribute__((address_space(3))) bf16x8*)(kp+512);
  kf[2]=*(const __attribute__((address_space(3))) bf16x8*)(kp+2048); kf[3]=*(const __attribute__((address_space(3))) bf16x8*)(kp+2560);
  kf[4]=*(const __attribute__((address_space(3))) bf16x8*)(kp+4096); kf[5]=*(const __attribute__((address_space(3))) bf16x8*)(kp+4608);
  kf[6]=*(const __attribute__((address_space(3))) bf16x8*)(kp+6144); kf[7]=*(const __attribute__((address_space(3))) bf16x8*)(kp+6656);
}
__device__ __forceinline__ void kload2(bf16x8*kf,lds_cptr kp,int j){ kf[2*j]=*(const __attribute__((address_space(3))) bf16x8*)(kp+j*2048); kf[2*j+1]=*(const __attribute__((address_space(3))) bf16x8*)(kp+j*2048+512); }
__device__ __forceinline__ s16x4 vtr(lds_cptr p){ return __builtin_bit_cast(s16x4,__builtin_amdgcn_ds_read_tr16_b64_v4i16((__attribute__((address_space(3))) v4i16_t*)p)); }
__device__ __forceinline__ float rowmax(const f32x16&p0,const f32x16&p1){
  float a=max3f(p0[0],p0[1],p1[0]),b=max3f(p0[2],p0[3],p1[1]);a=max3f(a,p1[2],p1[3]);
  #pragma unroll
  for(int r=4;r<16;r+=4){a=max3f(a,p0[r],p0[r+1]);b=max3f(b,p0[r+2],p0[r+3]);a=max3f(a,p1[r],p1[r+1]);b=max3f(b,p1[r+2],p1[r+3]);}
  const float m=max2f(a,b);
  auto rr=__builtin_amdgcn_permlane32_swap(__float_as_uint(m),__float_as_uint(m),false,false);
  return max2f(__uint_as_float(rr[0]),__uint_as_float(rr[1]));
}
__device__ __forceinline__ void pv(f32x16*o,int vb,bf16x8 pa0,bf16x8 pa1,bf16x8 pa2,bf16x8 pa3){
  #pragma unroll
  for(int d0=0;d0<2;++d0){s16x4 lo[4],hi[4];
    #pragma unroll
    for(int ks=0;ks<4;++ks){
      asm volatile("ds_read_b64_tr_b16 %0,%1 offset:%c2":"=&v"(lo[ks]):"v"(vb),"i"(d0*4096+ks*1024):"memory");
      asm volatile("ds_read_b64_tr_b16 %0,%1 offset:%c2":"=&v"(hi[ks]):"v"(vb),"i"(d0*4096+ks*1024+512):"memory");}
    asm volatile("s_waitcnt lgkmcnt(0)":::"memory");SBAR();
    #define PK(k) (bf16x8){lo[k][0],lo[k][1],lo[k][2],lo[k][3],hi[k][0],hi[k][1],hi[k][2],hi[k][3]}
    o[d0]=__builtin_amdgcn_mfma_f32_32x32x16_bf16(pa0,PK(0),o[d0],0,0,0);
    o[d0]=__builtin_amdgcn_mfma_f32_32x32x16_bf16(pa1,PK(1),o[d0],0,0,0);
    o[d0]=__builtin_amdgcn_mfma_f32_32x32x16_bf16(pa2,PK(2),o[d0],0,0,0);
    o[d0]=__builtin_amdgcn_mfma_f32_32x32x16_bf16(pa3,PK(3),o[d0],0,0,0);
    #undef PK
  }
}

#ifndef ATTN_STORE16
#define ATTN_STORE16(p,v) (*(u32x4*)(p)=(v))
#endif
template<int THRL> __device__ __forceinline__ void attn_unit(int b,int h,int qb,const bf16*Q,const bf16*__restrict__ K,const bf16*__restrict__ V,bf16*O,const float*__restrict__ FP,char*shm){
  int tid_=threadIdx.x; asm volatile("":"+v"(tid_));
  const int tid=tid_,lane=tid&63,r32=lane&31,hi=lane>>5; const int wid=__builtin_amdgcn_readfirstlane(tid>>6);
  const long rowbase=(long)b*SEQ; const int q0=qb*QB;
  const bf16*Qw=Q+(rowbase+q0+wid*QBLK)*DM+h*D;
  const bf16*Kh=K+rowbase*DM+h*D,*Vh=V+rowbase*DM+h*D;
  const lds_cptr shm3=(lds_cptr)shm;
  const unsigned lds0=(unsigned)(uintptr_t)shm;
  float*wsf=(float*)(shm+LDS_WS)+wid*64;
  const bf16*ksrc=Kh+(long)lane*DM+wid*8;
  const bf16*vsrc=Vh+(long)(16*(wid&3)+(lane>>2))*DM+(wid>>2)*32+(lane&3)*8;
  const unsigned kdst=lds0+LDS_K+wid*1024, vdst=lds0+LDS_V+wid*1024;
  #define DMA_K(t,slot) glds16(ksrc+(long)(t)*KVBLK*DM,(unsigned)__builtin_amdgcn_readfirstlane(kdst+(slot)))
  #define DMA_V(t,slot) glds16(vsrc+(long)(t)*KVBLK*DM,(unsigned)__builtin_amdgcn_readfirstlane(vdst+(slot)))
  const int vb0=(int)(lds0+LDS_V)+((lane>>4)&1)*32+(lane&3)*8+(4*hi+((lane&15)>>2))*64;
  const char*Kbase=shm+LDS_K; bf16x8 kf[8];
  const lds_cptr kp0=shm3+LDS_K+hi*1024+r32*16; const lds_cptr vp0=shm3+LDS_V+((lane>>4)&1)*32+(lane&3)*8+(4*hi+((lane&15)>>2))*64;
  const int NT=(q0+QB)/KVBLK;
  DMA_K(0,0);DMA_V(0,0);DMA_K(1,SLOTB);
  const float*Fbh=FP+(long)(b*NHEAD+h)*SEQ;
  { typedef float f32x4_t __attribute__((ext_vector_type(4))); __attribute__((address_space(3))) f32x4_t*fdst=(__attribute__((address_space(3))) f32x4_t*)(shm3+LDS_FK);
    for(int i=tid;i<(q0+QB)/4;i+=NW*64)fdst[i]=*reinterpret_cast<const f32x4_t*>(Fbh+4*i); }
  const float fq=Fbh[q0+wid*QBLK+r32];
  const __attribute__((address_space(3))) float*fk3=(const __attribute__((address_space(3))) float*)(shm3+LDS_FK)+4*hi;
  #define FINIT(P0,P1,t) do{ typedef float f32x4_t __attribute__((ext_vector_type(4))); const __attribute__((address_space(3))) float*fk_=fk3+(t)*KVBLK; \
    _Pragma("unroll") for(int g_=0;g_<4;++g_){ const f32x4_t a_=*(const __attribute__((address_space(3))) f32x4_t*)(fk_+8*g_), b_=*(const __attribute__((address_space(3))) f32x4_t*)(fk_+32+8*g_); \
      _Pragma("unroll") for(int j_=0;j_<4;++j_){ P0[4*g_+j_]=tq-a_[j_]; P1[4*g_+j_]=tq-b_[j_]; } } }while(0)
  bf16x8 qr[4];
  #pragma unroll
  for(int d0=0;d0<4;++d0)qr[d0]=*reinterpret_cast<const bf16x8*>(&Qw[(long)r32*DM+d0*16+hi*8]);
  float mhat=0.f,l_reg=0.f;f32x16 o[2];o[0]=f32x16{};o[1]=f32x16{};float tq=fq;
  const int qrel=wid*QBLK+r32;
  #define CMASK(P0,P1,t) do{int jb_=(t)-(NT-4); if(jb_>=0)cmask(P0,P1,jb_,qrel,hi);}while(0)
  bool resc=false;
  #define START(P0,P1) do{ const float rm=rowmax(P0,P1); resc=false; \
    { const float dl=rm; mhat=fadd_s(mhat,dl); \
      _Pragma("unroll") for(int r=0;r<16;++r){P0[r]=fsub_s(P0[r],dl);P1[r]=fsub_s(P1[r],dl);} \
      tq=fq-mhat; } \
    _Pragma("unroll") for(int r=0;r<16;++r)P0[r]=__builtin_amdgcn_exp2f(P0[r]); }while(0)
  #define RESC() do{ if(resc){ asm volatile("s_waitcnt lgkmcnt(0)":::"memory"); \
      _Pragma("unroll") for(int d_=0;d_<2;++d_) _Pragma("unroll") for(int r=0;r<16;++r)o[d_][r]*=wsf[crow(r,hi)]; } }while(0)
  f32x16 pA0,pA1,pB0,pB1;
  int sl_prev=0,sl_cur=0,sl_next=SLOTB;
  #define ROT() do{sl_prev=sl_cur;sl_cur=sl_next;sl_next=(sl_next==(NSLOT-1)*SLOTB)?0:sl_next+SLOTB;}while(0)
  DMA_K(2,2*SLOTB);
  WAIT_BAR(3);
  FINIT(pA0,pA1,0);
  qkt(pA0,pA1,Kbase,qr,r32,hi);asm volatile("s_nop 15\n\ts_nop 7":"+v"(pA0),"+v"(pA1));CMASK(pA0,pA1,0);
  START(pA0,pA1);
  _Pragma("unroll") for(int r=0;r<16;++r)pA1[r]=__builtin_amdgcn_exp2f(pA1[r]);
  WAIT_BAR(0);
  DMA_K(3,0);DMA_V(1,SLOTB);
  ROT();
  kload8(kf,kp0+sl_cur);
  WAIT_BAR(2);
  s16x4 vlo[8],vhi[8]; u32x4 pw0,pw1,pw2,pw3;
  #define PKW(P,B) cvtpk_s(P[B],P[B+1])
  #define PAF(k) __builtin_bit_cast(bf16x8,pw##k)
  #define VFR(i) (bf16x8){vlo[i][0],vlo[i][1],vlo[i][2],vlo[i][3],vhi[i][0],vhi[i][1],vhi[i][2],vhi[i][3]}
  #define PIN(x) asm volatile("":"+v"(x))
  #define MX3(a,b,c) __builtin_fmaxf(__builtin_fmaxf((a),(b)),(c))
  #define GAPA(MF,A0,A1,A2,A3,W0,W1,PW) do{ MF; sacc+=A0; sacc+=A1; sacc+=A2; sacc+=A3; PIN(sacc); W0; W1; PIN(PW); SBAR(); }while(0)
  #define EX(v) __builtin_amdgcn_exp2f(v)
  #define GAPB(MF,X,B) do{ MF; X[B]=EX(X[B]); X[B+1]=EX(X[B+1]); X[B+2]=EX(X[B+2]); X[B+3]=EX(X[B+3]); PIN(X); SBAR(); }while(0)
  #define VRD(i) do{ vlo[i]=vtr(vp_+(((i)>>2)*4096+((i)&3)*1024)); vhi[i]=vtr(vp_+(((i)>>2)*4096+((i)&3)*1024+512)); }while(0)
  #define KRD(G,j) do{ if(G){ kload2(kf,kp0+sl_next,j); SBAR(); } }while(0)
  #define STEP(C0,C1,P0,P1,t,GK,GV,GL) do{ SBAR(); FINIT(C0,C1,t); SBAR(); \
    const lds_cptr vp_=vp0+sl_prev; \
    VRD(0); SBAR(); float sacc=(P0[0]+P0[1]); \
    GAPA(C0=__builtin_amdgcn_mfma_f32_32x32x16_bf16(kf[0],qr[0],C0,0,0,0), P0[2],P0[3],P0[4],P0[5],     pw0[0]=PKW(P0,0), pw0[1]=PKW(P0,2), pw0); \
    VRD(4); SBAR(); GAPA(C1=__builtin_amdgcn_mfma_f32_32x32x16_bf16(kf[1],qr[0],C1,0,0,0), P0[6],P0[7],P0[8],P0[9],     pw0[2]=PKW(P0,4), pw0[3]=PKW(P0,6), pw0); \
    VRD(1); SBAR(); GAPA(C0=__builtin_amdgcn_mfma_f32_32x32x16_bf16(kf[2],qr[1],C0,0,0,0),   P0[10],P0[11],P0[12],P0[13], pw1[0]=PKW(P0,8), pw1[1]=PKW(P0,10), pw1); \
    VRD(5); SBAR(); GAPA(C1=__builtin_amdgcn_mfma_f32_32x32x16_bf16(kf[3],qr[1],C1,0,0,0),   P0[14],P0[15],P1[0],P1[1],   pw1[2]=PKW(P0,12),pw1[3]=PKW(P0,14), pw1); \
    VRD(2); SBAR(); GAPA(C0=__builtin_amdgcn_mfma_f32_32x32x16_bf16(kf[4],qr[2],C0,0,0,0),   P1[2],P1[3],P1[4],P1[5],     pw2[0]=PKW(P1,0), pw2[1]=PKW(P1,2), pw2); \
    VRD(6); SBAR(); GAPA(C1=__builtin_amdgcn_mfma_f32_32x32x16_bf16(kf[5],qr[2],C1,0,0,0),   P1[6],P1[7],P1[8],P1[9],     pw2[2]=PKW(P1,4), pw2[3]=PKW(P1,6), pw2); \
    VRD(3); SBAR(); GAPA(C0=__builtin_amdgcn_mfma_f32_32x32x16_bf16(kf[6],qr[3],C0,0,0,0),   P1[10],P1[11],P1[12],P1[13], pw3[0]=PKW(P1,8), pw3[1]=PKW(P1,10), pw3); \
    VRD(7); SBAR(); GAPA(C1=__builtin_amdgcn_mfma_f32_32x32x16_bf16(kf[7],qr[3],C1,0,0,0),   P1[14],P1[15],0.f,0.f,       pw3[2]=PKW(P1,12),pw3[3]=PKW(P1,14), pw3); \
    l_reg+=sacc; \
    if(GK){DMA_K((t)+3,sl_cur);} if(GV){DMA_V((t)+1,sl_next);} \
    CMASK(C0,C1,t); \
    { float a=MX3(C0[0],C0[1],C1[0]),b=MX3(C0[2],C0[3],C1[1]); a=MX3(a,C1[2],C1[3]); \
      _Pragma("unroll") for(int r=4;r<16;r+=4){a=MX3(a,C0[r],C0[r+1]);b=MX3(b,C0[r+2],C0[r+3]);a=MX3(a,C1[r],C1[r+1]);b=MX3(b,C1[r+2],C1[r+3]);} \
      float rm=__builtin_fmaxf(a,b); { auto rr=__builtin_amdgcn_permlane32_swap(__float_as_uint(rm),__float_as_uint(rm),false,false); rm=__builtin_fmaxf(__uint_as_float(rr[0]),__uint_as_float(rr[1])); } \
      resc=false; \
      if(__builtin_expect(__any(rm>(float)THRL),0)){ const float dl=__builtin_fmaxf(rm,0.f); mhat+=dl; \
        _Pragma("unroll") for(int r=0;r<16;++r){C0[r]-=dl;C1[r]-=dl;} \
        tq=fq-mhat; \
        const float f=__builtin_amdgcn_exp2f(-dl); l_reg*=f; if(hi==0)wsf[r32]=f; resc=true; } } \
    SBAR(); \
    GAPB(o[0]=__builtin_amdgcn_mfma_f32_32x32x16_bf16(PAF(0),VFR(0),o[0],0,0,0), C0,0); \
    GAPB(o[1]=__builtin_amdgcn_mfma_f32_32x32x16_bf16(PAF(0),VFR(4),o[1],0,0,0), C0,4); \
    KRD(GL,0); GAPB(o[0]=__builtin_amdgcn_mfma_f32_32x32x16_bf16(PAF(1),VFR(1),o[0],0,0,0), C0,8); \
    KRD(GL,1); GAPB(o[1]=__builtin_amdgcn_mfma_f32_32x32x16_bf16(PAF(1),VFR(5),o[1],0,0,0), C0,12); \
    KRD(GL,2); GAPB(o[0]=__builtin_amdgcn_mfma_f32_32x32x16_bf16(PAF(2),VFR(2),o[0],0,0,0), C1,0); \
    KRD(GL,3); GAPB(o[1]=__builtin_amdgcn_mfma_f32_32x32x16_bf16(PAF(2),VFR(6),o[1],0,0,0), C1,4); \
    GAPB(o[0]=__builtin_amdgcn_mfma_f32_32x32x16_bf16(PAF(3),VFR(3),o[0],0,0,0), C1,8); \
    GAPB(o[1]=__builtin_amdgcn_mfma_f32_32x32x16_bf16(PAF(3),VFR(7),o[1],0,0,0), C1,12); \
    }while(0)
  int t=1;
  #undef CMASK
  #define CMASK(P0,P1,t) do{}while(0)
  for(;t+5<NT;t+=2){
    STEP(pB0,pB1,pA0,pA1,t,true,true,true);     WAIT_BAR(2); RESC(); ROT();
    STEP(pA0,pA1,pB0,pB1,t+1,true,true,true);   WAIT_BAR(2); RESC(); ROT();
  }
  #undef CMASK
  #define CMASK(P0,P1,t) do{int jb_=(t)-(NT-4); if(jb_>=0)cmask(P0,P1,jb_,qrel,hi);}while(0)
  #define ENDW(tt) do{ if((tt)+3<NT){WAIT_BAR(2);} else if((tt)+2<NT){WAIT_BAR(1);} else {WAIT_BAR(0);} }while(0)
  for(;t+1<NT;t+=2){
    STEP(pB0,pB1,pA0,pA1,t,(t+3<NT),(t+1<NT),(t+1<NT));       ENDW(t);   RESC(); ROT();
    STEP(pA0,pA1,pB0,pB1,t+1,(t+4<NT),(t+2<NT),(t+2<NT));     ENDW(t+1); RESC(); ROT();
  }
  STEP(pB0,pB1,pA0,pA1,NT-1,false,false,false); RESC();
  { float sacc=pB0[0]+pB0[1]; _Pragma("unroll") for(int r=2;r<16;++r)sacc+=pB0[r]; _Pragma("unroll") for(int r=0;r<16;++r)sacc+=pB1[r]; l_reg+=sacc;
    pw0=(u32x4){PKW(pB0,0),PKW(pB0,2),PKW(pB0,4),PKW(pB0,6)};pw1=(u32x4){PKW(pB0,8),PKW(pB0,10),PKW(pB0,12),PKW(pB0,14)};pw2=(u32x4){PKW(pB1,0),PKW(pB1,2),PKW(pB1,4),PKW(pB1,6)};pw3=(u32x4){PKW(pB1,8),PKW(pB1,10),PKW(pB1,12),PKW(pB1,14)};
    SBAR(); pv(o,vb0+sl_cur,PAF(0),PAF(1),PAF(2),PAF(3)); }
  #undef PKW
  #undef PAF
  #undef VFR
  #undef PIN
  #undef MX3
  #undef GAPA
  #undef GAPB
  #undef EX
  #undef VRD
  #undef KRD
  #undef STEP
  #undef ENDW
  {auto rr=__builtin_amdgcn_permlane32_swap(__float_as_uint(l_reg),__float_as_uint(l_reg),false,false);l_reg=__uint_as_float(rr[0])+__uint_as_float(rr[1]);}
  if(hi==0)wsf[32+r32]=l_reg;asm volatile("s_waitcnt lgkmcnt(0)":::"memory");
  float rli[16];
  #pragma unroll
  for(int r=0;r<16;++r)rli[r]=__builtin_amdgcn_rcpf(wsf[32+crow(r,hi)]);
  bf16*Ow=O+(rowbase+q0+wid*QBLK)*DM+h*D;
  { bf16*stg=(bf16*)(shm+LDS_OST)+wid*2048;
    #pragma unroll
    for(int r=0;r<16;++r){const int orow=crow(r,hi);
      #pragma unroll
      for(int d0=0;d0<2;++d0)stg[orow*64+d0*32+r32]=__float2bfloat16(o[d0][r]*rli[r]);}
    asm volatile("s_waitcnt lgkmcnt(0)":::"memory");
    #pragma unroll
    for(int i=0;i<4;++i){const int row=i*8+(lane>>3),ch=lane&7; const u32x4 v=*(const u32x4*)(stg+row*64+ch*8); ATTN_STORE16(Ow+(long)row*DM+ch*8,v);} }
  asm volatile("s_waitcnt lgkmcnt(0)\n\ts_barrier":::"memory");
  #undef FINIT
  #undef DMA_K
  #undef DMA_V
  #undef CMASK
  #undef START
  #undef RESC
  #undef ROT
}
constexpr int ATTN_LDS_BYTES=LDS_BYTES;
#undef SBAR
#undef WAIT_BAR
}
#define GAS __attribute__((address_space(1)))
#define LAS __attribute__((address_space(3)))
typedef unsigned short bf16;
typedef unsigned v4u __attribute__((ext_vector_type(4)));
typedef float f32x4 __attribute__((ext_vector_type(4)));
typedef short bf16x8 __attribute__((ext_vector_type(8)));
typedef GAS unsigned gu32;
typedef GAS unsigned long long gu64;
#define RLX_AGENT __ATOMIC_RELAXED, __HIP_MEMORY_SCOPE_AGENT
#define LDS_WAIT() asm volatile("s_waitcnt lgkmcnt(0)" ::: "memory")
#define VM_WAIT() asm volatile("s_waitcnt vmcnt(0)" ::: "memory")
__device__ __forceinline__ unsigned long long rt() { return __builtin_amdgcn_s_memrealtime(); }
__device__ __forceinline__ unsigned f2bf(float f) { unsigned u = __builtin_bit_cast(unsigned, f); return (u + 0x7fffu + ((u >> 16) & 1u)) >> 16; }
__device__ __forceinline__ unsigned pk2(float lo, float hi) { return f2bf(lo) | (f2bf(hi) << 16); }

#define XB_TMO      128
#define XB_XCNT(j)  (256  + 64 * (j))
#define XB_XSUB(j)  (1280 + 64 * (j))
#define XB_XGEN(j)  (2304 + 64 * (j))
#define XB_TOP      3328
#define XB_TOPGEN   3392
#define XCD_BAR_WORDS 3456
#define XB_SPIN_CAP (1u << 18)

__device__ __forceinline__ unsigned xb_ld(unsigned* p)              { return __hip_atomic_load(p, __ATOMIC_RELAXED, __HIP_MEMORY_SCOPE_AGENT); }
__device__ __forceinline__ unsigned xb_add(unsigned* p, unsigned v) { return __hip_atomic_fetch_add(p, v, __ATOMIC_RELAXED, __HIP_MEMORY_SCOPE_AGENT); }
__device__ __forceinline__ unsigned xb_xcc_id() { return (unsigned)__builtin_amdgcn_s_getreg((3 << 11) | 20) & 0xFu; }
#define XB_SPIN(cond, bar) do { unsigned _sp = 0; while (cond) { __builtin_amdgcn_s_sleep(1); \
    if ((++_sp & 255u) == 0u) { if (xb_ld(&(bar)[XB_TMO])) break; if (_sp > XB_SPIN_CAP) { atomicAdd(&(bar)[XB_TMO], 1u); break; } } } } while (0)

struct XcdBarrier {
    unsigned* bar; unsigned x;
    volatile LAS unsigned* st;
};

__device__ __forceinline__ XcdBarrier xcd_barrier_post(unsigned* bar, volatile LAS unsigned* st) {
    XcdBarrier b; b.bar = bar; b.x = xb_xcc_id(); b.st = st;
    if (threadIdx.x == 0) (void)xb_add(&bar[XB_XCNT(b.x)], 1u);
    return b;
}
__device__ __forceinline__ void xcd_barrier_complete(unsigned* bar, unsigned x, unsigned& nloc, unsigned& nx) {
    const unsigned G = gridDim.x * gridDim.y * gridDim.z;
    unsigned sum, cnt, mine, sp = 0u;
    for (;;) {
        sum = 0u; cnt = 0u; mine = 0u;
#pragma unroll
        for (unsigned j = 0; j < 16; ++j) { const unsigned c = xb_ld(&bar[XB_XCNT(j)]); sum += c; cnt += (c > 0u) ? 1u : 0u; mine = (j == x) ? c : mine; }
        if (sum == G) break;
        __builtin_amdgcn_s_sleep(1);
        if ((++sp & 255u) == 0u) { if (xb_ld(&bar[XB_TMO])) break; if (sp > XB_SPIN_CAP) { atomicAdd(&bar[XB_TMO], 1u); break; } }
    }
    nloc = mine > 0u ? mine : 1u; nx = cnt > 0u ? cnt : 1u;
}

__device__ __forceinline__ void xcd_barrier(const XcdBarrier& b) {
    asm volatile("s_waitcnt vmcnt(0)" ::: "memory");
    __syncthreads();
    if (threadIdx.x == 0) {
        unsigned* bar = b.bar;
        __builtin_amdgcn_s_waitcnt(0);
        unsigned nloc = b.st[0], nx = b.st[1];
        if (nloc == 0u) { xcd_barrier_complete(bar, b.x, nloc, nx); b.st[0] = nloc; b.st[1] = nx; }
        const unsigned old = xb_add(&bar[XB_XSUB(b.x)], 1u);
        const unsigned gen = old / nloc;
        if (old + 1u == (gen + 1u) * nloc) {
            __builtin_amdgcn_fence(__ATOMIC_RELEASE, "agent");
            asm volatile("s_waitcnt vmcnt(0)" ::: "memory");
            const unsigned og = xb_add(&bar[XB_TOP], 1u);
            const unsigned tg = og / nx;
            if (og + 1u == (tg + 1u) * nx) xb_add(&bar[XB_TOPGEN], 1u);
            else XB_SPIN(xb_ld(&bar[XB_TOPGEN]) == tg, bar);
            __builtin_amdgcn_fence(__ATOMIC_ACQUIRE, "agent");
            xb_add(&bar[XB_XGEN(b.x)], 1u);
            asm volatile("s_waitcnt vmcnt(0)" ::: "memory");
        } else {
            XB_SPIN(xb_ld(&bar[XB_XGEN(b.x)]) == gen, bar);
            __builtin_amdgcn_fence(__ATOMIC_ACQUIRE, "agent");
            asm volatile("s_waitcnt vmcnt(0)" ::: "memory");
        }
    }
    __syncthreads();
}

constexpr size_t MiB = 1u << 20;
constexpr size_t SZB = (size_t)NTOK * DM * 2;
constexpr size_t WS_CTL = 0, CTL_ZERO_BYTES = 1 * MiB;
constexpr size_t WS_MOD = 1 * MiB;
constexpr size_t WS_LB = WS_MOD + 768 * 1024;
constexpr size_t WS_FP = 2 * MiB;
constexpr size_t WS_LS = 4 * MiB;
constexpr size_t WS_LIST = 6 * MiB;
constexpr size_t WS_ASGE = 10 * MiB;
constexpr size_t WS_ASGW = 10 * MiB + 512 * 1024;
constexpr size_t WS_WIN = 12 * MiB;
constexpr size_t WS_WBR = WS_WIN + 72 * MiB;
constexpr size_t WS_WOUT = WS_WBR + 16 * MiB;
constexpr size_t WS_WGU = WS_WOUT + 8 * MiB;
constexpr size_t WS_WD = WS_WGU + 512 * MiB;
constexpr size_t WS_X1 = WS_WD + 256 * MiB;
constexpr size_t WS_HB = WS_X1 + 128 * MiB;
constexpr size_t WS_PROJ = WS_HB + 64 * MiB;
constexpr size_t WS_LF = WS_PROJ + 576 * MiB;
constexpr size_t WS_OAB = WS_LF + 128 * MiB;
constexpr size_t WS_END = WS_OAB + 128 * MiB;
constexpr size_t WS_Y = WS_PROJ;
constexpr size_t WS_MG = WS_PROJ + 2 * SZB;
constexpr int MOE_TILES_MAX = 544;
constexpr size_t WS_ACT = WS_PROJ;
constexpr size_t WS_YR = WS_PROJ + 272 * MiB;
static_assert(WS_YR + 272 * MiB <= WS_LF, "MoE buffers fit over the projection buffers");
static_assert(WS_END <= (size_t)2048 * MiB, "workspace map fits in 2 GiB");
constexpr int CW_BAR = 4096;
constexpr int CW_WQ = 8192;
constexpr int CW_CNT = 16384;

constexpr int RING_OFF = 0, RING_BYTES = 131072;
constexpr int SCR_WAVE = 16640;
constexpr int TAB_OFF = 139264;
constexpr int T_MISC = TAB_OFF;
constexpr int T_TBASE = TAB_OFF + 256;
constexpr int T_CNT = TAB_OFF + 512;
constexpr int T_LCNT = TAB_OFF + 640;
constexpr int T_GBASE = TAB_OFF + 768;
constexpr int T_RT2E = TAB_OFF + 1024;
constexpr int T_ASG = TAB_OFF + 2048;
constexpr int LDS_BYTES = 147456;
static_assert(8 * SCR_WAVE <= TAB_OFF && T_ASG + 8 * 512 <= LDS_BYTES, "LDS map");

typedef float f32x2 __attribute__((ext_vector_type(2)));
typedef unsigned u32x2 __attribute__((ext_vector_type(2)));
typedef float f32x16 __attribute__((ext_vector_type(16)));
typedef short v4i16_t __attribute__((ext_vector_type(4)));
#define LDS_BARRIER() do { asm volatile("s_waitcnt lgkmcnt(0)" ::: "memory"); __builtin_amdgcn_s_barrier(); asm volatile("" ::: "memory"); } while (0)

__device__ __forceinline__ float wave_sum(float v) {
#pragma unroll
    for (int o = 1; o < 64; o <<= 1) v += __shfl_xor(v, o);
    return v;
}
__device__ __forceinline__ unsigned pkbf(float lo, float hi) { return pg8::cvt_pk_bf16(lo, hi); }

__device__ __forceinline__ void transpose_item(const float* __restrict__ src, int ld, bf16* __restrict__ dst, LAS float* scr, int lane) {
#pragma unroll 4
    for (int i = 0; i < 16; ++i) { const int kk = 4 * i + (lane >> 4), nn = 4 * (lane & 15);
        const f32x4 v = *(const GAS f32x4*)(src + (size_t)kk * ld + nn);
        scr[(nn + 0) * 65 + kk] = v.x; scr[(nn + 1) * 65 + kk] = v.y; scr[(nn + 2) * 65 + kk] = v.z; scr[(nn + 3) * 65 + kk] = v.w; }
    LDS_WAIT(); asm volatile("" ::: "memory");
    const int kc = lane & 7;
#pragma unroll
    for (int i2 = 0; i2 < 8; ++i2) { const int n = (lane >> 3) + 8 * i2; const LAS float* s = scr + n * 65 + 8 * kc;
        v4u o; o.x = pkbf(s[0], s[1]); o.y = pkbf(s[2], s[3]); o.z = pkbf(s[4], s[5]); o.w = pkbf(s[6], s[7]);
        *(GAS v4u*)(dst + (size_t)n * DM + 8 * kc) = o; }
    LDS_WAIT(); asm volatile("" ::: "memory");
}

struct Ptrs {
    const float *x, *c, *w_in, *fox_f_bias, *hg_lb_logits, *hg_norm_w, *w_branch, *w_out, *ada_w, *ada_b, *ln1_g, *ln1_b, *w_router, *b_router,
                *w_gate, *b_gate, *w_up, *b_up, *w_down, *b_down, *ln2_g, *ln2_b;
    float* out; unsigned char* ws;
};

__device__ __forceinline__ void p0_prologue(const Ptrs& P, LAS unsigned char* lds, int G) {
    int tid_ = threadIdx.x; asm volatile("" : "+v"(tid_)); const int tid = tid_, lane = tid & 63, wave = __builtin_amdgcn_readfirstlane(tid >> 6);
    unsigned char* ws = P.ws;
    {
        LAS float* cact = (LAS float*)(lds);
        LAS float* part = (LAS float*)(lds + 32768);
        for (int idx = tid; idx < NB * DM; idx += 512) { const int b = idx >> 10, k = idx & 1023; const float v = P.c[idx]; cact[k * 8 + b] = v / (1.0f + __expf(-v)); }
        __syncthreads();
        float* MOD = (float*)(ws + WS_MOD);
        for (int u = blockIdx.x; u < NLAYER * 96; u += G) {
            const int l = u / 96, cc = u % 96, col = cc * 64 + lane;
            const float* wp = P.ada_w + ((size_t)l * DM + wave * 128) * 6144 + col;
            float acc[8];
#pragma unroll
            for (int b = 0; b < 8; ++b) acc[b] = 0.f;
#pragma unroll 8
            for (int k = 0; k < 128; ++k) { const float wv = wp[(size_t)k * 6144]; const f32x4 c0 = *(const LAS f32x4*)(cact + (wave * 128 + k) * 8), c1 = *(const LAS f32x4*)(cact + (wave * 128 + k) * 8 + 4);
                acc[0] += c0.x * wv; acc[1] += c0.y * wv; acc[2] += c0.z * wv; acc[3] += c0.w * wv; acc[4] += c1.x * wv; acc[5] += c1.y * wv; acc[6] += c1.z * wv; acc[7] += c1.w * wv; }
#pragma unroll
            for (int b = 0; b < 8; ++b) part[(wave * 8 + b) * 64 + lane] = acc[b];
            __syncthreads();
            { const int b = tid >> 6; float s = 0.f;
#pragma unroll
              for (int w = 0; w < 8; ++w) s += part[(w * 8 + b) * 64 + lane];
              MOD[((size_t)l * NB + b) * 6144 + col] = s + P.ada_b[(size_t)l * 6144 + col]; }
            __syncthreads();
        }
    }
    if (blockIdx.x == G - 1) {
        float* LB = (float*)(ws + WS_LB);
        for (int d = tid; d < DM; d += 512) {
            const float a0 = P.hg_lb_logits[d], a1 = P.hg_lb_logits[DM + d], a2 = P.hg_lb_logits[2 * DM + d], a3 = P.hg_lb_logits[3 * DM + d];
            const float mx = fmaxf(fmaxf(a0, a1), fmaxf(a2, a3));
            const float e0 = expf(a0 - mx), e1 = expf(a1 - mx), e2 = expf(a2 - mx), e3 = expf(a3 - mx), inv = 1.0f / (e0 + e1 + e2 + e3);
            const float p1 = e1 * inv, p2 = e2 * inv, p3 = e3 * inv;
            LB[d] = 0.f; LB[DM + d] = fminf(fmaxf(p1, 0.f), 1.f); LB[2 * DM + d] = fminf(fmaxf(p1 + p2, 0.f), 1.f); LB[3 * DM + d] = fminf(fmaxf(p1 + p2 + p3, 0.f), 1.f);
        }
    }
    __syncthreads();
    {
        LAS float* scr = (LAS float*)(lds + wave * SCR_WAVE);
        const int gw = blockIdx.x * 8 + wave, NGW = G * 8;
        constexpr int I_IN1 = 16 * 112, I_IN2 = 16 * 32, I_BR = 2 * 256, I_OUT = 256, I_EXP = 768, I_MOE = NEXP * I_EXP;
        constexpr int I_LAYER = I_IN1 + I_IN2 + I_BR + I_OUT + I_MOE;
        for (int it = gw; it < NLAYER * I_LAYER; it += NGW) {
            const int l = it / I_LAYER; int r = it % I_LAYER;
            if (r < I_IN1) { const int kb = r / 112, nb = r % 112;
                transpose_item(P.w_in + ((size_t)l * DM + kb * 64) * PIN + nb * 64, PIN, (bf16*)(ws + WS_WIN) + ((size_t)l * NPROJ + nb * 64) * DM + kb * 64, scr, lane); continue; }
            r -= I_IN1;
            if (r < I_IN2) { const int kb = r / 32, nb = r % 32;
                transpose_item(P.w_in + ((size_t)l * DM + kb * 64) * PIN + 7184 + nb * 64, PIN, (bf16*)(ws + WS_WIN) + ((size_t)l * NPROJ + 7168 + nb * 64) * DM + kb * 64, scr, lane); continue; }
            r -= I_IN2;
            if (r < I_BR) { const int half = r / 256, q = r % 256, kb = q / 16, nb = q % 16;
                transpose_item(P.w_branch + ((size_t)l * 2048 + half * 1024 + kb * 64) * DM + nb * 64, DM, (bf16*)(ws + WS_WBR) + (((size_t)l * 2 + half) * DM + nb * 64) * DM + kb * 64, scr, lane); continue; }
            r -= I_BR;
            if (r < I_OUT) { const int kb = r / 16, nb = r % 16;
                transpose_item(P.w_out + ((size_t)l * DM + kb * 64) * DM + nb * 64, DM, (bf16*)(ws + WS_WOUT) + ((size_t)l * DM + nb * 64) * DM + kb * 64, scr, lane); continue; }
            r -= I_OUT;
            { const int e = r / I_EXP, q = r % I_EXP, which = q / 256, q2 = q % 256, kb = q2 / 16, nb = q2 % 16;
              const size_t le = (size_t)l * NEXP + e;
              if (which == 0) transpose_item(P.w_gate + (le * DM + kb * 64) * DM + nb * 64, DM, (bf16*)(ws + WS_WGU) + (le * 2048 + 256 * (nb >> 1) + 64 * (nb & 1)) * DM + kb * 64, scr, lane);
              else if (which == 1) transpose_item(P.w_up + (le * DM + kb * 64) * DM + nb * 64, DM, (bf16*)(ws + WS_WGU) + (le * 2048 + 256 * (nb >> 1) + 128 + 64 * (nb & 1)) * DM + kb * 64, scr, lane);
              else transpose_item(P.w_down + (le * DM + kb * 64) * DM + nb * 64, DM, (bf16*)(ws + WS_WD) + (le * DM + nb * 64) * DM + kb * 64, scr, lane); }
        }
    }
}

struct RowV { f32x4 v[4]; };
__device__ __forceinline__ RowV ld_row(const float* p, int lane) { RowV r; const GAS f32x4* q = (const GAS f32x4*)p + lane;
#pragma unroll
    for (int j = 0; j < 4; ++j) r.v[j] = q[64 * j];
    return r; }
__device__ __forceinline__ void st_row(float* p, int lane, const RowV& r) { GAS f32x4* q = (GAS f32x4*)p + lane;
#pragma unroll
    for (int j = 0; j < 4; ++j) q[64 * j] = r.v[j]; }
__device__ __forceinline__ void st_row_bf16(bf16* p, int lane, const RowV& r) { GAS u32x2* q = (GAS u32x2*)p + lane;
#pragma unroll
    for (int j = 0; j < 4; ++j) { u32x2 w; w.x = pkbf(r.v[j].x, r.v[j].y); w.y = pkbf(r.v[j].z, r.v[j].w); q[64 * j] = w; } }
__device__ __forceinline__ void st_row_lds(LAS float* p, int lane, const RowV& r) { LAS f32x4* q = (LAS f32x4*)p + lane;
#pragma unroll
    for (int j = 0; j < 4; ++j) q[64 * j] = r.v[j]; }
__device__ __forceinline__ void ln_stats(const RowV& r, float& mean, float& rstd, float eps) {
    float s = 0.f;
#pragma unroll
    for (int j = 0; j < 4; ++j) s += (r.v[j].x + r.v[j].y) + (r.v[j].z + r.v[j].w);
    mean = wave_sum(s) * (1.0f / DM); float q = 0.f;
#pragma unroll
    for (int j = 0; j < 4; ++j) { const f32x4 d = r.v[j] - mean; q += (d.x * d.x + d.y * d.y) + (d.z * d.z + d.w * d.w); }
    rstd = 1.0f / sqrtf(wave_sum(q) * (1.0f / DM) + eps);
}
__device__ __forceinline__ float log_sigmoid(float x) { return fminf(x, 0.f) - log1pf(expf(-fabsf(x))); }
__device__ __forceinline__ void af_dots(const LAS float* stage, const float* __restrict__ waf, const float* __restrict__ fbias, float* LS, int row0, int lane) {
    const int r = lane >> 4, j = lane & 15; const LAS float* hs = stage + r * DM; const float* wp = waf + j; float acc = 0.f;
#pragma unroll 4
    for (int k = 0; k < DM; k += 4) { const f32x4 hv = *(const LAS f32x4*)(hs + k);
        acc += hv.x * wp[(size_t)k * PIN]; acc += hv.y * wp[(size_t)(k + 1) * PIN]; acc += hv.z * wp[(size_t)(k + 2) * PIN]; acc += hv.w * wp[(size_t)(k + 3) * PIN]; }
    LS[(size_t)(row0 + r) * 16 + j] = log_sigmoid(acc + fbias[j]);
}

__device__ __forceinline__ void phase_a0(const Ptrs& P, LAS unsigned char* lds, int G) {
    int tid_ = threadIdx.x; asm volatile("" : "+v"(tid_)); const int tid = tid_, lane = tid & 63, wave = __builtin_amdgcn_readfirstlane(tid >> 6); (void)tid;
    unsigned char* ws = P.ws; const int RPW = NTOK / (G * 8); const int m0 = (blockIdx.x * 8 + wave) * RPW, b = m0 / SEQL;
    const float* MOD = (const float*)(ws + WS_MOD) + (size_t)(0 * NB + b) * 6144;
    const RowV sh1 = ld_row(MOD, lane), sc1 = ld_row(MOD + DM, lane);
    LAS float* stage = (LAS float*)(lds + wave * 16384);
    for (int rg = 0; rg < RPW / 4; ++rg) {
        for (int r = 0; r < 4; ++r) { const int m = m0 + rg * 4 + r; RowV xv = ld_row(P.x + (size_t)m * DM, lane);
#pragma unroll
            for (int j = 0; j < 4; ++j) xv.v[j] = xv.v[j] * (sc1.v[j] + 1.0f) + sh1.v[j];
            st_row_bf16((bf16*)(ws + WS_HB) + (size_t)m * DM, lane, xv); st_row_lds(stage + r * DM, lane, xv); }
        LDS_WAIT(); asm volatile("" ::: "memory");
        af_dots(stage, P.w_in + 7168, P.fox_f_bias, (float*)(ws + WS_LS), m0 + rg * 4, lane);
        LDS_WAIT(); asm volatile("" ::: "memory");
    }
}

__device__ __forceinline__ void phase_f(const Ptrs& P, LAS unsigned char* lds, int l, const float* xcur, int G) {
    int tid_ = threadIdx.x; asm volatile("" : "+v"(tid_)); const int tid = tid_, lane = tid & 63, wave = __builtin_amdgcn_readfirstlane(tid >> 6);
    unsigned char* ws = P.ws; const int RPW = NTOK / (G * 8); const int m0 = (blockIdx.x * 8 + wave) * RPW, b = m0 / SEQL;
    LAS int* lcnt = (LAS int*)(lds + T_LCNT); LAS int* gbase = (LAS int*)(lds + T_GBASE);
    LAS int* aE = (LAS int*)(lds + T_ASG + wave * 512); LAS float* aW = (LAS float*)(lds + T_ASG + wave * 512 + 256);
    if (tid < 32) lcnt[tid] = 0;
    __syncthreads();
    {
        const float* MOD = (const float*)(ws + WS_MOD) + (size_t)(l * NB + b) * 6144;
        const RowV g1 = ld_row(MOD + 2 * DM, lane), sh2 = ld_row(MOD + 3 * DM, lane), sc2 = ld_row(MOD + 4 * DM, lane);
        const RowV lng = ld_row(P.ln1_g + (size_t)l * DM, lane), lnb = ld_row(P.ln1_b + (size_t)l * DM, lane);
        LAS float* stage = (LAS float*)(lds + wave * 16384);
        const float* wr = P.w_router + (size_t)l * DM * NEXP; const float* br = P.b_router + (size_t)l * NEXP;
        const float* Y = (const float*)(ws + WS_Y);
        for (int rg = 0; rg < RPW / 4; ++rg) {
            for (int r = 0; r < 4; ++r) { const int m = m0 + rg * 4 + r;
                RowV xv = ld_row(xcur + (size_t)m * DM, lane); const RowV yv = ld_row(Y + (size_t)m * DM, lane);
#pragma unroll
                for (int j = 0; j < 4; ++j) xv.v[j] = xv.v[j] * DN_ALPHA + (g1.v[j] + 1.0f) * yv.v[j];
                float mean, rstd; ln_stats(xv, mean, rstd, 1e-5f);
#pragma unroll
                for (int j = 0; j < 4; ++j) xv.v[j] = (xv.v[j] - mean) * rstd * lng.v[j] + lnb.v[j];
                st_row((float*)(ws + WS_X1) + (size_t)m * DM, lane, xv);
#pragma unroll
                for (int j = 0; j < 4; ++j) xv.v[j] = xv.v[j] * (sc2.v[j] + 1.0f) + sh2.v[j];
                st_row_bf16((bf16*)(ws + WS_HB) + (size_t)m * DM, lane, xv); st_row_lds(stage + r * DM, lane, xv); }
            LDS_WAIT(); asm volatile("" ::: "memory");
            const int r = lane >> 4, eg = lane & 15; const LAS float* hs = stage + r * DM; const float* wp = wr + 2 * eg; float a0 = 0.f, a1 = 0.f;
#pragma unroll 4
            for (int k = 0; k < DM; k += 4) { const f32x4 hv = *(const LAS f32x4*)(hs + k);
                const f32x2 w0 = *(const GAS f32x2*)(wp + (size_t)k * NEXP), w1 = *(const GAS f32x2*)(wp + (size_t)(k + 1) * NEXP), w2 = *(const GAS f32x2*)(wp + (size_t)(k + 2) * NEXP), w3 = *(const GAS f32x2*)(wp + (size_t)(k + 3) * NEXP);
                a0 += hv.x * w0.x; a1 += hv.x * w0.y; a0 += hv.y * w1.x; a1 += hv.y * w1.y; a0 += hv.z * w2.x; a1 += hv.z * w2.y; a0 += hv.w * w3.x; a1 += hv.w * w3.y; }
            float v0 = a0 + br[2 * eg], v1 = a1 + br[2 * eg + 1]; const int i0 = 2 * eg, i1 = 2 * eg + 1;
            float tv[4]; int ti[4];
#pragma unroll
            for (int k = 0; k < 4; ++k) {
                float bv = v0 >= v1 ? v0 : v1; int bi = v0 >= v1 ? i0 : i1;
#pragma unroll
                for (int o = 1; o < 16; o <<= 1) { const float ov = __shfl_xor(bv, o); const int oi = __shfl_xor(bi, o); if (ov > bv || (ov == bv && oi < bi)) { bv = ov; bi = oi; } }
                tv[k] = bv; ti[k] = bi; if (bi == i0) v0 = -INFINITY; if (bi == i1) v1 = -INFINITY;
            }
            const float e1 = expf(tv[1] - tv[0]), e2 = expf(tv[2] - tv[0]), e3 = expf(tv[3] - tv[0]), inv = 1.0f / (1.0f + e1 + e2 + e3);
            const int slot = (rg * 4 + r) * 4;
            if (eg == 0) { aE[slot] = ti[0]; aW[slot] = inv; } else if (eg == 1) { aE[slot + 1] = ti[1]; aW[slot + 1] = e1 * inv; }
            else if (eg == 2) { aE[slot + 2] = ti[2]; aW[slot + 2] = e2 * inv; } else if (eg == 3) { aE[slot + 3] = ti[3]; aW[slot + 3] = e3 * inv; }
            LDS_WAIT(); asm volatile("" ::: "memory");
        }
    }
    const int nasg = RPW * 4; int e = 0, lpos = 0; float w = 0.f;
    if (lane < nasg) { e = aE[lane]; w = aW[lane]; lpos = __hip_atomic_fetch_add(lcnt + e, 1, __ATOMIC_RELAXED, __HIP_MEMORY_SCOPE_WORKGROUP); }
    __syncthreads();
    if (tid < 32) { const int n = lcnt[tid]; gbase[tid] = n ? (int)__hip_atomic_fetch_add((unsigned*)(ws + WS_CTL) + CW_CNT + (l * NEXP + tid) * 64, (unsigned)n, __ATOMIC_RELAXED, __HIP_MEMORY_SCOPE_AGENT) : 0; }
    __syncthreads();
    if (lane < nasg) { const int pos = gbase[e] + lpos, tok = m0 + (lane >> 2);
        ((int*)(ws + WS_LIST))[(size_t)e * NTOK + pos] = tok; ((int*)(ws + WS_ASGE))[(size_t)tok * 4 + (lane & 3)] = (e << 16) | pos; ((float*)(ws + WS_ASGW))[(size_t)tok * 4 + (lane & 3)] = w; }
}

__device__ __forceinline__ int moe_tables(const Ptrs& P, LAS unsigned char* lds, int l) {
    int tid_ = threadIdx.x; asm volatile("" : "+v"(tid_)); const int tid = tid_;
    LAS int* tbase = (LAS int*)(lds + T_TBASE); LAS int* cnt = (LAS int*)(lds + T_CNT); LAS unsigned char* rt2e = (LAS unsigned char*)(lds + T_RT2E);
    __syncthreads();
    if (tid < 32) cnt[tid] = (int)__hip_atomic_load((unsigned*)(P.ws + WS_CTL) + CW_CNT + (l * NEXP + tid) * 64, __ATOMIC_RELAXED, __HIP_MEMORY_SCOPE_AGENT);
    __syncthreads();
    if (tid == 0) { int s = 0; for (int e = 0; e < NEXP; ++e) { tbase[e] = s; s += (cnt[e] + 255) >> 8; } tbase[NEXP] = s; }
    __syncthreads();
    if (tid < 32) { for (int rt = tbase[tid]; rt < tbase[tid + 1]; ++rt) rt2e[rt] = (unsigned char)tid; }
    __syncthreads();
    return tbase[NEXP];
}

__device__ __forceinline__ void phase_j(const Ptrs& P, LAS unsigned char* lds, int l, int G) {
    int tid_ = threadIdx.x; asm volatile("" : "+v"(tid_)); const int tid = tid_, lane = tid & 63, wave = __builtin_amdgcn_readfirstlane(tid >> 6); (void)tid;
    unsigned char* ws = P.ws; const int RPW = NTOK / (G * 8); const int m0 = (blockIdx.x * 8 + wave) * RPW, b = m0 / SEQL;
    const LAS int* tbase = (const LAS int*)(lds + T_TBASE);
    const float* MOD = (const float*)(ws + WS_MOD) + (size_t)(l * NB + b) * 6144;
    const RowV g2 = ld_row(MOD + 5 * DM, lane);
    const RowV lng = ld_row(P.ln2_g + (size_t)l * DM, lane), lnb = ld_row(P.ln2_b + (size_t)l * DM, lane);
    const bool more = l + 1 < NLAYER;
    RowV sh1, sc1;
    { const float* MODN = (const float*)(ws + WS_MOD) + (size_t)((more ? l + 1 : l) * NB + b) * 6144; sh1 = ld_row(MODN, lane); sc1 = ld_row(MODN + DM, lane); }
    LAS float* stage = (LAS float*)(lds + wave * 16384);
    const bf16* YR = (const bf16*)(ws + WS_YR); const float* X1 = (const float*)(ws + WS_X1);
    for (int rg = 0; rg < RPW / 4; ++rg) {
        for (int r = 0; r < 4; ++r) { const int m = m0 + rg * 4 + r;
            const v4u ae = *(const GAS v4u*)((const unsigned*)(ws + WS_ASGE) + (size_t)m * 4); const f32x4 aw = *(const GAS f32x4*)((const float*)(ws + WS_ASGW) + (size_t)m * 4);
            RowV y;
#pragma unroll
            for (int j = 0; j < 4; ++j) y.v[j] = (f32x4){0.f, 0.f, 0.f, 0.f};
#pragma unroll
            for (int k = 0; k < 4; ++k) { const unsigned a = ae[k]; const int e = (int)(a >> 16), pos = (int)(a & 0xffffu); const size_t slot = (size_t)tbase[e] * 256 + pos; const float wk = aw[k];
                const GAS u32x2* q = (const GAS u32x2*)(YR + slot * DM) + lane;
#pragma unroll
                for (int j = 0; j < 4; ++j) { const u32x2 t = q[64 * j]; y.v[j].x += wk * pg8::bf_lo(t.x); y.v[j].y += wk * pg8::bf_hi(t.x); y.v[j].z += wk * pg8::bf_lo(t.y); y.v[j].w += wk * pg8::bf_hi(t.y); } }
            RowV xv = ld_row(X1 + (size_t)m * DM, lane);
#pragma unroll
            for (int j = 0; j < 4; ++j) xv.v[j] = xv.v[j] * DN_ALPHA + (g2.v[j] + 1.0f) * y.v[j];
            float mean, rstd; ln_stats(xv, mean, rstd, 1e-5f);
#pragma unroll
            for (int j = 0; j < 4; ++j) xv.v[j] = (xv.v[j] - mean) * rstd * lng.v[j] + lnb.v[j];
            st_row(P.out + (size_t)m * DM, lane, xv);
            if (more) {
#pragma unroll
                for (int j = 0; j < 4; ++j) xv.v[j] = xv.v[j] * (sc1.v[j] + 1.0f) + sh1.v[j];
                st_row_bf16((bf16*)(ws + WS_HB) + (size_t)m * DM, lane, xv); st_row_lds(stage + r * DM, lane, xv); }
        }
        if (more) {
            LDS_WAIT(); asm volatile("" ::: "memory");
            af_dots(stage, P.w_in + (size_t)(l + 1) * DM * PIN + 7168, P.fox_f_bias + (l + 1) * 16, (float*)(ws + WS_LS), m0 + rg * 4, lane);
            LDS_WAIT(); asm volatile("" ::: "memory");
        }
    }
}

__device__ __forceinline__ void fscan(const Ptrs& P, LAS unsigned char* lds) {
    int tid_ = threadIdx.x; asm volatile("" : "+v"(tid_)); const int tid = tid_, lane = tid & 63, wave = __builtin_amdgcn_readfirstlane(tid >> 6);
    const int bh = blockIdx.x, b = bh >> 4, h = bh & 15;
    const float* LS = (const float*)(P.ws + WS_LS) + ((size_t)b * SEQL + 8 * tid) * 16 + h; float* FP = (float*)(P.ws + WS_FP) + (size_t)bh * SEQL + 8 * tid;
    LAS float* wt = (LAS float*)(lds);
    float v[8];
#pragma unroll
    for (int j = 0; j < 8; ++j) v[j] = LS[j * 16];
#pragma unroll
    for (int j = 1; j < 8; ++j) v[j] += v[j - 1];
    float inc = v[7];
#pragma unroll
    for (int o = 1; o < 64; o <<= 1) { const float t = __shfl_up(inc, o); if (lane >= o) inc += t; }
    if (lane == 63) wt[wave] = inc;
    __syncthreads();
    float off = inc - v[7];
    for (int w = 0; w < wave; ++w) off += wt[w];
    *(GAS f32x4*)(FP) = (f32x4){(off + v[0]) * LOG2E, (off + v[1]) * LOG2E, (off + v[2]) * LOG2E, (off + v[3]) * LOG2E};
    *(GAS f32x4*)(FP + 4) = (f32x4){(off + v[4]) * LOG2E, (off + v[5]) * LOG2E, (off + v[6]) * LOG2E, (off + v[7]) * LOG2E};
    __syncthreads();
}

namespace hg {
constexpr int L_QP = 0, L_KP = 16384, L_IV = 32768, L_SP = 49152, L_PM = 81920, L_O = 91136, L_TOT = 123904, L_EBM = 128000, L_EBL = 128512;
constexpr int PM_PITCH = 144;
static_assert(L_EBL + 512 <= RING_BYTES, "HGRN LDS map");
__device__ __forceinline__ int off_b(int row, int ch) { return 256 * row + 16 * (ch ^ (((row & 3) << 2) | ((row >> 2) & 3))); }
__device__ __forceinline__ bf16x8 row_frag(const LAS unsigned char* img, int row0, int s, int lane) { return *(const LAS bf16x8*)(img + off_b(row0 + (lane & 31), 2 * s + (lane >> 5))); }
__device__ __forceinline__ bf16x8 tr_frag(const LAS unsigned char* img, int c, int ks, int lane) {
    const int hh = lane >> 5, blk = (lane >> 4) & 1, q = (lane & 15) >> 2, p = lane & 3;
    const LAS unsigned char* a0 = img + off_b(16 * ks + 8 * hh + q, 4 * c + 2 * blk + (p >> 1)) + 8 * (p & 1);
    const LAS unsigned char* a1 = img + off_b(16 * ks + 8 * hh + 4 + q, 4 * c + 2 * blk + (p >> 1)) + 8 * (p & 1);
    const v4i16_t lo = __builtin_amdgcn_ds_read_tr16_b64_v4i16((LAS v4i16_t*)a0), hi = __builtin_amdgcn_ds_read_tr16_b64_v4i16((LAS v4i16_t*)a1);
    return (bf16x8){lo[0], lo[1], lo[2], lo[3], hi[0], hi[1], hi[2], hi[3]};
}
#define HG_MFMA(a, b, c) __builtin_amdgcn_mfma_f32_32x32x16_bf16((a), (b), (c), 0, 0, 0)

__device__ __forceinline__ void hgrn_unit(int b, int h, const bf16* __restrict__ QS, const float* __restrict__ LF, const bf16* __restrict__ KK, const bf16* __restrict__ IV, const bf16* __restrict__ SG,
                                          const float* __restrict__ nw, bf16* __restrict__ OA, LAS unsigned char* lds) {
    int tid_ = threadIdx.x; asm volatile("" : "+v"(tid_));
    const int tid = tid_, lane = tid & 63, wid = __builtin_amdgcn_readfirstlane(tid >> 6);
    const int r = lane & 31, hh = lane >> 5;
    const size_t colb = (size_t)h * 128;
    const int ct = tid >> 3, cpart = tid & 7;
    float nwv[16];
#pragma unroll
    for (int i = 0; i < 16; ++i) nwv[i] = nw[16 * cpart + i];
    f32x16 Sacc[2];
#pragma unroll
    for (int i = 0; i < 16; ++i) { Sacc[0][i] = 0.f; Sacc[1][i] = 0.f; }
    f32x2 lf2[8]; unsigned q2[8], k2[8]; v4u ivr[2], sgr[2];
#define HG_LOAD(c) do { const size_t rb_ = (size_t)b * SEQL + (size_t)(c) * 64; \
        _Pragma("unroll") for (int j = 0; j < 8; ++j) { const size_t o_ = (rb_ + 8 * wid + j) * DM + colb + 2 * lane; \
            lf2[j] = *(const GAS f32x2*)(LF + o_); q2[j] = *(const GAS unsigned*)(QS + o_); k2[j] = *(const GAS unsigned*)(KK + o_); } \
        _Pragma("unroll") for (int i = 0; i < 2; ++i) { const int idx_ = tid + 512 * i; ivr[i] = *(const GAS v4u*)(IV + (rb_ + (idx_ >> 4)) * DM + colb + 8 * (idx_ & 15)); } \
        _Pragma("unroll") for (int i = 0; i < 2; ++i) sgr[i] = *(const GAS v4u*)(SG + (rb_ + ct) * DM + colb + 16 * cpart + 8 * i); } while (0)
    HG_LOAD(0);
    for (int c = 0; c < SEQL / 64; ++c) {
        float c0[8], c1[8];
        c0[0] = lf2[0].x; c1[0] = lf2[0].y;
#pragma unroll
        for (int j = 1; j < 8; ++j) { c0[j] = c0[j - 1] + lf2[j].x; c1[j] = c1[j - 1] + lf2[j].y; }
        *(LAS f32x2*)(lds + L_TOT + (wid * 128 + 2 * lane) * 4) = (f32x2){c0[7], c1[7]};
        LDS_BARRIER();
        float p0 = 0.f, p1 = 0.f, R0 = 0.f, R1 = 0.f, T0 = 0.f, T1 = 0.f;
#pragma unroll
        for (int w = 0; w < 8; ++w) { const f32x2 t = *(const LAS f32x2*)(lds + L_TOT + (w * 128 + 2 * lane) * 4);
            if (w < wid) { p0 += t.x; p1 += t.y; } if (w < 4) { R0 += t.x; R1 += t.y; } T0 += t.x; T1 += t.y; }
#pragma unroll
        for (int j = 0; j < 8; ++j) {
            const float b0 = p0 + c0[j], b1 = p1 + c1[j];
            const float eq0 = __expf(fminf(b0 - R0, 80.f)), eq1 = __expf(fminf(b1 - R1, 80.f)), ek0 = __expf(fminf(R0 - b0, 80.f)), ek1 = __expf(fminf(R1 - b1, 80.f));
            const unsigned qw = pkbf(pg8::bf_lo(q2[j]) * eq0, pg8::bf_hi(q2[j]) * eq1), kw = pkbf(pg8::bf_lo(k2[j]) * ek0, pg8::bf_hi(k2[j]) * ek1);
            const int o_ = off_b(8 * wid + j, lane >> 2) + 4 * (lane & 3);
            *(LAS unsigned*)(lds + L_QP + o_) = qw; *(LAS unsigned*)(lds + L_KP + o_) = kw;
        }
        if (wid == 0) { *(LAS f32x2*)(lds + L_EBM + 8 * lane) = (f32x2){__expf(R0), __expf(R1)}; *(LAS f32x2*)(lds + L_EBL + 8 * lane) = (f32x2){__expf(T0 - R0), __expf(T1 - R1)}; }
#pragma unroll
        for (int i = 0; i < 2; ++i) { const int idx_ = tid + 512 * i; *(LAS v4u*)(lds + L_IV + off_b(idx_ >> 4, idx_ & 15)) = ivr[i]; }
        const v4u sg0 = sgr[0], sg1 = sgr[1];
        if (c + 1 < SEQL / 64) HG_LOAD(c + 1);
        LDS_BARRIER();
        {
            const int db = wid >> 1, vb0 = 2 * (wid & 1);
            float em[16], el[16];
#pragma unroll
            for (int g = 0; g < 4; ++g) { const f32x4 a = *(const LAS f32x4*)(lds + L_EBM + (32 * db + 8 * g + 4 * hh) * 4), e2 = *(const LAS f32x4*)(lds + L_EBL + (32 * db + 8 * g + 4 * hh) * 4);
                em[4 * g] = a.x; em[4 * g + 1] = a.y; em[4 * g + 2] = a.z; em[4 * g + 3] = a.w; el[4 * g] = e2.x; el[4 * g + 1] = e2.y; el[4 * g + 2] = e2.z; el[4 * g + 3] = e2.w; }
#pragma unroll
            for (int tl = 0; tl < 2; ++tl) { const int vb = vb0 + tl;
#pragma unroll
                for (int i = 0; i < 16; ++i) Sacc[tl][i] *= em[i];
#pragma unroll
                for (int g = 0; g < 4; ++g) { u32x2 w; w.x = pkbf(Sacc[tl][4 * g], Sacc[tl][4 * g + 1]); w.y = pkbf(Sacc[tl][4 * g + 2], Sacc[tl][4 * g + 3]);
                    *(LAS u32x2*)(lds + L_SP + off_b(32 * vb + r, 4 * db + g) + 8 * hh) = w; } }
            if (wid < 3) {
                const int tb = wid > 0 ? 1 : 0, sb = wid > 1 ? 1 : 0;
                f32x16 sc;
#pragma unroll
                for (int i = 0; i < 16; ++i) sc[i] = 0.f;
#pragma unroll
                for (int s = 0; s < 8; ++s) { const bf16x8 a = row_frag(lds + L_KP, 32 * sb, s, lane), bq = row_frag(lds + L_QP, 32 * tb, s, lane); sc = HG_MFMA(a, bq, sc); }
                const int t = 32 * tb + r;
#pragma unroll
                for (int g = 0; g < 4; ++g) { float x[4];
#pragma unroll
                    for (int j = 0; j < 4; ++j) { const int s_ = 32 * sb + 8 * g + 4 * hh + j; x[j] = s_ <= t ? sc[4 * g + j] : 0.f; }
                    u32x2 w; w.x = pkbf(x[0], x[1]); w.y = pkbf(x[2], x[3]);
                    *(LAS u32x2*)(lds + L_PM + t * PM_PITCH + (32 * sb + 8 * g + 4 * hh) * 2) = w; }
            }
#pragma unroll
            for (int ks = 0; ks < 4; ++ks) { const bf16x8 a = tr_frag(lds + L_KP, db, ks, lane);
#pragma unroll
                for (int tl = 0; tl < 2; ++tl) { const bf16x8 bi = tr_frag(lds + L_IV, vb0 + tl, ks, lane); Sacc[tl] = HG_MFMA(a, bi, Sacc[tl]); } }
#pragma unroll
            for (int tl = 0; tl < 2; ++tl)
#pragma unroll
                for (int i = 0; i < 16; ++i) Sacc[tl][i] *= el[i];
        }
        LDS_BARRIER();
        {
            const int tb = wid >> 2, vb = wid & 3;
            f32x16 o;
#pragma unroll
            for (int i = 0; i < 16; ++i) o[i] = 0.f;
#pragma unroll
            for (int ks = 0; ks < 4; ++ks) { if (ks < 2 || tb == 1) {
                const bf16x8 a = *(const LAS bf16x8*)(lds + L_PM + (32 * tb + r) * PM_PITCH + (16 * ks + 8 * hh) * 2); const bf16x8 bi = tr_frag(lds + L_IV, vb, ks, lane); o = HG_MFMA(a, bi, o); } }
#pragma unroll
            for (int s = 0; s < 8; ++s) { const bf16x8 a = row_frag(lds + L_QP, 32 * tb, s, lane), bs = row_frag(lds + L_SP, 32 * vb, s, lane); o = HG_MFMA(a, bs, o); }
#pragma unroll
            for (int i = 0; i < 16; ++i) { const int t = 32 * tb + (i & 3) + 8 * (i >> 2) + 4 * hh; *(LAS float*)(lds + L_O + (t * 128 + 32 * vb + r) * 4) = o[i]; }
        }
        LDS_BARRIER();
        {
            float ov[16];
#pragma unroll
            for (int g = 0; g < 4; ++g) { const f32x4 a = *(const LAS f32x4*)(lds + L_O + (ct * 128 + 16 * cpart + 4 * g) * 4); ov[4 * g] = a.x; ov[4 * g + 1] = a.y; ov[4 * g + 2] = a.z; ov[4 * g + 3] = a.w; }
            float ss = 0.f;
#pragma unroll
            for (int i = 0; i < 16; ++i) ss += ov[i] * ov[i];
            ss += __shfl_xor(ss, 1); ss += __shfl_xor(ss, 2); ss += __shfl_xor(ss, 4);
            const float rstd = 1.0f / sqrtf(ss * (1.0f / 128.0f) + 1e-6f);
            const unsigned gs[8] = {sg0.x, sg0.y, sg0.z, sg0.w, sg1.x, sg1.y, sg1.z, sg1.w};
            unsigned ow[8];
#pragma unroll
            for (int i = 0; i < 8; ++i) ow[i] = pkbf(ov[2 * i] * rstd * nwv[2 * i] * pg8::bf_lo(gs[i]), ov[2 * i + 1] * rstd * nwv[2 * i + 1] * pg8::bf_hi(gs[i]));
            bf16* op = OA + ((size_t)b * SEQL + (size_t)c * 64 + ct) * DM + colb + 16 * cpart;
            *(GAS v4u*)(op) = (v4u){ow[0], ow[1], ow[2], ow[3]}; *(GAS v4u*)(op + 8) = (v4u){ow[4], ow[5], ow[6], ow[7]};
        }
    }
#undef HG_LOAD
    LDS_BARRIER();
}
}

#ifndef PH_SKIP
#define PH_SKIP 0u
#endif
struct Args { Ptrs p; };
__global__ void __launch_bounds__(512, 2) mk_fwd(Args args) {
    extern __shared__ __attribute__((aligned(16))) unsigned char lds_raw[];
    LAS unsigned char* lds = (LAS unsigned char*)lds_raw;
    const Ptrs& P = args.p;
    unsigned char* ws = P.ws;
    const int tid = threadIdx.x, G = gridDim.x;
    volatile LAS unsigned* MISC = (volatile LAS unsigned*)(lds + T_MISC);
    gu32* ctl = (gu32*)(ws + WS_CTL);
    for (int u = tid; u < (LDS_BYTES - TAB_OFF) / 4; u += 512) ((LAS unsigned*)(lds + TAB_OFF))[u] = 0u;
    __syncthreads();
    (void)xcd_barrier_post((unsigned*)(ws + WS_CTL) + CW_BAR, MISC + 8);
#define GRID_BAR() do { XcdBarrier bar_; bar_.bar = (unsigned*)(P.ws + WS_CTL) + CW_BAR; bar_.x = xb_xcc_id(); bar_.st = (volatile LAS unsigned*)(lds + T_MISC) + 8; xcd_barrier(bar_); } while (0)
#define RUN(k) (((PH_SKIP >> (k)) & 1u) == 0u)

    if (RUN(0)) p0_prologue(P, lds, G);
    GRID_BAR();
    if (RUN(1)) phase_a0(P, lds, G);
    GRID_BAR();

    for (int l = 0; l < NLAYER; ++l) {
        bf16* PROJ = (bf16*)(ws + WS_PROJ);
        if (RUN(2)) {
            if (blockIdx.x < 128) fscan(P, lds);
            pg8::Gemm g{(const pg8::bf16_t*)(ws + WS_HB), (const pg8::bf16_t*)(ws + WS_WIN) + (size_t)l * NPROJ * DM, NTOK, NPROJ, DM};
            pg8::StaticOrder S; S.init(NTOK, NPROJ, G, (int)blockIdx.x);
            pg8::EpiInProj E{(pg8::bf16_t*)PROJ, (float*)(ws + WS_LF), (const float*)(ws + WS_LB) + (size_t)l * DM, 0.125f * LOG2E};
            pg8::gemm_phase<pg8::EpiInProj, pg8::StaticOrder, true, true, false>(lds + RING_OFF, g, S, E);
        }
        GRID_BAR();
        if (RUN(3)) {
#ifndef NO_HGRN
            for (;;) {
                __syncthreads();
                if (tid == 0) MISC[0] = __hip_atomic_fetch_add(ctl + CW_WQ + 64 * l, 1u, RLX_AGENT);
                __syncthreads();
                const int item = __builtin_amdgcn_readfirstlane((int)MISC[0]);
                if (item >= 64) break;
                hg::hgrn_unit(item >> 3, item & 7, PROJ + 0 * (size_t)NTOK * DM, (const float*)(ws + WS_LF), PROJ + 1 * (size_t)NTOK * DM, PROJ + 2 * (size_t)NTOK * DM, PROJ + 3 * (size_t)NTOK * DM,
                              P.hg_norm_w + (size_t)l * 128, (bf16*)(ws + WS_OAB), lds + RING_OFF);
            }
#endif
#ifndef NO_ATTN
            for (;;) {
                __syncthreads();
                if (tid == 0) MISC[0] = __hip_atomic_fetch_add(ctl + CW_WQ + 64 * (NLAYER + l), 1u, RLX_AGENT);
                __syncthreads();
                const int j = __builtin_amdgcn_readfirstlane((int)MISC[0]);
                if (j >= 2048) break;
                const int qb = 15 - (j >> 7), bh = j & 127;
                attn_body::attn_unit<8>(bh >> 4, bh & 15, qb, (const attn_body::bf16*)(PROJ + 4 * (size_t)NTOK * DM), (const attn_body::bf16*)(PROJ + 5 * (size_t)NTOK * DM),
                                        (const attn_body::bf16*)(PROJ + 6 * (size_t)NTOK * DM), (attn_body::bf16*)(ws + WS_OAB + SZB), (const float*)(ws + WS_FP), (char*)lds_raw + RING_OFF);
            }
#endif
        }
        GRID_BAR();
        if (RUN(4)) {
            pg8::Gemm g{(const pg8::bf16_t*)(ws + WS_OAB), (const pg8::bf16_t*)(ws + WS_WBR) + (size_t)l * 2 * DM * DM, 2 * NTOK, 2 * DM, DM};
            pg8::PairOrder S; S.init(G, (int)blockIdx.x);
            pg8::EpiBranch E{(const pg8::bf16_t*)(PROJ + 7 * (size_t)NTOK * DM), (const pg8::bf16_t*)(PROJ + 8 * (size_t)NTOK * DM), (pg8::bf16_t*)(ws + WS_MG)};
            pg8::gemm_phase<pg8::EpiBranch, pg8::PairOrder, true, true, false>(lds + RING_OFF, g, S, E);
        }
        GRID_BAR();
        if (RUN(5)) {
            pg8::Gemm g{(const pg8::bf16_t*)(ws + WS_MG), (const pg8::bf16_t*)(ws + WS_WOUT) + (size_t)l * DM * DM, NTOK, DM, DM};
            pg8::StaticOrder S; S.init(NTOK, DM, G, (int)blockIdx.x);
            pg8::EpiF32 E{(float*)(ws + WS_Y), DM};
            pg8::gemm_phase<pg8::EpiF32, pg8::StaticOrder, true, true, false>(lds + RING_OFF, g, S, E);
        }
        GRID_BAR();
        if (RUN(6)) phase_f(P, lds, l, l == 0 ? P.x : P.out, G);
        GRID_BAR();
        if (RUN(7)) {
            const int ntile = moe_tables(P, lds, l);
            pg8::Gemm g{(const pg8::bf16_t*)(ws + WS_HB), (const pg8::bf16_t*)(ws + WS_WGU) + (size_t)l * NEXP * 2048 * DM, 0, 0, DM};
            pg8::MoeOrder S{G, (int)blockIdx.x, ntile, 8, (const LAS unsigned char*)(lds + T_RT2E), (const LAS int*)(lds + T_TBASE), (const LAS int*)(lds + T_CNT), (const int*)(ws + WS_LIST)};
            pg8::EpiMoe1 E{(pg8::bf16_t*)(ws + WS_ACT), P.b_gate + (size_t)l * NEXP * DM, P.b_up + (size_t)l * NEXP * DM};
            pg8::gemm_phase<pg8::EpiMoe1, pg8::MoeOrder, true, true, true>(lds + RING_OFF, g, S, E);
        }
        GRID_BAR();
        if (RUN(8)) {
            const int ntile = moe_tables(P, lds, l);
            pg8::Gemm g{(const pg8::bf16_t*)(ws + WS_ACT), (const pg8::bf16_t*)(ws + WS_WD) + (size_t)l * NEXP * DM * DM, 0, 0, DM};
            pg8::MoeOrder S{G, (int)blockIdx.x, ntile, 4, (const LAS unsigned char*)(lds + T_RT2E), (const LAS int*)(lds + T_TBASE), (const LAS int*)(lds + T_CNT), (const int*)(ws + WS_LIST)};
            pg8::EpiMoe2 E{(pg8::bf16_t*)(ws + WS_YR), P.b_down + (size_t)l * NEXP * DM};
            pg8::gemm_phase<pg8::EpiMoe2, pg8::MoeOrder, true, true, false>(lds + RING_OFF, g, S, E);
        }
        GRID_BAR();
        if (RUN(9)) { (void)moe_tables(P, lds, l); phase_j(P, lds, l, G); }
        if (l + 1 < NLAYER) GRID_BAR();
    }
#undef GRID_BAR
#undef RUN
}

extern "C" void kernel_launch(void* const* d_in, const int* in_sizes, int n_in, void* d_out, int out_size, void* d_ws, size_t ws_size, hipStream_t stream) {
    static int grid = 0;
    if (grid == 0) {
        if (n_in != 22 || in_sizes[0] != NTOK * DM || out_size != NTOK * DM || ws_size < WS_END) {
            fprintf(stderr, "kernel_launch: built for 22 inputs, x/out of %d floats, >= %zu bytes of workspace; got n_in %d, in0 %d, out %d, ws %zu; nothing launched\n", NTOK * DM, (size_t)WS_END, n_in, n_in > 0 ? in_sizes[0] : -1, out_size, ws_size);
            grid = -1; return; }
        int dev = 0, cus = 0, per_cu = 0;
        if (hipGetDevice(&dev) != hipSuccess || hipDeviceGetAttribute(&cus, hipDeviceAttributeMultiprocessorCount, dev) != hipSuccess) { fprintf(stderr, "kernel_launch: device query failed\n"); grid = -1; return; }
        if (hipFuncSetAttribute((const void*)mk_fwd, hipFuncAttributeMaxDynamicSharedMemorySize, LDS_BYTES) != hipSuccess) { fprintf(stderr, "kernel_launch: hipFuncSetAttribute failed\n"); grid = -1; return; }
        if (hipOccupancyMaxActiveBlocksPerMultiprocessor(&per_cu, (const void*)mk_fwd, 512, LDS_BYTES) != hipSuccess || per_cu < 1) fprintf(stderr, "kernel_launch: note: occupancy query reports %d workgroups per CU\n", per_cu);
        (void)hipGetLastError();
        grid = cus;
        if (NTOK % (grid * 8 * 4) != 0) { fprintf(stderr, "kernel_launch: %d CUs: the row-wise phases need NTOK %% (32 * CUs) == 0\n", grid); grid = -1; return; }
    }
    if (grid < 0) return;
    if (hipMemsetAsync((char*)d_ws + WS_CTL, 0, CTL_ZERO_BYTES, stream) != hipSuccess) { fprintf(stderr, "kernel_launch: hipMemsetAsync failed\n"); return; }
    Args a{};
    const float** pp = (const float**)&a.p;
    for (int i = 0; i < 22; ++i) pp[i] = (const float*)d_in[i];
    a.p.out = (float*)d_out; a.p.ws = (unsigned char*)d_ws;
    hipLaunchKernelGGL(mk_fwd, dim3(grid), dim3(512), LDS_BYTES, stream, a);
    const hipError_t le = hipPeekAtLastError();
    if (le != hipSuccess) fprintf(stderr, "kernel_launch: launch failed: %s (grid %d)\n", hipGetErrorName(le), grid);
}
```

```cpp
#include <hip/hip_runtime.h>
#include <hip/hip_bf16.h>
#include <cstdio>
#include <cstdint>
#include <cmath>

constexpr int NTOK = 32768, DM = 1024, NB = 8, SEQL = 4096, NLAYER = 4;
constexpr int NEXP = 32, TOPK = 4;
constexpr int PIN = 9232;
constexpr int NPROJ = 9216;
constexpr float DN_ALPHA = 1.6817928305074290f;
constexpr float LOG2E = 1.4426950408889634f;

namespace pg8 {
#define PG8_LAS __attribute__((address_space(3)))
typedef unsigned short bf16_t;
typedef short bf16x8 __attribute__((ext_vector_type(8)));
typedef float f32x4 __attribute__((ext_vector_type(4)));
typedef unsigned u32x4 __attribute__((ext_vector_type(4)));
constexpr int BM = 256, BK = 64, HALF = 128, HTB = HALF * BK * 2  , STAGE_BYTES = 8 * HTB, NXCD = 8, WGM = 4;

__host__ __device__ __forceinline__ int lds_byte(int r, int c) { const int st = (r >> 4) * 2 + (c >> 5), rr = r & 15, cc = c & 31, ob = rr * 64 + cc * 2; return st * 1024 + (ob ^ (((ob >> 9) & 1) << 5)); }
__host__ __device__ __forceinline__ void stage_rc(int b, int& R, int& C) { const int st = b / 1024, sb = b % 1024, swz = sb ^ (((sb >> 9) & 1) << 5); R = (st >> 1) * 16 + swz / 64; C = (st & 1) * 32 + (swz % 64) / 2; }
__host__ __device__ __forceinline__ int perm32(int rho) { const int n = rho >> 4, i = rho & 15; return 8 * (i >> 2) + 4 * n + (i & 3); }

struct Unit { int pm, pn; };
struct Gemm { const bf16_t* A; const bf16_t* Bt; int M, N, K; };

struct StaticOrder {
    int nM, nN, nwg, G, c;
    __host__ __device__ void init(int M, int N, int G_, int c_) { nM = M / BM; nN = N / BM; nwg = nM * nN; G = G_; c = c_; }
    __host__ __device__ bool map(long L, Unit& u) const {
        if (L >= nwg) return false;
        int wgid = (int)L; { const int q = nwg / NXCD, r = nwg % NXCD, xcd = wgid % NXCD, off = wgid / NXCD; wgid = (xcd < r ? xcd * (q + 1) : r * (q + 1) + (xcd - r) * q) + off; }
        const int nig = WGM * nN, gid = wgid / nig, fm = gid * WGM, gsz = (nM - fm) < WGM ? (nM - fm) : WGM;
        u.pm = fm + ((wgid % nig) % gsz); u.pn = (wgid % nig) / gsz; return true;
    }
    __host__ __device__ bool next(int i, Unit& u) const { return map((long)i * G + c, u); }
    __device__ __forceinline__ int arow(const Unit&, int) const { return 0; }
};
struct PairOrder {
    StaticOrder so;
    __device__ void init(int G_, int c_) { so.init(NTOK, DM, G_, c_); }
    __device__ bool next(int i, Unit& u) const { Unit t; if (!so.map((long)(i >> 1) * so.G + so.c, t)) return false; const int half = i & 1; u.pm = half * (NTOK / BM) + t.pm; u.pn = half * (DM / BM) + t.pn; return true; }
    __device__ __forceinline__ int arow(const Unit&, int) const { return 0; }
};
struct MoeOrder {
    int G, c, ntile, ncol;
    const PG8_LAS unsigned char* rt2e; const PG8_LAS int* tbase; const PG8_LAS int* cnt; const int* list;
    __device__ bool next(int i, Unit& u) const {
        if ((G & 7) != 0 || G < 256) { const long L = (long)i * G + c; if (L >= (long)ntile * ncol) return false; const int rt = (int)(L / ncol), pl = (int)(L % ncol); u.pm = rt; u.pn = (int)rt2e[rt] * ncol + pl; return true; }
        const int x = c & 7, k = c >> 3, per = G >> 5;
        const int stride = ncol == 8 ? 4 : 8, sub = ncol == 8 ? (x >> 1) : x, pl = (ncol == 8 ? 4 * (x & 1) : 0) + (k & 3);
        const int rt = stride * (per * i + (k >> 2)) + sub;
        if (rt >= ntile) return false;
        u.pm = rt; u.pn = (int)rt2e[rt] * ncol + pl; return true; }
    __device__ __forceinline__ int arow(const Unit& u, int r) const { const int e = u.pn / ncol; const int pos = (u.pm - tbase[e]) * BM + r; return pos < cnt[e] ? list[e * NTOK + pos] : 0; }
};

__device__ __forceinline__ unsigned cvt_pk_bf16(float lo, float hi) { unsigned r; asm volatile("v_cvt_pk_bf16_f32 %0, %1, %2" : "=v"(r) : "v"(lo), "v"(hi)); return r; }
__device__ __forceinline__ float bf_lo(unsigned w) { return __uint_as_float(w << 16); }
__device__ __forceinline__ float bf_hi(unsigned w) { return __uint_as_float(w & 0xffff0000u); }
__device__ __forceinline__ float fast_sigmoid(float x) { return __builtin_amdgcn_rcpf(1.0f + __expf(-x)); }
template <int CTRL> __device__ __forceinline__ float dpp_row(float v) { return __int_as_float(__builtin_amdgcn_update_dpp(0, __float_as_int(v), CTRL, 0xF, 0xF, true)); }
__device__ __forceinline__ float row16_scan(float v) { v += dpp_row<0x111>(v); v += dpp_row<0x112>(v); v += dpp_row<0x114>(v); v += dpp_row<0x118>(v); return v; }
__device__ __forceinline__ float row16_sum(float v) { v += dpp_row<0x128>(v); v += dpp_row<0x124>(v); v += dpp_row<0x122>(v); v += dpp_row<0x121>(v); return v; }
__device__ __forceinline__ float row16_max(float v) { v = fmaxf(v, dpp_row<0x128>(v)); v = fmaxf(v, dpp_row<0x124>(v)); v = fmaxf(v, dpp_row<0x122>(v)); v = fmaxf(v, dpp_row<0x121>(v)); return v; }
__device__ __forceinline__ float rows4_sum(float v) {
    { auto r = __builtin_amdgcn_permlane32_swap(__float_as_uint(v), __float_as_uint(v), false, false); v = __uint_as_float(r[0]) + __uint_as_float(r[1]); }
    { auto r = __builtin_amdgcn_permlane16_swap(__float_as_uint(v), __float_as_uint(v), false, false); v = __uint_as_float(r[0]) + __uint_as_float(r[1]); }
    return v; }


struct EpiInProj {
    static constexpr bool PERM = true, AFTER_DRAIN = false;
#ifdef EPI_REP_INPROJ
    static constexpr int REPS = EPI_REP_INPROJ;
#else
    static constexpr int REPS = 1;
#endif
    bf16_t* proj; float* eb; const float* lb; float qscale; unsigned* nrm;
    __device__ __forceinline__ void operator()(const f32x4 (&acc)[2][2][4][2], const Unit& u, int wr, int wc, int fr, int fq) const {
        const int grp = u.pn >> 2, row0 = u.pm * BM + wr * 64 + fr, col0 = (u.pn & 3) * BM + wc * 32 + 8 * fq;
        bf16_t* base = proj + (size_t)grp * ((size_t)NTOK * DM);
        if (u.pn < 8) {
            const int hc0 = u.pn * HALF + wc * 32 + 8 * fq;
            bf16_t* qs = proj; bf16_t* kk_ = proj + (size_t)NTOK * DM;
            const f32x4 l0 = *(const f32x4*)(lb + hc0), l1 = *(const f32x4*)(lb + hc0 + 4);
#pragma unroll
            for (int ai = 0; ai < 2; ++ai)
#pragma unroll
                for (int jh = 0; jh < 2; ++jh) {
                    float qpv[4][4], kpv[4][4], ebm[4], ebl[4], blv[4];
#pragma unroll
                    for (int jj = 0; jj < 4; ++jj) {
                        const float lbv = jh == 0 ? l0[jj] : l1[jj];
                        float s[4], kk[4], tt[4];
#pragma unroll
                        for (int m = 0; m < 4; ++m) {
                            float x = acc[ai][1][m][jh][jj];
                            x = fminf(fmaxf(x, -30.f), 30.f);
                            const float e = __expf(-x), inv = __builtin_amdgcn_rcpf(1.0f + e), oms = e * inv;
                            const float f = lbv + (1.0f - lbv) * inv;
                            const float v = __logf(fmaxf(f, 1e-30f)); kk[m] = (1.0f - lbv) * oms;
                            s[m] = row16_scan(v); tt[m] = row16_sum(v);
                        }
                        const float t0 = tt[0], t1 = tt[1], t2 = tt[2], t3 = tt[3];
                        const float R = t0 + t1, BL = (t0 + t1) + (t2 + t3);
                        const float bq[4] = {s[0], s[1] + t0, s[2] + R, s[3] + (R + t2)};
#pragma unroll
                        for (int m = 0; m < 4; ++m) { const float qv = acc[ai][0][m][jh][jj];
                            qpv[m][jj] = qv * fast_sigmoid(qv) * __expf(fminf(bq[m] - R, 80.f)); kpv[m][jj] = kk[m] * __expf(fminf(R - bq[m], 80.f)); }
                        ebm[jj] = __expf(R); ebl[jj] = __expf(BL - R); blv[jj] = BL;
                    }
                    typedef unsigned u32x2_t __attribute__((ext_vector_type(2)));
#pragma unroll
                    for (int m = 0; m < 4; ++m) { const size_t off = ((size_t)u.pn * NTOK + (row0 + ai * HALF + m * 16)) * HALF + (wc * 32 + 8 * fq + 4 * jh);
                        u32x2_t w; w.x = cvt_pk_bf16(kpv[m][0], kpv[m][1]); w.y = cvt_pk_bf16(kpv[m][2], kpv[m][3]); *(u32x2_t*)(kk_ + off) = w;
                        u32x2_t q; q.x = cvt_pk_bf16(qpv[m][0], qpv[m][1]); q.y = cvt_pk_bf16(qpv[m][2], qpv[m][3]); *(u32x2_t*)(qs + off) = q; }
                    if (fr == 0) { const size_t eo = (size_t)((u.pm * BM + ai * HALF + wr * 64) >> 6) * DM + hc0 + 4 * jh; const size_t es = (size_t)(NTOK / 64) * DM;
                        *(f32x4*)(eb + eo) = (f32x4){ebm[0], ebm[1], ebm[2], ebm[3]}; *(f32x4*)(eb + es + eo) = (f32x4){ebl[0], ebl[1], ebl[2], ebl[3]}; *(f32x4*)(eb + 2 * es + eo) = (f32x4){blv[0], blv[1], blv[2], blv[3]}; }
                }
            return;
        }
        const int mode = grp == 3 ? 1 : (grp >= 7 ? 2 : 0);
        const float sc = grp == 4 ? qscale : 1.0f;
        const bool wantn = grp == 4 || grp == 5;
        float mx[2][2] = {{0.f, 0.f}, {0.f, 0.f}};
        size_t hoff[2]; int rstr;
        if (grp <= 3) { rstr = HALF; hoff[0] = (size_t)((u.pn & 3) * 2 + 0) * NTOK * HALF + wc * 32 + 8 * fq; hoff[1] = (size_t)((u.pn & 3) * 2 + 1) * NTOK * HALF + wc * 32 + 8 * fq; }
        else if (grp <= 6) { rstr = 64; hoff[0] = (size_t)((u.pn & 3) * 4 + 0 + (wc >> 1)) * NTOK * 64 + (wc & 1) * 32 + 8 * fq; hoff[1] = (size_t)((u.pn & 3) * 4 + 2 + (wc >> 1)) * NTOK * 64 + (wc & 1) * 32 + 8 * fq; }
        else { rstr = DM; hoff[0] = col0; hoff[1] = col0 + HALF; }
#pragma unroll
        for (int ai = 0; ai < 2; ++ai)
#pragma unroll
            for (int m = 0; m < 4; ++m) { bf16_t* rowp = base + (size_t)(row0 + ai * HALF + m * 16) * rstr;
#pragma unroll
                for (int bj = 0; bj < 2; ++bj) { f32x4 v0 = acc[ai][bj][m][0], v1 = acc[ai][bj][m][1];
                    if (mode != 0) {
#pragma unroll
                        for (int j = 0; j < 4; ++j) { const float s0 = fast_sigmoid(v0[j]), s1 = fast_sigmoid(v1[j]); v0[j] = mode == 1 ? v0[j] * s0 : s0; v1[j] = mode == 1 ? v1[j] * s1 : s1; }
                    } else { v0 = v0 * sc; v1 = v1 * sc; }
                    if (wantn) { float ss = (v0[0] * v0[0] + v0[1] * v0[1]) + (v0[2] * v0[2] + v0[3] * v0[3]) + (v1[0] * v1[0] + v1[1] * v1[1]) + (v1[2] * v1[2] + v1[3] * v1[3]);
                        ss = rows4_sum(ss); mx[ai][bj] = fmaxf(mx[ai][bj], ss); }
                    u32x4 w; w.x = cvt_pk_bf16(v0[0], v0[1]); w.y = cvt_pk_bf16(v0[2], v0[3]); w.z = cvt_pk_bf16(v1[0], v1[1]); w.w = cvt_pk_bf16(v1[2], v1[3]);
                    *(u32x4*)(rowp + hoff[bj]) = w; } }
        if (wantn) {
#pragma unroll
            for (int ai = 0; ai < 2; ++ai)
#pragma unroll
                for (int bj = 0; bj < 2; ++bj) { float v = mx[ai][bj];
                    v = row16_max(v);
                    if (fr == 0 && fq == 0) { const int R = u.pm * BM + ai * HALF + wr * 64, head = ((u.pn & 3) * BM + bj * HALF + wc * 32) >> 6;
                        atomicMax(nrm + ((((grp - 4) * 128 + (R >> 12) * 16 + head) * 64 + ((R & 4095) >> 6)) * 2 + (wc & 1)), __float_as_uint(v)); } }
        }
    }
};
struct EpiBranch {
    static constexpr bool PERM = true, AFTER_DRAIN = false;
    static constexpr int REPS = 1;
    const bf16_t* ga; const bf16_t* gb; bf16_t* mg;
    __device__ __forceinline__ void operator()(const f32x4 (&acc)[2][2][4][2], const Unit& u, int wr, int wc, int fr, int fq) const {
        const int half = u.pm >= (NTOK / BM) ? 1 : 0, pm = u.pm - half * (NTOK / BM), pn = u.pn - half * (DM / BM);
        const int row0 = pm * BM + wr * 64 + fr, col0 = pn * BM + wc * 32 + 8 * fq;
        const bf16_t* gp = half ? gb : ga;
#pragma unroll
        for (int ai = 0; ai < 2; ++ai)
#pragma unroll
            for (int m = 0; m < 4; ++m) { const size_t ro = (size_t)(row0 + ai * HALF + m * 16) * DM + col0;
#pragma unroll
                for (int bj = 0; bj < 2; ++bj) { const f32x4 v0 = acc[ai][bj][m][0], v1 = acc[ai][bj][m][1];
                    const u32x4 gw = *(const u32x4*)(gp + ro + bj * HALF);
                    float o[8];
                    o[0] = bf_lo(gw.x) * v0[0]; o[1] = bf_hi(gw.x) * v0[1]; o[2] = bf_lo(gw.y) * v0[2]; o[3] = bf_hi(gw.y) * v0[3];
                    o[4] = bf_lo(gw.z) * v1[0]; o[5] = bf_hi(gw.z) * v1[1]; o[6] = bf_lo(gw.w) * v1[2]; o[7] = bf_hi(gw.w) * v1[3];
                    if (half) { const u32x4 pw = *(const u32x4*)(mg + ro + bj * HALF);
                        o[0] += bf_lo(pw.x); o[1] += bf_hi(pw.x); o[2] += bf_lo(pw.y); o[3] += bf_hi(pw.y); o[4] += bf_lo(pw.z); o[5] += bf_hi(pw.z); o[6] += bf_lo(pw.w); o[7] += bf_hi(pw.w); }
                    u32x4 w; w.x = cvt_pk_bf16(o[0], o[1]); w.y = cvt_pk_bf16(o[2], o[3]); w.z = cvt_pk_bf16(o[4], o[5]); w.w = cvt_pk_bf16(o[6], o[7]);
                    *(u32x4*)(mg + ro + bj * HALF) = w; } }
    }
};
struct EpiBf16Plain {
    static constexpr bool PERM = true, AFTER_DRAIN = false;
    static constexpr int REPS = 1;
    bf16_t* O; int ldc;
    __device__ __forceinline__ void operator()(const f32x4 (&acc)[2][2][4][2], const Unit& u, int wr, int wc, int fr, int fq) const {
        const int row0 = u.pm * BM + wr * 64 + fr, col0 = u.pn * BM + wc * 32 + 8 * fq;
#pragma unroll
        for (int ai = 0; ai < 2; ++ai)
#pragma unroll
            for (int m = 0; m < 4; ++m) { bf16_t* rowp = O + (size_t)(row0 + ai * HALF + m * 16) * ldc + col0;
#pragma unroll
                for (int bj = 0; bj < 2; ++bj) { const f32x4 v0 = acc[ai][bj][m][0], v1 = acc[ai][bj][m][1];
                    u32x4 w; w.x = cvt_pk_bf16(v0[0], v0[1]); w.y = cvt_pk_bf16(v0[2], v0[3]); w.z = cvt_pk_bf16(v1[0], v1[1]); w.w = cvt_pk_bf16(v1[2], v1[3]);
                    *(u32x4*)(rowp + bj * HALF) = w; } }
    }
};
struct EpiF32 {
    static constexpr bool PERM = true, AFTER_DRAIN = false;
    static constexpr int REPS = 1;
    float* O; int ldc;
    __device__ __forceinline__ void operator()(const f32x4 (&acc)[2][2][4][2], const Unit& u, int wr, int wc, int fr, int fq) const {
        const int row0 = u.pm * BM + wr * 64 + fr, col0 = u.pn * BM + wc * 32 + 8 * fq;
#pragma unroll
        for (int ai = 0; ai < 2; ++ai)
#pragma unroll
            for (int m = 0; m < 4; ++m) { float* rowp = O + (size_t)(row0 + ai * HALF + m * 16) * ldc + col0;
#pragma unroll
                for (int bj = 0; bj < 2; ++bj) { *(f32x4*)(rowp + bj * HALF) = acc[ai][bj][m][0]; *(f32x4*)(rowp + bj * HALF + 4) = acc[ai][bj][m][1]; } }
    }
};
struct EpiMoe1 {
    static constexpr bool PERM = true, AFTER_DRAIN = false;
#ifdef EPI_REP_MOE
    static constexpr int REPS = EPI_REP_MOE;
#else
    static constexpr int REPS = 1;
#endif
    bf16_t* act; const float* bg; const float* bu;
    __device__ __forceinline__ void operator()(const f32x4 (&acc)[2][2][4][2], const Unit& u, int wr, int wc, int fr, int fq) const {
        const int row0 = u.pm * BM + wr * 64 + fr, cl = wc * 32 + 8 * fq, colo = (u.pn & 7) * HALF + cl;
        const size_t bo = (size_t)u.pn * HALF + cl;
        const f32x4 g0 = *(const f32x4*)(bg + bo), g1 = *(const f32x4*)(bg + bo + 4), u0 = *(const f32x4*)(bu + bo), u1 = *(const f32x4*)(bu + bo + 4);
#pragma unroll
        for (int ai = 0; ai < 2; ++ai)
#pragma unroll
            for (int m = 0; m < 4; ++m) {
                float o[8];
#pragma unroll
                for (int j = 0; j < 8; ++j) {
                    float gv = (j < 4 ? acc[ai][0][m][0][j & 3] : acc[ai][0][m][1][j & 3]) + (j < 4 ? g0[j & 3] : g1[j & 3]);
                    float uv = (j < 4 ? acc[ai][1][m][0][j & 3] : acc[ai][1][m][1][j & 3]) + (j < 4 ? u0[j & 3] : u1[j & 3]);
                    gv = fminf(gv, 7.0f); uv = fminf(fmaxf(uv, -7.0f), 7.0f);
                    o[j] = (uv + 1.0f) * (gv * fast_sigmoid(1.702f * gv));
                }
                u32x4 w; w.x = cvt_pk_bf16(o[0], o[1]); w.y = cvt_pk_bf16(o[2], o[3]); w.z = cvt_pk_bf16(o[4], o[5]); w.w = cvt_pk_bf16(o[6], o[7]);
                *(u32x4*)(act + (size_t)(row0 + ai * HALF + m * 16) * DM + colo) = w;
            }
    }
};
struct EpiMoe2 {
    static constexpr bool PERM = true, AFTER_DRAIN = false;
#ifdef EPI_REP_MOE
    static constexpr int REPS = EPI_REP_MOE;
#else
    static constexpr int REPS = 1;
#endif
    bf16_t* yr; const float* bd;
    __device__ __forceinline__ void operator()(const f32x4 (&acc)[2][2][4][2], const Unit& u, int wr, int wc, int fr, int fq) const {
        const int row0 = u.pm * BM + wr * 64 + fr, cl = wc * 32 + 8 * fq, colo = (u.pn & 3) * BM + cl;
        const size_t bo = (size_t)u.pn * BM + cl;
        f32x4 bv[2][2];
#pragma unroll
        for (int bj = 0; bj < 2; ++bj) { bv[bj][0] = *(const f32x4*)(bd + bo + bj * HALF); bv[bj][1] = *(const f32x4*)(bd + bo + bj * HALF + 4); }
#pragma unroll
        for (int ai = 0; ai < 2; ++ai)
#pragma unroll
            for (int m = 0; m < 4; ++m) { bf16_t* rowp = yr + (size_t)(row0 + ai * HALF + m * 16) * DM + colo;
#pragma unroll
                for (int bj = 0; bj < 2; ++bj) { const f32x4 v0 = acc[ai][bj][m][0] + bv[bj][0], v1 = acc[ai][bj][m][1] + bv[bj][1];
                    u32x4 w; w.x = cvt_pk_bf16(v0[0], v0[1]); w.y = cvt_pk_bf16(v0[2], v0[3]); w.z = cvt_pk_bf16(v1[0], v1[1]); w.w = cvt_pk_bf16(v1[2], v1[3]);
                    *(u32x4*)(rowp + bj * HALF) = w; } }
    }
};
template <class Epi, class Sched, bool ALIGN_EPI = false, bool SP2 = false, bool GATHER = false>
__device__ __forceinline__ void gemm_phase(PG8_LAS unsigned char* lds, const Gemm g, const Sched& S, const Epi& E, const int wv  ) {
    int tid_ = wv * 64 + (int)__builtin_amdgcn_mbcnt_hi(~0u, __builtin_amdgcn_mbcnt_lo(~0u, 0u)); asm volatile("" : "+v"(tid_));
    const int tid = tid_, wid = __builtin_amdgcn_readfirstlane(tid >> 6), lane = tid & 63, wr = wid >> 2, wc = wid & 3, fr = lane & 15, fq = lane >> 4;
    const int K = g.K, nt = K / BK;
    unsigned voffA[2], voffB[2]; int rA[2], cA2[2];
#pragma unroll
    for (int i = 0; i < 2; ++i) { int R, C; stage_rc(tid * 16 + i * 8192, R, C); const int Rb = Epi::PERM ? ((R & ~31) + perm32(R & 31)) : R;
        voffA[i] = (unsigned)(R * K + C) * 2u; voffB[i] = (unsigned)(Rb * K + C) * 2u; rA[i] = R; cA2[i] = C * 2; }
    unsigned cvo[2][2], nvo[2][2];
#define PG8_GVO(dst, un) do { _Pragma("unroll") for (int _h = 0; _h < 2; ++_h) _Pragma("unroll") for (int _i = 0; _i < 2; ++_i) \
        dst[_h][_i] = (unsigned)S.arow(un, _h * HALF + rA[_i]) * (unsigned)(K * 2) + (unsigned)cA2[_i]; } while (0)
    const size_t kstep = (size_t)(BK * 2);
    const size_t hstep = (size_t)HALF * K * 2;
    const size_t tstep = 2 * hstep;
    const unsigned ldsw = (unsigned)wid * 1024u;
    const int aoff = lds_byte(wr * 64 + fr, fq * 8), boff = lds_byte(wc * 32 + fr, fq * 8);
#define PG8_SA(b, h) (((b) * 2 + (h)) * HTB)
#define PG8_SB(b, h) ((4 + (b) * 2 + (h)) * HTB)
#define PG8_STAGE(bufoff, gbase, voff) do { _Pragma("unroll") for (int _i = 0; _i < 2; ++_i) \
        __builtin_amdgcn_global_load_lds((const unsigned*)((const char*)(gbase) + (voff)[_i]), (PG8_LAS unsigned*)(lds + (bufoff) + ldsw + _i * 8192), 16, 0, 0); } while (0)
#define PG8_STAGE_A(bufoff, gbase, hh, nx) do { if constexpr (GATHER) { _Pragma("unroll") for (int _i = 0; _i < 2; ++_i) { const unsigned _vo = (nx) ? nvo[hh][_i] : cvo[hh][_i]; \
        __builtin_amdgcn_global_load_lds((const unsigned*)((const char*)(gbase) + _vo), (PG8_LAS unsigned*)(lds + (bufoff) + ldsw + _i * 8192), 16, 0, 0); } } \
        else { PG8_STAGE(bufoff, (gbase) + (hh) * hstep, voffA); } } while (0)
#define PG8_LDA(dst, b, h) do { _Pragma("unroll") for (int m = 0; m < 4; ++m) _Pragma("unroll") for (int k = 0; k < 2; ++k) dst[m][k] = *(const PG8_LAS bf16x8*)(lds + PG8_SA(b, h) + aoff + m * 2048 + k * 1024); } while (0)
#define PG8_LDB(dst, b, h) do { _Pragma("unroll") for (int n = 0; n < 2; ++n) _Pragma("unroll") for (int k = 0; k < 2; ++k) dst[n][k] = *(const PG8_LAS bf16x8*)(lds + PG8_SB(b, h) + boff + n * 2048 + k * 1024); } while (0)
#define PG8_MMA(ai, bj, At, Bt) do { __builtin_amdgcn_s_setprio(1); _Pragma("unroll") for (int m = 0; m < 4; ++m) _Pragma("unroll") for (int n = 0; n < 2; ++n) _Pragma("unroll") for (int k = 0; k < 2; ++k) \
        acc[ai][bj][m][n] = __builtin_amdgcn_mfma_f32_16x16x32_bf16(Bt[n][k], At[m][k], acc[ai][bj][m][n], 0, 0, 0); __builtin_amdgcn_s_setprio(0); } while (0)
#define PG8_WAIT_V(n) asm volatile("s_waitcnt vmcnt(" #n ")" ::: "memory")
#define PG8_WAIT_L(n) asm volatile("s_waitcnt lgkmcnt(" #n ")" ::: "memory")
#define PG8_BAR __builtin_amdgcn_s_barrier()
#define PG8_SCHED __builtin_amdgcn_sched_barrier(0)
    Unit cur, nxt; int ui = 0;
    if (!S.next(0, cur)) return;
    f32x4 acc[2][2][4][2];
#pragma unroll
    for (int a = 0; a < 2; ++a)
#pragma unroll
        for (int b = 0; b < 2; ++b)
#pragma unroll
            for (int m = 0; m < 4; ++m)
#pragma unroll
                for (int n = 0; n < 2; ++n) acc[a][b][m][n] = (f32x4){0.f, 0.f, 0.f, 0.f};
    bf16x8 At[4][2], B0[2][2], B1[2][2];
    const char* cA = (const char*)g.A + (GATHER ? (size_t)0 : (size_t)cur.pm * tstep); const char* cB = (const char*)g.Bt + (size_t)cur.pn * tstep;
    if constexpr (GATHER) { PG8_GVO(cvo, cur); }
    if constexpr (SP2) {
        PG8_STAGE(PG8_SB(0, 0), cB, voffB); PG8_STAGE(PG8_SB(0, 1), cB + hstep, voffB); PG8_STAGE_A(PG8_SA(0, 0), cA, 0, false); PG8_STAGE_A(PG8_SA(0, 1), cA, 1, false);
        if (wr == 1) PG8_BAR;
        PG8_WAIT_V(2); PG8_BAR;
        PG8_STAGE(PG8_SB(1, 0), cB + kstep, voffB); PG8_STAGE_A(PG8_SA(1, 0), cA + kstep, 0, false); PG8_STAGE(PG8_SB(1, 1), cB + hstep + kstep, voffB);
        PG8_WAIT_V(6); PG8_BAR;
    } else {
        PG8_STAGE(PG8_SB(0, 0), cB, voffB); PG8_STAGE_A(PG8_SA(0, 0), cA, 0, false); PG8_STAGE(PG8_SB(0, 1), cB + hstep, voffB); PG8_STAGE_A(PG8_SA(0, 1), cA, 1, false);
        if (wr == 1) PG8_BAR;
        PG8_WAIT_V(4); PG8_BAR;
        PG8_STAGE(PG8_SB(1, 0), cB + kstep, voffB); PG8_STAGE_A(PG8_SA(1, 0), cA + kstep, 0, false); PG8_STAGE(PG8_SB(1, 1), cB + hstep + kstep, voffB);
        PG8_WAIT_V(6); PG8_BAR;
    }
    for (;;) {
        const bool has_next = S.next(ui + 1, nxt);
        const char* nA = GATHER ? cA : (has_next ? (const char*)g.A + (size_t)nxt.pm * tstep : cA); const char* nB = has_next ? (const char*)g.Bt + (size_t)nxt.pn * tstep : cB;
        if constexpr (GATHER) { if (has_next) { PG8_GVO(nvo, nxt); } else { _Pragma("unroll") for (int _h = 0; _h < 2; ++_h) _Pragma("unroll") for (int _i = 0; _i < 2; ++_i) nvo[_h][_i] = cvo[_h][_i]; } }
        for (int t = 0; t < nt; t += 2) {
            const bool last = (t == nt - 2);
            const char* a1 = cA + (size_t)(t + 1) * kstep;
            const char* a2 = last ? nA : cA + (size_t)(t + 2) * kstep; const char* b2 = last ? nB : cB + (size_t)(t + 2) * kstep;
            const char* a3 = a2 + kstep; const char* b3 = b2 + kstep;
            if constexpr (SP2) {
            PG8_LDB(B0, 0, 0); PG8_LDB(B1, 0, 1); PG8_SCHED; PG8_LDA(At, 0, 0); PG8_STAGE_A(PG8_SA(1, 1), a1, 1, false);
            PG8_WAIT_V(8); PG8_WAIT_L(0); PG8_BAR; PG8_MMA(0, 0, At, B0); PG8_MMA(0, 1, At, B1); PG8_BAR; PG8_SCHED;
            PG8_LDA(At, 0, 1); PG8_STAGE(PG8_SB(0, 0), b2, voffB); PG8_STAGE(PG8_SB(0, 1), b2 + hstep, voffB); PG8_STAGE_A(PG8_SA(0, 0), a2, 0, last);
            PG8_WAIT_V(8); PG8_WAIT_L(0); PG8_BAR; PG8_MMA(1, 0, At, B0); PG8_MMA(1, 1, At, B1); PG8_BAR; PG8_SCHED;
            PG8_LDB(B0, 1, 0); PG8_LDB(B1, 1, 1); PG8_SCHED; PG8_LDA(At, 1, 0); PG8_STAGE_A(PG8_SA(0, 1), a2, 1, last);
            PG8_WAIT_V(8); PG8_WAIT_L(0); PG8_BAR; PG8_MMA(0, 0, At, B0); PG8_MMA(0, 1, At, B1); PG8_BAR; PG8_SCHED;
            PG8_LDA(At, 1, 1); PG8_STAGE(PG8_SB(1, 0), b3, voffB); PG8_STAGE(PG8_SB(1, 1), b3 + hstep, voffB); PG8_STAGE_A(PG8_SA(1, 0), a3, 0, last);
            PG8_WAIT_V(8); PG8_WAIT_L(0); PG8_BAR; PG8_MMA(1, 0, At, B0); PG8_MMA(1, 1, At, B1); PG8_BAR; PG8_SCHED;
            } else {
            PG8_LDB(B0, 0, 0); PG8_SCHED; PG8_LDA(At, 0, 0); PG8_STAGE_A(PG8_SA(1, 1), a1, 1, false);
            PG8_WAIT_L(8); PG8_BAR; PG8_WAIT_L(0); PG8_MMA(0, 0, At, B0); PG8_BAR; PG8_SCHED;
            PG8_LDB(B1, 0, 1); PG8_STAGE(PG8_SB(0, 0), b2, voffB);
            PG8_BAR; PG8_WAIT_L(0); PG8_MMA(0, 1, At, B1); PG8_BAR;
            PG8_LDA(At, 0, 1); PG8_STAGE_A(PG8_SA(0, 0), a2, 0, last);
            PG8_BAR; PG8_WAIT_L(0); PG8_MMA(1, 0, At, B0); PG8_BAR; PG8_SCHED;
            PG8_STAGE(PG8_SB(0, 1), b2 + hstep, voffB);
            PG8_WAIT_V(6); PG8_BAR; PG8_MMA(1, 1, At, B1); PG8_BAR;
            PG8_LDB(B0, 1, 0); PG8_SCHED; PG8_LDA(At, 1, 0); PG8_STAGE_A(PG8_SA(0, 1), a2, 1, last);
            PG8_WAIT_L(8); PG8_BAR; PG8_WAIT_L(0); PG8_MMA(0, 0, At, B0); PG8_BAR; PG8_SCHED;
            PG8_LDB(B1, 1, 1); PG8_STAGE(PG8_SB(1, 0), b3, voffB);
            PG8_BAR; PG8_WAIT_L(0); PG8_MMA(0, 1, At, B1); PG8_BAR;
            PG8_LDA(At, 1, 1); PG8_STAGE_A(PG8_SA(1, 0), a3, 0, last);
            PG8_BAR; PG8_WAIT_L(0); PG8_MMA(1, 0, At, B0); PG8_BAR; PG8_SCHED;
            PG8_STAGE(PG8_SB(1, 1), b3 + hstep, voffB);
            PG8_WAIT_V(6); PG8_BAR; PG8_MMA(1, 1, At, B1); PG8_BAR;
            }
        }
        if constexpr (ALIGN_EPI) { if (wr == 0) PG8_BAR; }
        if constexpr (!Epi::AFTER_DRAIN) { E(acc, cur, wr, wc, fr, fq); if constexpr (Epi::REPS > 1) { asm volatile("" ::: "memory"); E(acc, cur, wr, wc, fr, fq); } }
        if (!has_next) break;
#pragma unroll
        for (int a = 0; a < 2; ++a)
#pragma unroll
            for (int b = 0; b < 2; ++b)
#pragma unroll
                for (int m = 0; m < 4; ++m)
#pragma unroll
                    for (int n = 0; n < 2; ++n) acc[a][b][m][n] = (f32x4){0.f, 0.f, 0.f, 0.f};
        cur = nxt; cA = nA; cB = nB; ++ui;
        if constexpr (GATHER) { _Pragma("unroll") for (int _h = 0; _h < 2; ++_h) _Pragma("unroll") for (int _i = 0; _i < 2; ++_i) cvo[_h][_i] = nvo[_h][_i]; }
        if constexpr (ALIGN_EPI) { if (wr == 1) PG8_BAR; }
    }
    PG8_WAIT_V(0);
    if constexpr (!ALIGN_EPI) { if (wr == 0) PG8_BAR; }
    PG8_BAR;
#undef PG8_SA
#undef PG8_SB
#undef PG8_STAGE
#undef PG8_STAGE_A
#undef PG8_GVO
#undef PG8_LDA
#undef PG8_LDB
#undef PG8_MMA
#undef PG8_WAIT_V
#undef PG8_WAIT_L
#undef PG8_BAR
#undef PG8_SCHED
}
}

namespace attn_body {
using bf16=__hip_bfloat16;
using bf16x8=__attribute__((ext_vector_type(8)))short;
using s16x4=__attribute__((ext_vector_type(4)))short;
using f32x16=__attribute__((ext_vector_type(16)))float;
using u32x4=__attribute__((ext_vector_type(4)))unsigned;
constexpr int BATCH=8,NHEAD=16,SEQ=4096,D=64,DM=NHEAD*D;
constexpr long HSTR=(long)BATCH*SEQ*D;
constexpr int NW=8,QBLK=32,QB=QBLK*NW,KVBLK=64,NQB=SEQ/QB;
constexpr int ATTN_PITCH=DM, ATTN_UNIT_ROWS=QB;
__device__ __forceinline__ int crow(int r,int hi){return (r&3)+8*(r>>2)+4*hi;}
#define SBAR() __builtin_amdgcn_sched_barrier(0)
__device__ __forceinline__ void cmask(f32x16&p0,f32x16&p1,int jb,int qrel,int hi){
  const float NEG=-INFINITY; int kb=64*jb+4*hi;
  #pragma unroll
  for(int r=0;r<16;++r){int kv=kb+(r&3)+8*(r>>2); if(kv>qrel)p0[r]=NEG; if(kv+32>qrel)p1[r]=NEG;}
}

constexpr int NSLOT=3, SLOTB=8192;
constexpr int LDS_K=0, LDS_V=NSLOT*SLOTB, LDS_WS=2*NSLOT*SLOTB, LDS_OST=LDS_WS+NW*64*4, LDS_FK=LDS_OST+NW*4096, LDS_BYTES=LDS_FK+SEQ*4;
constexpr float C2=0.125f*1.4426950408889634f;
__device__ __forceinline__ void glds16(const void*gsrc,unsigned lds_dst){unsigned keep;
  asm volatile("s_mov_b32 %0, m0\n\ts_mov_b32 m0, %2\n\ts_nop 0\n\tglobal_load_lds_dwordx4 %1, off\n\ts_mov_b32 m0, %0":"=&s"(keep):"v"(gsrc),"s"(lds_dst):"memory");}
__device__ __forceinline__ float max3f(float a,float b,float c){float r;asm("v_max3_f32 %0, %1, %2, %3":"=v"(r):"v"(a),"v"(b),"v"(c));return r;}
__device__ __forceinline__ float max2f(float a,float b){float r;asm("v_max_f32_e32 %0, %1, %2":"=v"(r):"v"(a),"v"(b));return r;}
__device__ __forceinline__ float fadd_s(float a,float b){float r;asm("v_add_f32_e32 %0, %1, %2":"=v"(r):"v"(a),"v"(b));return r;}
__device__ __forceinline__ float fsub_s(float a,float b){float r;asm("v_sub_f32_e32 %0, %1, %2":"=v"(r):"v"(a),"v"(b));return r;}
typedef float f32x2_t __attribute__((ext_vector_type(2))); typedef __bf16 bf16x2_t __attribute__((ext_vector_type(2)));
__device__ __forceinline__ unsigned cvtpk_s(float lo,float hi){f32x2_t v={lo,hi};bf16x2_t b=__builtin_convertvector(v,bf16x2_t);return __builtin_bit_cast(unsigned,b);}
#define WAIT_BAR(N) asm volatile("s_waitcnt vmcnt(" #N ") lgkmcnt(0)\n\ts_barrier":::"memory")

__device__ __forceinline__ void qkt(f32x16&p0,f32x16&p1,const char*Kslot,const bf16x8*qr,int r32,int hi){
  const char*kb=Kslot+hi*1024+r32*16;
  #pragma unroll
  for(int d0=0;d0<4;++d0){
    const bf16x8 b0=*reinterpret_cast<const bf16x8*>(kb+d0*2048);
    const bf16x8 b1=*reinterpret_cast<const bf16x8*>(kb+d0*2048+512);
    p0=__builtin_amdgcn_mfma_f32_32x32x16_bf16(b0,qr[d0],p0,0,0,0);p1=__builtin_amdgcn_mfma_f32_32x32x16_bf16(b1,qr[d0],p1,0,0,0);}
}
typedef __attribute__((address_space(3))) const char* lds_cptr;
typedef short v4i16_t __attribute__((ext_vector_type(4)));
__device__ __forceinline__ void kload8(bf16x8*kf,lds_cptr kp){
  kf[0]=*(const __attribute__((address_space(3))) bf16x8*)(kp);      kf[1]=*(const __attribute__((address_space(3))) bf16x8*)(kp+512);
  kf[2]=*(const __attribute__((address_space(3))) bf16x8*)(kp+2048); kf[3]=*(const __attribute__((address_space(3))) bf16x8*)(kp+2560);
  kf[4]=*(const __attribute__((address_space(3))) bf16x8*)(kp+4096); kf[5]=*(const __attribute__((address_space(3))) bf16x8*)(kp+4608);
  kf[6]=*(const __attribute__((address_space(3))) bf16x8*)(kp+6144); kf[7]=*(const __attribute__((address_space(3))) bf16x8*)(kp+6656);
}
__device__ __forceinline__ void kload2(bf16x8*kf,lds_cptr kp,int j){ kf[2*j]=*(const __attribute__((address_space(3))) bf16x8*)(kp+j*2048); kf[2*j+1]=*(const __attribute__((address_space(3))) bf16x8*)(kp+j*2048+512); }
__device__ __forceinline__ s16x4 vtr(lds_cptr p){ return __builtin_bit_cast(s16x4,__builtin_amdgcn_ds_read_tr16_b64_v4i16((__attribute__((address_space(3))) v4i16_t*)p)); }
__device__ __forceinline__ float rowmax(const f32x16&p0,const f32x16&p1){
  float a=max3f(p0[0],p0[1],p1[0]),b=max3f(p0[2],p0[3],p1[1]);a=max3f(a,p1[2],p1[3]);
  #pragma unroll
  for(int r=4;r<16;r+=4){a=max3f(a,p0[r],p0[r+1]);b=max3f(b,p0[r+2],p0[r+3]);a=max3f(a,p1[r],p1[r+1]);b=max3f(b,p1[r+2],p1[r+3]);}
  const float m=max2f(a,b);
  auto rr=__builtin_amdgcn_permlane32_swap(__float_as_uint(m),__float_as_uint(m),false,false);
  return max2f(__uint_as_float(rr[0]),__uint_as_float(rr[1]));
}
__device__ __forceinline__ void pv(f32x16*o,int vb,bf16x8 pa0,bf16x8 pa1,bf16x8 pa2,bf16x8 pa3){
  #pragma unroll
  for(int d0=0;d0<2;++d0){s16x4 lo[4],hi[4];
    #pragma unroll
    for(int ks=0;ks<4;++ks){
      asm volatile("ds_read_b64_tr_b16 %0,%1 offset:%c2":"=&v"(lo[ks]):"v"(vb),"i"(d0*4096+ks*1024):"memory");
      asm volatile("ds_read_b64_tr_b16 %0,%1 offset:%c2":"=&v"(hi[ks]):"v"(vb),"i"(d0*4096+ks*1024+512):"memory");}
    asm volatile("s_waitcnt lgkmcnt(0)":::"memory");SBAR();
    #define PK(k) (bf16x8){lo[k][0],lo[k][1],lo[k][2],lo[k][3],hi[k][0],hi[k][1],hi[k][2],hi[k][3]}
    o[d0]=__builtin_amdgcn_mfma_f32_32x32x16_bf16(pa0,PK(0),o[d0],0,0,0);
    o[d0]=__builtin_amdgcn_mfma_f32_32x32x16_bf16(pa1,PK(1),o[d0],0,0,0);
    o[d0]=__builtin_amdgcn_mfma_f32_32x32x16_bf16(pa2,PK(2),o[d0],0,0,0);
    o[d0]=__builtin_amdgcn_mfma_f32_32x32x16_bf16(pa3,PK(3),o[d0],0,0,0);
    #undef PK
  }
}

#ifndef ATTN_STORE16
#define ATTN_STORE16(p,v) (*(u32x4*)(p)=(v))
#endif
__device__ __forceinline__ void attn_jstart_table(__attribute__((address_space(3))) unsigned char*jtab,const unsigned*__restrict__ NRM,const float*__restrict__ FP,const int wv){
  int lane_=(int)__builtin_amdgcn_mbcnt_hi(~0u,__builtin_amdgcn_mbcnt_lo(~0u,0u)); asm volatile("":"+v"(lane_)); const int lane=lane_;
  typedef float f32x2_t __attribute__((ext_vector_type(2)));
  f32x2_t nkx[16],nqx[16]; float fe[16],fb[16];
  #pragma unroll
  for(int i=0;i<16;++i){ const int bh=16*wv+i; const unsigned*NQ=NRM+(size_t)bh*128,*NK=NRM+(size_t)(128+bh)*128; const float*Fbh=FP+(long)bh*SEQ;
    nkx[i]=*reinterpret_cast<const f32x2_t*>(NK+2*lane); nqx[i]=*reinterpret_cast<const f32x2_t*>(NQ+2*lane); fe[i]=Fbh[64*lane+63]; fb[i]=Fbh[64*lane]; }
  #pragma unroll
  for(int i=0;i<16;++i){ const int bh=16*wv+i;
    const float kn=sqrtf(nkx[i].x+nkx[i].y)*1.02f, qs=nqx[i].x+nqx[i].y, fend=fe[i], fbeg=fb[i];
    for(int qb=0;qb<NQB;++qb){ const int NTfull=4*qb+4; float qn2=0.f,kd=0.f;
      #pragma unroll
      for(int t=0;t<4;++t){ qn2=fmaxf(qn2,__uint_as_float(__builtin_amdgcn_readlane(__float_as_uint(qs),4*qb+t))); kd=fmaxf(kd,__uint_as_float(__builtin_amdgcn_readlane(__float_as_uint(kn),4*qb+t))); }
      const float qn=sqrtf(qn2)*1.02f, lbv=-qn*kd, bias=__uint_as_float(__builtin_amdgcn_readlane(__float_as_uint(fbeg),4*qb))-fend;
      const bool need=(lane<NTfull)&&((lane>=NTfull-4)||!(qn*kn+bias<lbv-40.f));
      const unsigned long long bal=__ballot(need); const int js=(bal?(__ffsll((long long)bal)-1):0)&~1;
      if(lane==0)jtab[bh*NQB+qb]=(unsigned char)js; } }
}
template<int THRL> __device__ __forceinline__ void attn_unit(int b,int h,int qb,const bf16*Q,const bf16*__restrict__ K,const bf16*__restrict__ V,bf16*O,const float*__restrict__ FP,const __attribute__((address_space(3))) unsigned char*jtab,unsigned*wq,volatile __attribute__((address_space(3))) unsigned*wslot,char*shm,const int wv){
  int tid_ = wv * 64 + (int)__builtin_amdgcn_mbcnt_hi(~0u, __builtin_amdgcn_mbcnt_lo(~0u, 0u)); asm volatile("" : "+v"(tid_));
  const int tid=tid_,lane=tid&63,r32=lane&31,hi=lane>>5; const int wid=__builtin_amdgcn_readfirstlane(tid>>6);
  const long rowbase=(long)b*SEQ; const int q0=qb*QB;
  const bf16*Qw=Q+(long)h*HSTR+(rowbase+q0+wid*QBLK)*D;
  unsigned wnext=0u; if(tid==0)wnext=__hip_atomic_fetch_add(wq,1u,__ATOMIC_RELAXED,__HIP_MEMORY_SCOPE_AGENT);
  const float*Fbh=FP+(long)(b*NHEAD+h)*SEQ;
  const int NTfull=(q0+QB)/KVBLK; const int jstart=__builtin_amdgcn_readfirstlane((int)jtab[(b*NHEAD+h)*NQB+qb]);
  if(tid==0)*wslot=wnext;
  const bf16*Kh=K+(long)h*HSTR+(rowbase+(long)jstart*KVBLK)*D,*Vh=V+(long)h*HSTR+(rowbase+(long)jstart*KVBLK)*D;
  const lds_cptr shm3=(lds_cptr)shm;
  const unsigned lds0=(unsigned)(uintptr_t)shm;
  float*wsf=(float*)(shm+LDS_WS)+wid*64;
  const bf16*ksrc=Kh+(long)lane*D+wid*8;
  const bf16*vsrc=Vh+(long)(16*(wid&3)+(lane>>2))*D+(wid>>2)*32+(lane&3)*8;
  const unsigned kdst=lds0+LDS_K+wid*1024, vdst=lds0+LDS_V+wid*1024;
  #define DMA_K(t,slot) glds16(ksrc+(long)(t)*KVBLK*D,(unsigned)__builtin_amdgcn_readfirstlane(kdst+(slot)))
  #define DMA_V(t,slot) glds16(vsrc+(long)(t)*KVBLK*D,(unsigned)__builtin_amdgcn_readfirstlane(vdst+(slot)))
  const int vb0=(int)(lds0+LDS_V)+((lane>>4)&1)*32+(lane&3)*8+(4*hi+((lane&15)>>2))*64;
  const char*Kbase=shm+LDS_K; bf16x8 kf[8];
  const lds_cptr kp0=shm3+LDS_K+hi*1024+r32*16; const lds_cptr vp0=shm3+LDS_V+((lane>>4)&1)*32+(lane&3)*8+(4*hi+((lane&15)>>2))*64;
  const int NT=NTfull-jstart;
  DMA_K(0,0);DMA_V(0,0);DMA_K(1,SLOTB);
  { typedef float f32x4_t __attribute__((ext_vector_type(4))); __attribute__((address_space(3))) f32x4_t*fdst=(__attribute__((address_space(3))) f32x4_t*)(shm3+LDS_FK);
    for(int i=tid;i<NT*(KVBLK/4);i+=NW*64)fdst[i]=*reinterpret_cast<const f32x4_t*>(Fbh+jstart*KVBLK+4*i); }
  const float fq=Fbh[q0+wid*QBLK+r32];
  const __attribute__((address_space(3))) float*fk3=(const __attribute__((address_space(3))) float*)(shm3+LDS_FK)+4*hi;
  #define FINIT(P0,P1,t) do{ typedef float f32x4_t __attribute__((ext_vector_type(4))); const __attribute__((address_space(3))) float*fk_=fk3+(t)*KVBLK; \
    _Pragma("unroll") for(int g_=0;g_<4;++g_){ const f32x4_t a_=*(const __attribute__((address_space(3))) f32x4_t*)(fk_+8*g_), b_=*(const __attribute__((address_space(3))) f32x4_t*)(fk_+32+8*g_); \
      _Pragma("unroll") for(int j_=0;j_<4;++j_){ P0[4*g_+j_]=tq-a_[j_]; P1[4*g_+j_]=tq-b_[j_]; } } }while(0)
  bf16x8 qr[4];
  #pragma unroll
  for(int d0=0;d0<4;++d0)qr[d0]=*reinterpret_cast<const bf16x8*>(&Qw[(long)r32*D+d0*16+hi*8]);
  float l_reg=0.f;f32x16 o[2];o[0]=f32x16{};o[1]=f32x16{};float tq=fq;
  const int qrel=wid*QBLK+r32;
  #define CMASK(P0,P1,t) do{int jb_=(t)-(NT-4); if(jb_>=0)cmask(P0,P1,jb_,qrel,hi);}while(0)
  bool resc=false;
  #define START(P0,P1) do{ const float rm=rowmax(P0,P1); resc=false; \
    { const float dl=rm; \
      _Pragma("unroll") for(int r=0;r<16;++r){P0[r]=fsub_s(P0[r],dl);P1[r]=fsub_s(P1[r],dl);} \
      tq=fsub_s(tq,dl); } \
    _Pragma("unroll") for(int r=0;r<16;++r)P0[r]=__builtin_amdgcn_exp2f(P0[r]); }while(0)
  #define RESC() do{ if(resc){ asm volatile("s_waitcnt lgkmcnt(0)":::"memory"); \
      _Pragma("unroll") for(int d_=0;d_<2;++d_) _Pragma("unroll") for(int r=0;r<16;++r)o[d_][r]*=wsf[crow(r,hi)]; } }while(0)
  f32x16 pA0,pA1,pB0,pB1;
  int sl_prev=0,sl_cur=0,sl_next=SLOTB;
  #define ROT() do{sl_prev=sl_cur;sl_cur=sl_next;sl_next=(sl_next==(NSLOT-1)*SLOTB)?0:sl_next+SLOTB;}while(0)
  DMA_K(2,2*SLOTB);
  WAIT_BAR(3);
  FINIT(pA0,pA1,0);
  qkt(pA0,pA1,Kbase,qr,r32,hi);asm volatile("s_nop 15\n\ts_nop 7":"+v"(pA0),"+v"(pA1));CMASK(pA0,pA1,0);
  START(pA0,pA1);
  _Pragma("unroll") for(int r=0;r<16;++r)pA1[r]=__builtin_amdgcn_exp2f(pA1[r]);
  WAIT_BAR(0);
  DMA_K(3,0);DMA_V(1,SLOTB);
  ROT();
  kload8(kf,kp0+sl_cur);
  WAIT_BAR(2);
  s16x4 vlo[8],vhi[8]; u32x4 pw0,pw1,pw2,pw3;
  #define PKW(P,B) cvtpk_s(P[B],P[B+1])
  #define PAF(k) __builtin_bit_cast(bf16x8,pw##k)
  #define VFR(i) (bf16x8){vlo[i][0],vlo[i][1],vlo[i][2],vlo[i][3],vhi[i][0],vhi[i][1],vhi[i][2],vhi[i][3]}
  #define PIN(x) asm volatile("":"+v"(x))
  #define MX3(a,b,c) __builtin_fmaxf(__builtin_fmaxf((a),(b)),(c))
  #define GAPA(MF,A0,A1,A2,A3,W0,W1,PW) do{ MF; sacc+=A0; sacc+=A1; sacc+=A2; sacc+=A3; PIN(sacc); W0; W1; PIN(PW); SBAR(); }while(0)
  #define EX(v) __builtin_amdgcn_exp2f(v)
  #define GAPB(MF,X,B) do{ MF; X[B]=EX(X[B]); X[B+1]=EX(X[B+1]); X[B+2]=EX(X[B+2]); X[B+3]=EX(X[B+3]); PIN(X); SBAR(); }while(0)
  #define VRD(i) do{ vlo[i]=vtr(vp_+(((i)>>2)*4096+((i)&3)*1024)); vhi[i]=vtr(vp_+(((i)>>2)*4096+((i)&3)*1024+512)); }while(0)
  #define KRD(G,j) do{ if(G){ kload2(kf,kp0+sl_next,j); SBAR(); } }while(0)
  #define STEP(C0,C1,P0,P1,t,GK,GV,GL) do{ SBAR(); FINIT(C0,C1,t); SBAR(); \
    const lds_cptr vp_=vp0+sl_prev; \
    VRD(0); SBAR(); float sacc=(P0[0]+P0[1]); \
    GAPA(C0=__builtin_amdgcn_mfma_f32_32x32x16_bf16(kf[0],qr[0],C0,0,0,0), P0[2],P0[3],P0[4],P0[5],     pw0[0]=PKW(P0,0), pw0[1]=PKW(P0,2), pw0); \
    VRD(4); SBAR(); GAPA(C1=__builtin_amdgcn_mfma_f32_32x32x16_bf16(kf[1],qr[0],C1,0,0,0), P0[6],P0[7],P0[8],P0[9],     pw0[2]=PKW(P0,4), pw0[3]=PKW(P0,6), pw0); \
    VRD(1); SBAR(); GAPA(C0=__builtin_amdgcn_mfma_f32_32x32x16_bf16(kf[2],qr[1],C0,0,0,0),   P0[10],P0[11],P0[12],P0[13], pw1[0]=PKW(P0,8), pw1[1]=PKW(P0,10), pw1); \
    VRD(5); SBAR(); GAPA(C1=__builtin_amdgcn_mfma_f32_32x32x16_bf16(kf[3],qr[1],C1,0,0,0),   P0[14],P0[15],P1[0],P1[1],   pw1[2]=PKW(P0,12),pw1[3]=PKW(P0,14), pw1); \
    VRD(2); SBAR(); GAPA(C0=__builtin_amdgcn_mfma_f32_32x32x16_bf16(kf[4],qr[2],C0,0,0,0),   P1[2],P1[3],P1[4],P1[5],     pw2[0]=PKW(P1,0), pw2[1]=PKW(P1,2), pw2); \
    VRD(6); SBAR(); GAPA(C1=__builtin_amdgcn_mfma_f32_32x32x16_bf16(kf[5],qr[2],C1,0,0,0),   P1[6],P1[7],P1[8],P1[9],     pw2[2]=PKW(P1,4), pw2[3]=PKW(P1,6), pw2); \
    VRD(3); SBAR(); GAPA(C0=__builtin_amdgcn_mfma_f32_32x32x16_bf16(kf[6],qr[3],C0,0,0,0),   P1[10],P1[11],P1[12],P1[13], pw3[0]=PKW(P1,8), pw3[1]=PKW(P1,10), pw3); \
    VRD(7); SBAR(); GAPA(C1=__builtin_amdgcn_mfma_f32_32x32x16_bf16(kf[7],qr[3],C1,0,0,0),   P1[14],P1[15],0.f,0.f,       pw3[2]=PKW(P1,12),pw3[3]=PKW(P1,14), pw3); \
    l_reg+=sacc; \
    if(GK){DMA_K((t)+3,sl_cur);} if(GV){DMA_V((t)+1,sl_next);} \
    CMASK(C0,C1,t); \
    { float a=MX3(C0[0],C0[1],C1[0]),b=MX3(C0[2],C0[3],C1[1]); a=MX3(a,C1[2],C1[3]); \
      _Pragma("unroll") for(int r=4;r<16;r+=4){a=MX3(a,C0[r],C0[r+1]);b=MX3(b,C0[r+2],C0[r+3]);a=MX3(a,C1[r],C1[r+1]);b=MX3(b,C1[r+2],C1[r+3]);} \
      float rm=__builtin_fmaxf(a,b); { auto rr=__builtin_amdgcn_permlane32_swap(__float_as_uint(rm),__float_as_uint(rm),false,false); rm=__builtin_fmaxf(__uint_as_float(rr[0]),__uint_as_float(rr[1])); } \
      resc=false; \
      if(__builtin_expect(__any(rm>(float)THRL),0)){ const float dl=__builtin_fmaxf(rm,0.f); \
        _Pragma("unroll") for(int r=0;r<16;++r){C0[r]-=dl;C1[r]-=dl;} \
        tq-=dl; \
        const float f=__builtin_amdgcn_exp2f(-dl); l_reg*=f; if(hi==0)wsf[r32]=f; resc=true; } } \
    SBAR(); \
    GAPB(o[0]=__builtin_amdgcn_mfma_f32_32x32x16_bf16(PAF(0),VFR(0),o[0],0,0,0), C0,0); \
    GAPB(o[1]=__builtin_amdgcn_mfma_f32_32x32x16_bf16(PAF(0),VFR(4),o[1],0,0,0), C0,4); \
    KRD(GL,0); GAPB(o[0]=__builtin_amdgcn_mfma_f32_32x32x16_bf16(PAF(1),VFR(1),o[0],0,0,0), C0,8); \
    KRD(GL,1); GAPB(o[1]=__builtin_amdgcn_mfma_f32_32x32x16_bf16(PAF(1),VFR(5),o[1],0,0,0), C0,12); \
    KRD(GL,2); GAPB(o[0]=__builtin_amdgcn_mfma_f32_32x32x16_bf16(PAF(2),VFR(2),o[0],0,0,0), C1,0); \
    KRD(GL,3); GAPB(o[1]=__builtin_amdgcn_mfma_f32_32x32x16_bf16(PAF(2),VFR(6),o[1],0,0,0), C1,4); \
    GAPB(o[0]=__builtin_amdgcn_mfma_f32_32x32x16_bf16(PAF(3),VFR(3),o[0],0,0,0), C1,8); \
    GAPB(o[1]=__builtin_amdgcn_mfma_f32_32x32x16_bf16(PAF(3),VFR(7),o[1],0,0,0), C1,12); \
    }while(0)
  int t=1;
  #undef CMASK
  #define CMASK(P0,P1,t) do{}while(0)
  for(;t+5<NT;t+=2){
    STEP(pB0,pB1,pA0,pA1,t,true,true,true);     WAIT_BAR(2); RESC(); ROT();
    STEP(pA0,pA1,pB0,pB1,t+1,true,true,true);   WAIT_BAR(2); RESC(); ROT();
  }
  #undef CMASK
  #define CMASK(P0,P1,t) do{int jb_=(t)-(NT-4); if(jb_>=0)cmask(P0,P1,jb_,qrel,hi);}while(0)
  #define ENDW(tt) do{ if((tt)+3<NT){WAIT_BAR(2);} else if((tt)+2<NT){WAIT_BAR(1);} else {WAIT_BAR(0);} }while(0)
  for(;t+1<NT;t+=2){
    STEP(pB0,pB1,pA0,pA1,t,(t+3<NT),(t+1<NT),(t+1<NT));       ENDW(t);   RESC(); ROT();
    STEP(pA0,pA1,pB0,pB1,t+1,(t+4<NT),(t+2<NT),(t+2<NT));     ENDW(t+1); RESC(); ROT();
  }
  STEP(pB0,pB1,pA0,pA1,NT-1,false,false,false); RESC();
  { float sacc=pB0[0]+pB0[1]; _Pragma("unroll") for(int r=2;r<16;++r)sacc+=pB0[r]; _Pragma("unroll") for(int r=0;r<16;++r)sacc+=pB1[r]; l_reg+=sacc;
    pw0=(u32x4){PKW(pB0,0),PKW(pB0,2),PKW(pB0,4),PKW(pB0,6)};pw1=(u32x4){PKW(pB0,8),PKW(pB0,10),PKW(pB0,12),PKW(pB0,14)};pw2=(u32x4){PKW(pB1,0),PKW(pB1,2),PKW(pB1,4),PKW(pB1,6)};pw3=(u32x4){PKW(pB1,8),PKW(pB1,10),PKW(pB1,12),PKW(pB1,14)};
    SBAR(); pv(o,vb0+sl_cur,PAF(0),PAF(1),PAF(2),PAF(3)); }
  #undef PKW
  #undef PAF
  #undef VFR
  #undef PIN
  #undef MX3
  #undef GAPA
  #undef GAPB
  #undef EX
  #undef VRD
  #undef KRD
  #undef STEP
  #undef ENDW
  {auto rr=__builtin_amdgcn_permlane32_swap(__float_as_uint(l_reg),__float_as_uint(l_reg),false,false);l_reg=__uint_as_float(rr[0])+__uint_as_float(rr[1]);}
  if(hi==0)wsf[32+r32]=l_reg;asm volatile("s_waitcnt lgkmcnt(0)":::"memory");
  float rli[16];
  #pragma unroll
  for(int r=0;r<16;++r)rli[r]=__builtin_amdgcn_rcpf(wsf[32+crow(r,hi)]);
  bf16*Ow=O+(rowbase+q0+wid*QBLK)*DM+h*D;
  { bf16*stg=(bf16*)(shm+LDS_OST)+wid*2048;
    #pragma unroll
    for(int r=0;r<16;++r){const int orow=crow(r,hi);
      #pragma unroll
      for(int d0=0;d0<2;++d0)stg[orow*64+d0*32+r32]=__float2bfloat16(o[d0][r]*rli[r]);}
    asm volatile("s_waitcnt lgkmcnt(0)":::"memory");
    #pragma unroll
    for(int i=0;i<4;++i){const int row=i*8+(lane>>3),ch=lane&7; const u32x4 v=*(const u32x4*)(stg+row*64+ch*8); ATTN_STORE16(Ow+(long)row*DM+ch*8,v);} }
  asm volatile("s_waitcnt lgkmcnt(0)\n\ts_barrier":::"memory");
  #undef FINIT
  #undef DMA_K
  #undef DMA_V
  #undef CMASK
  #undef START
  #undef RESC
  #undef ROT
}
constexpr int ATTN_LDS_BYTES=LDS_BYTES;
#undef SBAR
#undef WAIT_BAR
}
#define GAS __attribute__((address_space(1)))
#define LAS __attribute__((address_space(3)))
typedef unsigned short bf16;
typedef unsigned v4u __attribute__((ext_vector_type(4)));
typedef float f32x4 __attribute__((ext_vector_type(4)));
typedef short bf16x8 __attribute__((ext_vector_type(8)));
typedef GAS unsigned gu32;
typedef GAS unsigned long long gu64;
#define RLX_AGENT __ATOMIC_RELAXED, __HIP_MEMORY_SCOPE_AGENT
#define LDS_WAIT() asm volatile("s_waitcnt lgkmcnt(0)" ::: "memory")
#define VM_WAIT() asm volatile("s_waitcnt vmcnt(0)" ::: "memory")
__device__ __forceinline__ unsigned long long rt() { return __builtin_amdgcn_s_memrealtime(); }
__device__ __forceinline__ unsigned f2bf(float f) { unsigned u = __builtin_bit_cast(unsigned, f); return (u + 0x7fffu + ((u >> 16) & 1u)) >> 16; }
__device__ __forceinline__ unsigned pk2(float lo, float hi) { return f2bf(lo) | (f2bf(hi) << 16); }

#define XB_TMO      128
#define XB_XCNT(j)  (256  + 64 * (j))
#define XB_XSUB(j)  (1280 + 64 * (j))
#define XB_XGEN(j)  (2304 + 64 * (j))
#define XB_TOP      3328
#define XB_TOPGEN   3392
#define XCD_BAR_WORDS 3456
#define XB_SPIN_CAP (1u << 18)

__device__ __forceinline__ unsigned xb_ld(unsigned* p)              { return __hip_atomic_load(p, __ATOMIC_RELAXED, __HIP_MEMORY_SCOPE_AGENT); }
__device__ __forceinline__ unsigned xb_add(unsigned* p, unsigned v) { return __hip_atomic_fetch_add(p, v, __ATOMIC_RELAXED, __HIP_MEMORY_SCOPE_AGENT); }
__device__ __forceinline__ unsigned xb_xcc_id() { return (unsigned)__builtin_amdgcn_s_getreg((3 << 11) | 20) & 0xFu; }
#define XB_SPIN(cond, bar) do { unsigned _sp = 0; while (cond) { __builtin_amdgcn_s_sleep(1); \
    if ((++_sp & 255u) == 0u) { if (xb_ld(&(bar)[XB_TMO])) break; if (_sp > XB_SPIN_CAP) { atomicAdd(&(bar)[XB_TMO], 1u); break; } } } } while (0)

struct XcdBarrier {
    unsigned* bar; unsigned x;
    volatile LAS unsigned* st;
};

__device__ __forceinline__ XcdBarrier xcd_barrier_post(unsigned* bar, volatile LAS unsigned* st) {
    XcdBarrier b; b.bar = bar; b.x = xb_xcc_id(); b.st = st;
    if (threadIdx.x == 0) (void)xb_add(&bar[XB_XCNT(b.x)], 1u);
    return b;
}
__device__ __forceinline__ void xcd_barrier_complete(unsigned* bar, unsigned x, unsigned& nloc, unsigned& nx) {
    const unsigned G = gridDim.x * gridDim.y * gridDim.z;
    unsigned sum, cnt, mine, sp = 0u;
    for (;;) {
        sum = 0u; cnt = 0u; mine = 0u;
#pragma unroll
        for (unsigned j = 0; j < 16; ++j) { const unsigned c = xb_ld(&bar[XB_XCNT(j)]); sum += c; cnt += (c > 0u) ? 1u : 0u; mine = (j == x) ? c : mine; }
        if (sum == G) break;
        __builtin_amdgcn_s_sleep(1);
        if ((++sp & 255u) == 0u) { if (xb_ld(&bar[XB_TMO])) break; if (sp > XB_SPIN_CAP) { atomicAdd(&bar[XB_TMO], 1u); break; } }
    }
    nloc = mine > 0u ? mine : 1u; nx = cnt > 0u ? cnt : 1u;
}

__device__ __forceinline__ void xcd_barrier(const XcdBarrier& b) {
    asm volatile("s_waitcnt vmcnt(0)" ::: "memory");
    __syncthreads();
    if (threadIdx.x == 0) {
        unsigned* bar = b.bar;
        __builtin_amdgcn_s_waitcnt(0);
        unsigned nloc = b.st[0], nx = b.st[1];
        if (nloc == 0u) { xcd_barrier_complete(bar, b.x, nloc, nx); b.st[0] = nloc; b.st[1] = nx; }
        const unsigned old = xb_add(&bar[XB_XSUB(b.x)], 1u);
        const unsigned gen = old / nloc;
        if (old + 1u == (gen + 1u) * nloc) {
            __builtin_amdgcn_fence(__ATOMIC_RELEASE, "agent");
            asm volatile("s_waitcnt vmcnt(0)" ::: "memory");
            const unsigned og = xb_add(&bar[XB_TOP], 1u);
            const unsigned tg = og / nx;
            if (og + 1u == (tg + 1u) * nx) xb_add(&bar[XB_TOPGEN], 1u);
            else XB_SPIN(xb_ld(&bar[XB_TOPGEN]) == tg, bar);
            __builtin_amdgcn_fence(__ATOMIC_ACQUIRE, "agent");
            xb_add(&bar[XB_XGEN(b.x)], 1u);
            asm volatile("s_waitcnt vmcnt(0)" ::: "memory");
        } else {
            XB_SPIN(xb_ld(&bar[XB_XGEN(b.x)]) == gen, bar);
            __builtin_amdgcn_fence(__ATOMIC_ACQUIRE, "agent");
            asm volatile("s_waitcnt vmcnt(0)" ::: "memory");
        }
    }
    __syncthreads();
}

constexpr size_t MiB = 1u << 20;
constexpr size_t SZB = (size_t)NTOK * DM * 2;
constexpr size_t WS_CTL = 0, CTL_ZERO_BYTES = 1 * MiB;
constexpr size_t WS_MOD = 1 * MiB;
constexpr size_t WS_LB = WS_MOD + 768 * 1024;
constexpr size_t WS_FP = 2 * MiB;
constexpr size_t WS_LS = 4 * MiB;
constexpr size_t WS_LIST = 6 * MiB;
constexpr size_t WS_ASGE = 10 * MiB;
constexpr size_t WS_ASGW = 10 * MiB + 512 * 1024;
constexpr size_t WS_WRT = 11 * MiB;
constexpr size_t WS_WAFT = 11 * MiB + 512 * 1024;
constexpr size_t WS_WIN = 12 * MiB;
constexpr size_t WS_WBR = WS_WIN + 72 * MiB;
constexpr size_t WS_WOUT = WS_WBR + 16 * MiB;
constexpr size_t WS_WGU = WS_WOUT + 8 * MiB;
constexpr size_t WS_WD = WS_WGU + 512 * MiB;
constexpr size_t WS_X1 = WS_WD + 256 * MiB;
constexpr size_t WS_HB = WS_X1 + 128 * MiB;
constexpr size_t WS_PROJ = WS_HB + 64 * MiB;
constexpr size_t WS_LF = WS_PROJ + 576 * MiB;
constexpr size_t WS_OAB = WS_LF + 128 * MiB;
constexpr size_t WS_HST = WS_OAB + 128 * MiB;
constexpr size_t WS_HTD = WS_HST + 12 * MiB;
constexpr size_t WS_EB = WS_HTD + 1 * MiB;
constexpr size_t WS_END = WS_EB + 6 * MiB;
constexpr size_t WS_Y = WS_PROJ;
constexpr size_t WS_MG = WS_PROJ + 2 * SZB;
constexpr int MOE_TILES_MAX = 544;
constexpr size_t WS_ACT = WS_PROJ;
constexpr size_t WS_YR = WS_PROJ + 272 * MiB;
static_assert(WS_YR + 272 * MiB <= WS_LF, "MoE buffers fit over the projection buffers");
static_assert(WS_END <= (size_t)2048 * MiB, "workspace map fits in 2 GiB");
constexpr int CW_BAR = 4096;
constexpr int CW_WQ = 8192;
constexpr int CW_NRM = 131072;
constexpr int CW_CNT = 16384;

constexpr int RING_OFF = 0, RING_BYTES = 131072;
constexpr int SPITCH = 1032;
constexpr int SCR_WAVE = 16640;
constexpr int TAB_OFF = 139264;
constexpr int T_MISC = TAB_OFF;
constexpr int T_TBASE = TAB_OFF + 256;
constexpr int T_CNT = TAB_OFF + 512;
constexpr int T_LCNT = TAB_OFF + 640;
constexpr int T_GBASE = TAB_OFF + 768;
constexpr int T_RT2E = TAB_OFF + 1024;
constexpr int T_ASG = TAB_OFF + 2048;
constexpr int PART_OFF = 147456;
constexpr int LDS_BYTES = 163840;
static_assert(8 * SCR_WAVE <= TAB_OFF && 8 * 4 * SPITCH * 4 <= TAB_OFF && T_ASG + 8 * 512 <= PART_OFF && PART_OFF + 16384 <= LDS_BYTES, "LDS map");

typedef float f32x2 __attribute__((ext_vector_type(2)));
typedef unsigned u32x2 __attribute__((ext_vector_type(2)));
typedef float f32x16 __attribute__((ext_vector_type(16)));
typedef short v4i16_t __attribute__((ext_vector_type(4)));
#define LDS_BARRIER() do { asm volatile("s_waitcnt lgkmcnt(0)" ::: "memory"); __builtin_amdgcn_s_barrier(); asm volatile("" ::: "memory"); } while (0)

__device__ __forceinline__ float wave_sum(float v) { return pg8::rows4_sum(pg8::row16_sum(v)); }
__device__ __forceinline__ void pair32(float& v, int& i) { auto a = __builtin_amdgcn_permlane32_swap(__float_as_uint(v), __float_as_uint(v), false, false); auto b = __builtin_amdgcn_permlane32_swap((unsigned)i, (unsigned)i, false, false);
    const float v0 = __uint_as_float(a[0]), v1 = __uint_as_float(a[1]); const int i0 = (int)b[0], i1 = (int)b[1]; const bool t = v1 > v0 || (v1 == v0 && i1 < i0); v = t ? v1 : v0; i = t ? i1 : i0; }
__device__ __forceinline__ void pair16(float& v, int& i) { auto a = __builtin_amdgcn_permlane16_swap(__float_as_uint(v), __float_as_uint(v), false, false); auto b = __builtin_amdgcn_permlane16_swap((unsigned)i, (unsigned)i, false, false);
    const float v0 = __uint_as_float(a[0]), v1 = __uint_as_float(a[1]); const int i0 = (int)b[0], i1 = (int)b[1]; const bool t = v1 > v0 || (v1 == v0 && i1 < i0); v = t ? v1 : v0; i = t ? i1 : i0; }
__device__ __forceinline__ unsigned pkbf(float lo, float hi) { return pg8::cvt_pk_bf16(lo, hi); }

struct TpRegs { f32x4 v[16]; };
__device__ __forceinline__ void tp_load(TpRegs& t, const float* __restrict__ src, int ld, int lane) {
#pragma unroll
    for (int i = 0; i < 16; ++i) { const int kk = 4 * i + (lane >> 4), nn = 4 * (lane & 15); t.v[i] = *(const GAS f32x4*)(src + (size_t)kk * ld + nn); }
}
__device__ __forceinline__ void tp_store(const TpRegs& t, bf16* __restrict__ dst, LAS float* scr, int lane) {
#pragma unroll
    for (int i = 0; i < 16; ++i) { const int kk = 4 * i + (lane >> 4), nn = 4 * (lane & 15);
        scr[(nn + 0) * 65 + kk] = t.v[i].x; scr[(nn + 1) * 65 + kk] = t.v[i].y; scr[(nn + 2) * 65 + kk] = t.v[i].z; scr[(nn + 3) * 65 + kk] = t.v[i].w; }
    LDS_WAIT(); asm volatile("" ::: "memory");
    const int kc = lane & 7;
#pragma unroll
    for (int i2 = 0; i2 < 8; ++i2) { const int n = (lane >> 3) + 8 * i2; const LAS float* s = scr + n * 65 + 8 * kc;
        v4u o; o.x = pkbf(s[0], s[1]); o.y = pkbf(s[2], s[3]); o.z = pkbf(s[4], s[5]); o.w = pkbf(s[6], s[7]);
        *(GAS v4u*)(dst + (size_t)n * DM + 8 * kc) = o; }
    LDS_WAIT(); asm volatile("" ::: "memory");
}
struct TpItem { const float* src; int ld; bf16* dst; };

struct Ptrs {
    const float *x, *c, *w_in, *fox_f_bias, *hg_lb_logits, *hg_norm_w, *w_branch, *w_out, *ada_w, *ada_b, *ln1_g, *ln1_b, *w_router, *b_router,
                *w_gate, *b_gate, *w_up, *b_up, *w_down, *b_down, *ln2_g, *ln2_b;
    float* out; unsigned char* ws;
};

__device__ __forceinline__ void p0_prologue(const Ptrs& P, LAS unsigned char* lds, int G, const int wv) {
    int tid_ = wv * 64 + (int)__builtin_amdgcn_mbcnt_hi(~0u, __builtin_amdgcn_mbcnt_lo(~0u, 0u)); asm volatile("" : "+v"(tid_)); const int tid = tid_, lane = tid & 63, wave = __builtin_amdgcn_readfirstlane(tid >> 6);
    unsigned char* ws = P.ws;
    {
        LAS float* cact = (LAS float*)(lds);
        LAS float* part = (LAS float*)(lds + 32768);
        for (int idx = tid; idx < NB * DM; idx += 512) { const int b = idx >> 10, k = idx & 1023; const float v = P.c[idx]; cact[k * 8 + b] = v / (1.0f + __expf(-v)); }
        __syncthreads();
        float* MOD = (float*)(ws + WS_MOD);
        for (int u = blockIdx.x; u < NLAYER * 96; u += G) {
            const int l = u / 96, cc = u % 96, col = cc * 64 + lane;
            const float* wp = P.ada_w + ((size_t)l * DM + wave * 128) * 6144 + col;
            float acc[8];
#pragma unroll
            for (int b = 0; b < 8; ++b) acc[b] = 0.f;
#pragma unroll 8
            for (int k = 0; k < 128; ++k) { const float wv = wp[(size_t)k * 6144]; const f32x4 c0 = *(const LAS f32x4*)(cact + (wave * 128 + k) * 8), c1 = *(const LAS f32x4*)(cact + (wave * 128 + k) * 8 + 4);
                acc[0] += c0.x * wv; acc[1] += c0.y * wv; acc[2] += c0.z * wv; acc[3] += c0.w * wv; acc[4] += c1.x * wv; acc[5] += c1.y * wv; acc[6] += c1.z * wv; acc[7] += c1.w * wv; }
#pragma unroll
            for (int b = 0; b < 8; ++b) part[(wave * 8 + b) * 64 + lane] = acc[b];
            __syncthreads();
            { const int b = tid >> 6; float s = 0.f;
#pragma unroll
              for (int w = 0; w < 8; ++w) s += part[(w * 8 + b) * 64 + lane];
              MOD[((size_t)l * NB + b) * 6144 + col] = s + P.ada_b[(size_t)l * 6144 + col]; }
            __syncthreads();
        }
    }
    if (blockIdx.x == G - 1) {
        float* LB = (float*)(ws + WS_LB);
        for (int d = tid; d < DM; d += 512) {
            const float a0 = P.hg_lb_logits[d], a1 = P.hg_lb_logits[DM + d], a2 = P.hg_lb_logits[2 * DM + d], a3 = P.hg_lb_logits[3 * DM + d];
            const float mx = fmaxf(fmaxf(a0, a1), fmaxf(a2, a3));
            const float e0 = expf(a0 - mx), e1 = expf(a1 - mx), e2 = expf(a2 - mx), e3 = expf(a3 - mx), inv = 1.0f / (e0 + e1 + e2 + e3);
            const float p1 = e1 * inv, p2 = e2 * inv, p3 = e3 * inv;
            LB[d] = 0.f; LB[DM + d] = fminf(fmaxf(p1, 0.f), 1.f); LB[2 * DM + d] = fminf(fmaxf(p1 + p2, 0.f), 1.f); LB[3 * DM + d] = fminf(fmaxf(p1 + p2 + p3, 0.f), 1.f);
        }
    }
    {
        bf16* WRT = (bf16*)(ws + WS_WRT); bf16* WAFT = (bf16*)(ws + WS_WAFT);
        for (int idx = blockIdx.x * 512 + tid; idx < NLAYER * (NEXP + 16) * DM; idx += G * 512) {
            const int l = idx / ((NEXP + 16) * DM), r = idx % ((NEXP + 16) * DM), n = r / DM, k = r % DM;
            const float w = n < NEXP ? P.w_router[((size_t)l * DM + k) * NEXP + n] : P.w_in[((size_t)l * DM + k) * PIN + 7168 + (n - NEXP)];
            const unsigned hb = f2bf(w); const float hf = __uint_as_float(hb << 16); const unsigned lb_ = f2bf(w - hf);
            if (n < NEXP) { WRT[(((size_t)l * 2 + 0) * NEXP + n) * DM + k] = (bf16)hb; WRT[(((size_t)l * 2 + 1) * NEXP + n) * DM + k] = (bf16)lb_; }
            else { WAFT[(((size_t)l * 2 + 0) * 16 + (n - NEXP)) * DM + k] = (bf16)hb; WAFT[(((size_t)l * 2 + 1) * 16 + (n - NEXP)) * DM + k] = (bf16)lb_; }
        }
    }
    __syncthreads();
    {
        LAS float* scr = (LAS float*)(lds + wave * SCR_WAVE);
        const int gw = blockIdx.x * 8 + wave, NGW = G * 8;
        constexpr int I_IN1 = 16 * 112, I_IN2 = 16 * 32, I_BR = 2 * 256, I_OUT = 256, I_EXP = 768, I_MOE = NEXP * I_EXP;
        constexpr int I_LAYER = I_IN1 + I_IN2 + I_BR + I_OUT + I_MOE, I_ALL = NLAYER * I_LAYER;
        auto decode = [&](int it) -> TpItem {
            const int l = it / I_LAYER; int r = it % I_LAYER; TpItem t;
            if (r < I_IN1) { const int kb = r / 112, nb = r % 112;
                const int n0 = nb * 64, drow = n0 < 1024 ? 256 * (n0 >> 7) + (n0 & 127) : (n0 < 2048 ? 256 * ((n0 - 1024) >> 7) + 128 + (n0 & 127) : n0);
                t.src = P.w_in + ((size_t)l * DM + kb * 64) * PIN + n0; t.ld = PIN; t.dst = (bf16*)(ws + WS_WIN) + ((size_t)l * NPROJ + drow) * DM + kb * 64; return t; }
            r -= I_IN1;
            if (r < I_IN2) { const int kb = r / 32, nb = r % 32;
                t.src = P.w_in + ((size_t)l * DM + kb * 64) * PIN + 7184 + nb * 64; t.ld = PIN; t.dst = (bf16*)(ws + WS_WIN) + ((size_t)l * NPROJ + 7168 + nb * 64) * DM + kb * 64; return t; }
            r -= I_IN2;
            if (r < I_BR) { const int half = r / 256, q = r % 256, kb = q / 16, nb = q % 16;
                t.src = P.w_branch + ((size_t)l * 2048 + half * 1024 + kb * 64) * DM + nb * 64; t.ld = DM; t.dst = (bf16*)(ws + WS_WBR) + (((size_t)l * 2 + half) * DM + nb * 64) * DM + kb * 64; return t; }
            r -= I_BR;
            if (r < I_OUT) { const int kb = r / 16, nb = r % 16;
                t.src = P.w_out + ((size_t)l * DM + kb * 64) * DM + nb * 64; t.ld = DM; t.dst = (bf16*)(ws + WS_WOUT) + ((size_t)l * DM + nb * 64) * DM + kb * 64; return t; }
            r -= I_OUT;
            const int e = r / I_EXP, q = r % I_EXP, which = q / 256, q2 = q % 256, kb = q2 / 16, nb = q2 % 16;
            const size_t le = (size_t)l * NEXP + e; t.ld = DM;
            if (which == 0) { t.src = P.w_gate + (le * DM + kb * 64) * DM + nb * 64; t.dst = (bf16*)(ws + WS_WGU) + (le * 2048 + 256 * (nb >> 1) + 64 * (nb & 1)) * DM + kb * 64; }
            else if (which == 1) { t.src = P.w_up + (le * DM + kb * 64) * DM + nb * 64; t.dst = (bf16*)(ws + WS_WGU) + (le * 2048 + 256 * (nb >> 1) + 128 + 64 * (nb & 1)) * DM + kb * 64; }
            else { t.src = P.w_down + (le * DM + kb * 64) * DM + nb * 64; t.dst = (bf16*)(ws + WS_WD) + (le * DM + nb * 64) * DM + kb * 64; }
            return t;
        };
        TpRegs cur, nxt; TpItem ci, ni;
        int it = gw;
        if (it < I_ALL) { ci = decode(it); tp_load(cur, ci.src, ci.ld, lane); }
        for (; it < I_ALL; it += NGW) {
            const bool more = it + NGW < I_ALL;
            if (more) { ni = decode(it + NGW); tp_load(nxt, ni.src, ni.ld, lane); }
            tp_store(cur, ci.dst, scr, lane);
            if (more) { cur = nxt; ci = ni; }
        }
    }
    __syncthreads();
}

struct RowV { f32x4 v[4]; };
__device__ __forceinline__ RowV ld_row(const float* p, int lane) { RowV r; const GAS f32x4* q = (const GAS f32x4*)p + lane;
#pragma unroll
    for (int j = 0; j < 4; ++j) r.v[j] = q[64 * j];
    return r; }
struct RowB { u32x2 v[4]; };
__device__ __forceinline__ RowB ld_row_bf16(const bf16* p, int lane) { RowB r; const GAS u32x2* q = (const GAS u32x2*)p + lane;
#pragma unroll
    for (int j = 0; j < 4; ++j) r.v[j] = q[64 * j];
    return r; }
__device__ __forceinline__ RowV row_b2f(const RowB& b) { RowV r;
#pragma unroll
    for (int j = 0; j < 4; ++j) r.v[j] = (f32x4){pg8::bf_lo(b.v[j].x), pg8::bf_hi(b.v[j].x), pg8::bf_lo(b.v[j].y), pg8::bf_hi(b.v[j].y)};
    return r; }
__device__ __forceinline__ void st_row(float* p, int lane, const RowV& r) { GAS f32x4* q = (GAS f32x4*)p + lane;
#pragma unroll
    for (int j = 0; j < 4; ++j) q[64 * j] = r.v[j]; }
__device__ __forceinline__ void st_row_bf16(bf16* p, int lane, const RowV& r) { GAS u32x2* q = (GAS u32x2*)p + lane;
#pragma unroll
    for (int j = 0; j < 4; ++j) { u32x2 w; w.x = pkbf(r.v[j].x, r.v[j].y); w.y = pkbf(r.v[j].z, r.v[j].w); q[64 * j] = w; } }
__device__ __forceinline__ void st_row_lds(LAS float* p, int lane, const RowV& r) { LAS f32x4* q = (LAS f32x4*)p + lane;
#pragma unroll
    for (int j = 0; j < 4; ++j) q[64 * j] = r.v[j]; }
__device__ __forceinline__ void ln_stats(const RowV& r, float& mean, float& rstd, float eps) {
    float s = 0.f;
#pragma unroll
    for (int j = 0; j < 4; ++j) s += (r.v[j].x + r.v[j].y) + (r.v[j].z + r.v[j].w);
    mean = wave_sum(s) * (1.0f / DM); float q = 0.f;
#pragma unroll
    for (int j = 0; j < 4; ++j) { const f32x4 d = r.v[j] - mean; q += (d.x * d.x + d.y * d.y) + (d.z * d.z + d.w * d.w); }
    rstd = 1.0f / sqrtf(wave_sum(q) * (1.0f / DM) + eps);
}
__device__ __forceinline__ float log_sigmoid(float x) { return fminf(x, 0.f) - log1pf(expf(-fabsf(x))); }
template <int NT>
__device__ __forceinline__ void dots_partial(const LAS float* stage0, const bf16* __restrict__ whi, const bf16* __restrict__ wlo, LAS f32x4* part, int wave, int lane) {
    const int rt = wave & 1, kq = wave >> 1, fr = lane & 15, fq = lane >> 4; const LAS float* hp = stage0 + (16 * rt + fr) * SPITCH + 256 * kq + 8 * fq;
    f32x4 acc[NT];
#pragma unroll
    for (int t = 0; t < NT; ++t) acc[t] = (f32x4){0.f, 0.f, 0.f, 0.f};
    const bf16* wh = whi + (size_t)fr * DM + 256 * kq + 8 * fq; const bf16* wl = wlo + (size_t)fr * DM + 256 * kq + 8 * fq;
#pragma unroll
    for (int s = 0; s < 8; ++s) {
        const f32x4 h0 = *(const LAS f32x4*)(hp + 32 * s), h1 = *(const LAS f32x4*)(hp + 32 * s + 4);
        v4u hi; hi.x = pkbf(h0.x, h0.y); hi.y = pkbf(h0.z, h0.w); hi.z = pkbf(h1.x, h1.y); hi.w = pkbf(h1.z, h1.w);
        v4u lo; lo.x = pkbf(h0.x - pg8::bf_lo(hi.x), h0.y - pg8::bf_hi(hi.x)); lo.y = pkbf(h0.z - pg8::bf_lo(hi.y), h0.w - pg8::bf_hi(hi.y));
        lo.z = pkbf(h1.x - pg8::bf_lo(hi.z), h1.y - pg8::bf_hi(hi.z)); lo.w = pkbf(h1.z - pg8::bf_lo(hi.w), h1.w - pg8::bf_hi(hi.w));
        const bf16x8 hhi = __builtin_bit_cast(bf16x8, hi), hlo = __builtin_bit_cast(bf16x8, lo);
#pragma unroll
        for (int t = 0; t < NT; ++t) {
            const bf16x8 a_hi = *(const GAS bf16x8*)(wh + (size_t)t * 16 * DM + 32 * s), a_lo = *(const GAS bf16x8*)(wl + (size_t)t * 16 * DM + 32 * s);
            acc[t] = __builtin_amdgcn_mfma_f32_16x16x32_bf16(a_hi, hhi, acc[t], 0, 0, 0);
            acc[t] = __builtin_amdgcn_mfma_f32_16x16x32_bf16(a_hi, hlo, acc[t], 0, 0, 0);
            acc[t] = __builtin_amdgcn_mfma_f32_16x16x32_bf16(a_lo, hhi, acc[t], 0, 0, 0);
        }
    }
#pragma unroll
    for (int t = 0; t < NT; ++t) part[((kq * 2 + rt) * NT + t) * 64 + lane] = acc[t];
}
template <int NT>
__device__ __forceinline__ void dots_final(const LAS f32x4* part, f32x4 (&out)[NT], int rt, int lane) {
#pragma unroll
    for (int t = 0; t < NT; ++t) { f32x4 a = part[((0 * 2 + rt) * NT + t) * 64 + lane];
#pragma unroll
        for (int kq = 1; kq < 4; ++kq) a += part[((kq * 2 + rt) * NT + t) * 64 + lane];
        out[t] = a; }
}
__device__ __forceinline__ int staged_tok(int j, int it, int RPW) { return (blockIdx.x * 8 + (j >> 2)) * RPW + 4 * it + (j & 3); }
__device__ __forceinline__ void af_block(LAS unsigned char* lds, const bf16* __restrict__ waft, const float* __restrict__ fbias, float* LS, int it, int RPW, int wave, int lane) {
    LAS f32x4* part = (LAS f32x4*)(lds + PART_OFF);
    dots_partial<1>((const LAS float*)lds, waft, waft + 16 * DM, part, wave, lane);
    LDS_BARRIER();
    if (wave < 2) { f32x4 acc[1]; dots_final<1>(part, acc, wave, lane);
        const int fr = lane & 15, fq = lane >> 4; const f32x4 bv = *(const GAS f32x4*)(fbias + 4 * fq);
        *(GAS f32x4*)(LS + (size_t)staged_tok(16 * wave + fr, it, RPW) * 16 + 4 * fq) = (f32x4){log_sigmoid(acc[0].x + bv.x), log_sigmoid(acc[0].y + bv.y), log_sigmoid(acc[0].z + bv.z), log_sigmoid(acc[0].w + bv.w)}; }
}

__device__ __forceinline__ void phase_a0(const Ptrs& P, LAS unsigned char* lds, int G, const int wv) {
    int tid_ = wv * 64 + (int)__builtin_amdgcn_mbcnt_hi(~0u, __builtin_amdgcn_mbcnt_lo(~0u, 0u)); asm volatile("" : "+v"(tid_)); const int tid = tid_, lane = tid & 63, wave = __builtin_amdgcn_readfirstlane(tid >> 6); (void)tid;
    unsigned char* ws = P.ws; const int RPW = NTOK / (G * 8); const int m0 = (blockIdx.x * 8 + wave) * RPW, b = m0 / SEQL;
    const float* MOD = (const float*)(ws + WS_MOD) + (size_t)(0 * NB + b) * 6144;
    const RowV sh1 = ld_row(MOD, lane), sc1 = ld_row(MOD + DM, lane);
    LAS float* stage = (LAS float*)(lds + wave * (4 * SPITCH * 4));
    RowV xnext = ld_row(P.x + (size_t)m0 * DM, lane);
    for (int rg = 0; rg < RPW / 4; ++rg) {
        for (int r = 0; r < 4; ++r) { const int m = m0 + rg * 4 + r; RowV xv = xnext;
            if (rg * 4 + r + 1 < RPW) xnext = ld_row(P.x + (size_t)(m + 1) * DM, lane);
#pragma unroll
            for (int j = 0; j < 4; ++j) xv.v[j] = xv.v[j] * (sc1.v[j] + 1.0f) + sh1.v[j];
            st_row_bf16((bf16*)(ws + WS_HB) + (size_t)m * DM, lane, xv); st_row_lds(stage + r * SPITCH, lane, xv); }
        LDS_BARRIER();
        af_block(lds, (const bf16*)(ws + WS_WAFT), P.fox_f_bias, (float*)(ws + WS_LS), rg, RPW, wave, lane);
        LDS_BARRIER();
    }
}

__device__ __forceinline__ void phase_f(const Ptrs& P, LAS unsigned char* lds, int l, const float* xcur, int G, const int wv, bool build_lists = true) {
    int tid_ = wv * 64 + (int)__builtin_amdgcn_mbcnt_hi(~0u, __builtin_amdgcn_mbcnt_lo(~0u, 0u)); asm volatile("" : "+v"(tid_)); const int tid = tid_, lane = tid & 63, wave = __builtin_amdgcn_readfirstlane(tid >> 6);
    unsigned char* ws = P.ws; const int RPW = NTOK / (G * 8); const int m0 = (blockIdx.x * 8 + wave) * RPW, b = m0 / SEQL;
    LAS int* lcnt = (LAS int*)(lds + T_LCNT); LAS int* gbase = (LAS int*)(lds + T_GBASE);
    LAS int* aE = (LAS int*)(lds + T_ASG); LAS float* aW = (LAS float*)(lds + T_ASG + 2048);
    if (tid < 32) lcnt[tid] = 0;
    __syncthreads();
    {
        const float* MOD = (const float*)(ws + WS_MOD) + (size_t)(l * NB + b) * 6144;
        const RowV g1 = ld_row(MOD + 2 * DM, lane), sh2 = ld_row(MOD + 3 * DM, lane), sc2 = ld_row(MOD + 4 * DM, lane);
        const RowV lng = ld_row(P.ln1_g + (size_t)l * DM, lane), lnb = ld_row(P.ln1_b + (size_t)l * DM, lane);
        LAS float* stage = (LAS float*)(lds + wave * (4 * SPITCH * 4));
        const bf16* wrt = (const bf16*)(ws + WS_WRT) + (size_t)l * 2 * NEXP * DM; const float* br = P.b_router + (size_t)l * NEXP;
        const bf16* Y = (const bf16*)(ws + WS_Y);
        RowV xnext = ld_row(xcur + (size_t)m0 * DM, lane); RowB ynext = ld_row_bf16(Y + (size_t)m0 * DM, lane);
        for (int rg = 0; rg < RPW / 4; ++rg) {
            for (int r = 0; r < 4; ++r) { const int m = m0 + rg * 4 + r;
                RowV xv = xnext; const RowV yv = row_b2f(ynext);
                if (rg * 4 + r + 1 < RPW) { xnext = ld_row(xcur + (size_t)(m + 1) * DM, lane); ynext = ld_row_bf16(Y + (size_t)(m + 1) * DM, lane); }
#pragma unroll
                for (int j = 0; j < 4; ++j) xv.v[j] = xv.v[j] * DN_ALPHA + (g1.v[j] + 1.0f) * yv.v[j];
                float mean, rstd; ln_stats(xv, mean, rstd, 1e-5f);
#pragma unroll
                for (int j = 0; j < 4; ++j) xv.v[j] = (xv.v[j] - mean) * rstd * lng.v[j] + lnb.v[j];
                st_row_bf16((bf16*)(ws + WS_X1) + (size_t)m * DM, lane, xv);
#pragma unroll
                for (int j = 0; j < 4; ++j) xv.v[j] = xv.v[j] * (sc2.v[j] + 1.0f) + sh2.v[j];
                st_row_bf16((bf16*)(ws + WS_HB) + (size_t)m * DM, lane, xv); st_row_lds(stage + r * SPITCH, lane, xv); }
            LDS_BARRIER();
            LAS f32x4* part = (LAS f32x4*)(lds + PART_OFF);
            dots_partial<2>((const LAS float*)lds, wrt, wrt + (size_t)NEXP * DM, part, wave, lane);
            LDS_BARRIER();
            if (wave < 2) {
                f32x4 lg[2]; dots_final<2>(part, lg, wave, lane);
                const int fr = lane & 15, fq = lane >> 4;
                float cv[8]; int ci[8];
                { const f32x4 b0 = *(const GAS f32x4*)(br + 4 * fq), b1 = *(const GAS f32x4*)(br + 16 + 4 * fq);
#pragma unroll
                  for (int i = 0; i < 4; ++i) { cv[i] = lg[0][i] + b0[i]; ci[i] = 4 * fq + i; cv[4 + i] = lg[1][i] + b1[i]; ci[4 + i] = 16 + 4 * fq + i; } }
                float tv[4]; int ti[4];
#pragma unroll
                for (int k = 0; k < 4; ++k) {
                    float bv = cv[0]; int bi = ci[0];
#pragma unroll
                    for (int i = 1; i < 8; ++i) if (cv[i] > bv) { bv = cv[i]; bi = ci[i]; }
                    pair16(bv, bi); pair32(bv, bi);
                    tv[k] = bv; ti[k] = bi;
#pragma unroll
                    for (int i = 0; i < 8; ++i) if (ci[i] == bi) cv[i] = -INFINITY;
                }
                const float e1 = expf(tv[1] - tv[0]), e2 = expf(tv[2] - tv[0]), e3 = expf(tv[3] - tv[0]), inv = 1.0f / (1.0f + e1 + e2 + e3);
                const int slot = rg * 128 + (16 * wave + fr) * 4;
                if (fq == 0) { aE[slot] = ti[0]; aW[slot] = inv; } else if (fq == 1) { aE[slot + 1] = ti[1]; aW[slot + 1] = e1 * inv; }
                else if (fq == 2) { aE[slot + 2] = ti[2]; aW[slot + 2] = e2 * inv; } else { aE[slot + 3] = ti[3]; aW[slot + 3] = e3 * inv; }
            }
            LDS_BARRIER();
        }
    }
    if (!build_lists) { __syncthreads(); return; }
    const int nasg = RPW * 32; int e = 0, lpos = 0; float w = 0.f;
    if (tid < nasg) { e = aE[tid]; w = aW[tid]; lpos = __hip_atomic_fetch_add(lcnt + e, 1, __ATOMIC_RELAXED, __HIP_MEMORY_SCOPE_WORKGROUP); }
    __syncthreads();
    if (tid < 32) { const int n = lcnt[tid]; gbase[tid] = n ? (int)__hip_atomic_fetch_add((unsigned*)(ws + WS_CTL) + CW_CNT + (l * NEXP + tid) * 64, (unsigned)n, __ATOMIC_RELAXED, __HIP_MEMORY_SCOPE_AGENT) : 0; }
    __syncthreads();
    if (tid < nasg) { const int pos = gbase[e] + lpos, tok = staged_tok((tid >> 2) & 31, tid >> 7, RPW);
        ((int*)(ws + WS_LIST))[(size_t)e * NTOK + pos] = tok; ((int*)(ws + WS_ASGE))[(size_t)tok * 4 + (tid & 3)] = (e << 16) | pos; ((float*)(ws + WS_ASGW))[(size_t)tok * 4 + (tid & 3)] = w; }
}

__device__ __forceinline__ int moe_tables(const Ptrs& P, LAS unsigned char* lds, int l, const int wv) {
    int tid_ = wv * 64 + (int)__builtin_amdgcn_mbcnt_hi(~0u, __builtin_amdgcn_mbcnt_lo(~0u, 0u)); asm volatile("" : "+v"(tid_)); const int tid = tid_;
    LAS int* tbase = (LAS int*)(lds + T_TBASE); LAS int* cnt = (LAS int*)(lds + T_CNT); LAS unsigned char* rt2e = (LAS unsigned char*)(lds + T_RT2E);
    __syncthreads();
    if (tid < 32) cnt[tid] = (int)__hip_atomic_load((unsigned*)(P.ws + WS_CTL) + CW_CNT + (l * NEXP + tid) * 64, __ATOMIC_RELAXED, __HIP_MEMORY_SCOPE_AGENT);
    __syncthreads();
    if (tid == 0) { int s = 0; for (int e = 0; e < NEXP; ++e) { tbase[e] = s; s += (cnt[e] + 255) >> 8; } tbase[NEXP] = s; }
    __syncthreads();
    if (tid < 32) { for (int rt = tbase[tid]; rt < tbase[tid + 1]; ++rt) rt2e[rt] = (unsigned char)tid; }
    __syncthreads();
    return tbase[NEXP];
}

__device__ __forceinline__ void phase_j(const Ptrs& P, LAS unsigned char* lds, int l, int G, const int wv) {
    int tid_ = wv * 64 + (int)__builtin_amdgcn_mbcnt_hi(~0u, __builtin_amdgcn_mbcnt_lo(~0u, 0u)); asm volatile("" : "+v"(tid_)); const int tid = tid_, lane = tid & 63, wave = __builtin_amdgcn_readfirstlane(tid >> 6); (void)tid;
    unsigned char* ws = P.ws; const int RPW = NTOK / (G * 8); const int m0 = (blockIdx.x * 8 + wave) * RPW, b = m0 / SEQL;
    const LAS int* tbase = (const LAS int*)(lds + T_TBASE);
    const float* MOD = (const float*)(ws + WS_MOD) + (size_t)(l * NB + b) * 6144;
    const RowV g2 = ld_row(MOD + 5 * DM, lane);
    const RowV lng = ld_row(P.ln2_g + (size_t)l * DM, lane), lnb = ld_row(P.ln2_b + (size_t)l * DM, lane);
    const bool more = l + 1 < NLAYER;
    RowV sh1, sc1;
    { const float* MODN = (const float*)(ws + WS_MOD) + (size_t)((more ? l + 1 : l) * NB + b) * 6144; sh1 = ld_row(MODN, lane); sc1 = ld_row(MODN + DM, lane); }
    LAS float* stage = (LAS float*)(lds + wave * (4 * SPITCH * 4));
    const bf16* YR = (const bf16*)(ws + WS_YR); const bf16* X1 = (const bf16*)(ws + WS_X1);
    const unsigned asge = ((const unsigned*)(ws + WS_ASGE))[(size_t)m0 * 4 + lane]; const float asgw = ((const float*)(ws + WS_ASGW))[(size_t)m0 * 4 + lane];
    struct JRow { u32x2 y[4][4]; RowB x; };
    auto jload = [&](int i, JRow& R) {
#pragma unroll
        for (int k = 0; k < 4; ++k) { const unsigned a = __builtin_amdgcn_readlane(asge, 4 * i + k); const int e = (int)(a >> 16), pos = (int)(a & 0xffffu); const size_t slot = (size_t)tbase[e] * 256 + pos;
            const GAS u32x2* q = (const GAS u32x2*)(YR + slot * DM) + lane;
#pragma unroll
            for (int j = 0; j < 4; ++j) R.y[k][j] = q[64 * j]; }
        R.x = ld_row_bf16(X1 + (size_t)(m0 + i) * DM, lane);
    };
    JRow rnext; jload(0, rnext);
    for (int rg = 0; rg < RPW / 4; ++rg) {
        for (int r = 0; r < 4; ++r) { const int i = rg * 4 + r, m = m0 + i;
            const JRow rc = rnext;
            if (i + 1 < RPW) jload(i + 1, rnext);
            RowV y;
#pragma unroll
            for (int j = 0; j < 4; ++j) y.v[j] = (f32x4){0.f, 0.f, 0.f, 0.f};
#pragma unroll
            for (int k = 0; k < 4; ++k) { const float wk = __uint_as_float(__builtin_amdgcn_readlane(__float_as_uint(asgw), 4 * i + k));
#pragma unroll
                for (int j = 0; j < 4; ++j) { const u32x2 t = rc.y[k][j]; y.v[j].x += wk * pg8::bf_lo(t.x); y.v[j].y += wk * pg8::bf_hi(t.x); y.v[j].z += wk * pg8::bf_lo(t.y); y.v[j].w += wk * pg8::bf_hi(t.y); } }
            RowV xv = row_b2f(rc.x);
#pragma unroll
            for (int j = 0; j < 4; ++j) xv.v[j] = xv.v[j] * DN_ALPHA + (g2.v[j] + 1.0f) * y.v[j];
            float mean, rstd; ln_stats(xv, mean, rstd, 1e-5f);
#pragma unroll
            for (int j = 0; j < 4; ++j) xv.v[j] = (xv.v[j] - mean) * rstd * lng.v[j] + lnb.v[j];
            st_row(P.out + (size_t)m * DM, lane, xv);
            if (more) {
#pragma unroll
                for (int j = 0; j < 4; ++j) xv.v[j] = xv.v[j] * (sc1.v[j] + 1.0f) + sh1.v[j];
                st_row_bf16((bf16*)(ws + WS_HB) + (size_t)m * DM, lane, xv); st_row_lds(stage + r * SPITCH, lane, xv); }
        }
        if (more) {
            LDS_BARRIER();
            af_block(lds, (const bf16*)(ws + WS_WAFT) + (size_t)(l + 1) * 2 * 16 * DM, P.fox_f_bias + (l + 1) * 16, (float*)(ws + WS_LS), rg, RPW, wave, lane);
            LDS_BARRIER();
        }
    }
}

__device__ __forceinline__ void fscan(const Ptrs& P, LAS unsigned char* lds, const int wv) {
    int tid_ = wv * 64 + (int)__builtin_amdgcn_mbcnt_hi(~0u, __builtin_amdgcn_mbcnt_lo(~0u, 0u)); asm volatile("" : "+v"(tid_)); const int tid = tid_, lane = tid & 63, wave = __builtin_amdgcn_readfirstlane(tid >> 6);
    const int bh = blockIdx.x >> 1, hf = blockIdx.x & 1, b = bh >> 4, h = bh & 15;
    const float* LS = (const float*)(P.ws + WS_LS) + ((size_t)b * SEQL + 2048 * hf + 4 * tid) * 16 + h; float* FP = (float*)(P.ws + WS_FP) + (size_t)bh * SEQL + 2048 * hf + 4 * tid;
    LAS float* wt = (LAS float*)(lds);
    float v[4], pre = 0.f;
#pragma unroll
    for (int j = 0; j < 4; ++j) v[j] = LS[j * 16];
    if (hf) { const float* L0 = (const float*)(P.ws + WS_LS) + ((size_t)b * SEQL + 4 * tid) * 16 + h; pre = (L0[0] + L0[16]) + (L0[32] + L0[48]); }
#pragma unroll
    for (int j = 1; j < 4; ++j) v[j] += v[j - 1];
    pre = wave_sum(pre);
    float inc = v[3];
    { const float rs = pg8::row16_scan(inc), rt = pg8::row16_sum(inc);
      const float r0 = __uint_as_float(__builtin_amdgcn_readlane(__float_as_uint(rt), 15)), r1 = __uint_as_float(__builtin_amdgcn_readlane(__float_as_uint(rt), 31)), r2 = __uint_as_float(__builtin_amdgcn_readlane(__float_as_uint(rt), 47));
      inc = rs + (lane >= 16 ? r0 : 0.f) + (lane >= 32 ? r1 : 0.f) + (lane >= 48 ? r2 : 0.f); }
    if (lane == 63) { wt[wave] = inc; wt[8 + wave] = pre; }
    __syncthreads();
    float off = inc - v[3];
    for (int w = 0; w < wave; ++w) off += wt[w];
    for (int w = 0; w < 8; ++w) off += wt[8 + w];
    *(GAS f32x4*)(FP) = (f32x4){(off + v[0]) * LOG2E, (off + v[1]) * LOG2E, (off + v[2]) * LOG2E, (off + v[3]) * LOG2E};
    __syncthreads();
}

namespace hg {
constexpr int L_QP = 0, L_KP = 16384, L_IV = 32768, L_SP = 49152, L_PM = 81920, L_O = 91136, L_TOT = 123904, L_EBM = 128000, L_EBL = 128512;
constexpr int PM_PITCH = 144;
static_assert(L_EBL + 512 <= RING_BYTES, "HGRN LDS map");
__device__ __forceinline__ int off_b(int row, int ch) { return 256 * row + 16 * (ch ^ (((row & 3) << 2) | ((row >> 2) & 3))); }
__device__ __forceinline__ bf16x8 row_frag(const LAS unsigned char* img, int row0, int s, int lane) { return *(const LAS bf16x8*)(img + off_b(row0 + (lane & 31), 2 * s + (lane >> 5))); }
__device__ __forceinline__ bf16x8 tr_frag(const LAS unsigned char* img, int c, int ks, int lane) {
    const int hh = lane >> 5, blk = (lane >> 4) & 1, q = (lane & 15) >> 2, p = lane & 3;
    const LAS unsigned char* a0 = img + off_b(16 * ks + 8 * hh + q, 4 * c + 2 * blk + (p >> 1)) + 8 * (p & 1);
    const LAS unsigned char* a1 = img + off_b(16 * ks + 8 * hh + 4 + q, 4 * c + 2 * blk + (p >> 1)) + 8 * (p & 1);
    const v4i16_t lo = __builtin_amdgcn_ds_read_tr16_b64_v4i16((LAS v4i16_t*)a0), hi = __builtin_amdgcn_ds_read_tr16_b64_v4i16((LAS v4i16_t*)a1);
    return (bf16x8){lo[0], lo[1], lo[2], lo[3], hi[0], hi[1], hi[2], hi[3]};
}
#define HG_MFMA(a, b, c) __builtin_amdgcn_mfma_f32_32x32x16_bf16((a), (b), (c), 0, 0, 0)

__device__ __forceinline__ void hgrn_unit(int b, int h, int seg, bool do_out, int st_slot, const bf16* __restrict__ QS, const float* __restrict__ EB, const bf16* __restrict__ KK, const bf16* __restrict__ IV, const bf16* __restrict__ SG,
                                          const float* __restrict__ nw, bf16* __restrict__ OA, float* __restrict__ HST, float* __restrict__ HTD, LAS unsigned char* lds, const int wv) {
    int tid_ = wv * 64 + (int)__builtin_amdgcn_mbcnt_hi(~0u, __builtin_amdgcn_mbcnt_lo(~0u, 0u)); asm volatile("" : "+v"(tid_));
    const int tid = tid_, lane = tid & 63, wid = __builtin_amdgcn_readfirstlane(tid >> 6);
    const int r = lane & 31, hh = lane >> 5;
    const size_t colb = (size_t)h * 128;
    const size_t hbase = (size_t)h * NTOK * 128;
    const int ct = tid >> 3, cpart = tid & 7;
    float nwv[16];
#pragma unroll
    for (int i = 0; i < 16; ++i) nwv[i] = nw[16 * cpart + i];
    f32x16 Sacc[2];
#pragma unroll
    for (int i = 0; i < 16; ++i) { Sacc[0][i] = 0.f; Sacc[1][i] = 0.f; }
    const int bh8 = b * 8 + h;
    if (do_out && seg > 0) {
        const size_t so = ((size_t)bh8 * 8 + wid) * 2 * 16 * 64 + lane; const size_t slot = (size_t)64 * 8 * 2 * 16 * 64;
        float d1[16], d2[16];
#pragma unroll
        for (int i = 0; i < 16; ++i) { const int d = 32 * (wid >> 1) + (i & 3) + 8 * (i >> 2) + 4 * hh; d1[i] = seg >= 2 ? __expf(HTD[(size_t)bh8 * 128 + d]) : 1.f; d2[i] = seg >= 3 ? __expf(HTD[(size_t)(64 + bh8) * 128 + d]) : 1.f; }
#pragma unroll
        for (int tl = 0; tl < 2; ++tl)
#pragma unroll
            for (int i = 0; i < 16; ++i) { float v = HST[so + (size_t)(tl * 16 + i) * 64];
                if (seg >= 2) v = v * d1[i] + HST[slot + so + (size_t)(tl * 16 + i) * 64];
                if (seg >= 3) v = v * d2[i] + HST[2 * slot + so + (size_t)(tl * 16 + i) * 64];
                Sacc[tl][i] = v; }
    }
    float td0 = 0.f, td1 = 0.f;
    const int cbeg = 16 * seg, cend = 16 * seg + 16;
    v4u qv[2], kv[2], ivr[2], sgr[2]; f32x2 eb0 = {0.f, 0.f}, eb1 = {0.f, 0.f}, eb2 = {0.f, 0.f};
#define HG_LOAD(c) do { const size_t rb_ = (size_t)b * SEQL + (size_t)(c) * 64; \
        _Pragma("unroll") for (int i = 0; i < 2; ++i) { const int idx_ = tid + 512 * i; const size_t o_ = hbase + rb_ * 128 + 8 * (size_t)idx_; \
            if (do_out) qv[i] = *(const GAS v4u*)(QS + o_); kv[i] = *(const GAS v4u*)(KK + o_); ivr[i] = *(const GAS v4u*)(IV + o_); } \
        if (do_out) { _Pragma("unroll") for (int i = 0; i < 2; ++i) sgr[i] = *(const GAS v4u*)(SG + hbase + (rb_ + ct) * 128 + 16 * cpart + 8 * i); } \
        if (wid == 0) { const size_t eo_ = (rb_ >> 6) * DM + colb + 2 * lane; const size_t es_ = (size_t)(NTOK / 64) * DM; \
            eb0 = *(const GAS f32x2*)(EB + eo_); eb1 = *(const GAS f32x2*)(EB + es_ + eo_); eb2 = *(const GAS f32x2*)(EB + 2 * es_ + eo_); } } while (0)
    HG_LOAD(cbeg);
    for (int c = cbeg; c < cend; ++c) {
#pragma unroll
        for (int i = 0; i < 2; ++i) { const int idx_ = tid + 512 * i, o_ = off_b(idx_ >> 4, idx_ & 15);
            *(LAS v4u*)(lds + L_KP + o_) = kv[i]; *(LAS v4u*)(lds + L_IV + o_) = ivr[i];
            if (do_out) *(LAS v4u*)(lds + L_QP + o_) = qv[i]; }
        if (wid == 0) { *(LAS f32x2*)(lds + L_EBM + 8 * lane) = eb0; *(LAS f32x2*)(lds + L_EBL + 8 * lane) = eb1; td0 += eb2.x; td1 += eb2.y; }
        const v4u sg0 = sgr[0], sg1 = sgr[1];
#ifdef HG_REP_LOAD
        if (c + 1 < cend) { HG_LOAD(c + 1); asm volatile("" ::: "memory"); }
#endif
        if (c + 1 < cend) HG_LOAD(c + 1);
        LDS_BARRIER();
        {
            const int db = wid >> 1, vb0 = 2 * (wid & 1);
            float em[16], el[16];
#pragma unroll
            for (int g = 0; g < 4; ++g) { const f32x4 a = *(const LAS f32x4*)(lds + L_EBM + (32 * db + 8 * g + 4 * hh) * 4), e2 = *(const LAS f32x4*)(lds + L_EBL + (32 * db + 8 * g + 4 * hh) * 4);
                em[4 * g] = a.x; em[4 * g + 1] = a.y; em[4 * g + 2] = a.z; em[4 * g + 3] = a.w; el[4 * g] = e2.x; el[4 * g + 1] = e2.y; el[4 * g + 2] = e2.z; el[4 * g + 3] = e2.w; }
#pragma unroll
            for (int tl = 0; tl < 2; ++tl) { const int vb = vb0 + tl;
#pragma unroll
                for (int i = 0; i < 16; ++i) Sacc[tl][i] *= em[i];
                if (do_out) {
#pragma unroll
                for (int g = 0; g < 4; ++g) { u32x2 w; w.x = pkbf(Sacc[tl][4 * g], Sacc[tl][4 * g + 1]); w.y = pkbf(Sacc[tl][4 * g + 2], Sacc[tl][4 * g + 3]);
                    *(LAS u32x2*)(lds + L_SP + off_b(32 * vb + r, 4 * db + g) + 8 * hh) = w; } } }
            if (do_out && wid < 3) {
                const int tb = wid > 0 ? 1 : 0, sb = wid > 1 ? 1 : 0;
                f32x16 sc;
#pragma unroll
                for (int i = 0; i < 16; ++i) sc[i] = 0.f;
#pragma unroll
                for (int s = 0; s < 8; ++s) { const bf16x8 a = row_frag(lds + L_KP, 32 * sb, s, lane), bq = row_frag(lds + L_QP, 32 * tb, s, lane); sc = HG_MFMA(a, bq, sc); }
                const int t = 32 * tb + r;
#pragma unroll
                for (int g = 0; g < 4; ++g) { float x[4];
#pragma unroll
                    for (int j = 0; j < 4; ++j) { const int s_ = 32 * sb + 8 * g + 4 * hh + j; x[j] = s_ <= t ? sc[4 * g + j] : 0.f; }
                    u32x2 w; w.x = pkbf(x[0], x[1]); w.y = pkbf(x[2], x[3]);
                    *(LAS u32x2*)(lds + L_PM + t * PM_PITCH + (32 * sb + 8 * g + 4 * hh) * 2) = w; }
            }
#pragma unroll
            for (int ks = 0; ks < 4; ++ks) { const bf16x8 a = tr_frag(lds + L_KP, db, ks, lane);
#pragma unroll
                for (int tl = 0; tl < 2; ++tl) { const bf16x8 bi = tr_frag(lds + L_IV, vb0 + tl, ks, lane); Sacc[tl] = HG_MFMA(a, bi, Sacc[tl]); } }
#pragma unroll
            for (int tl = 0; tl < 2; ++tl)
#pragma unroll
                for (int i = 0; i < 16; ++i) Sacc[tl][i] *= el[i];
        }
        if (!do_out) continue;
        LDS_BARRIER();
#ifndef HG_REP_B
#define HG_REP_B 1
#endif
#ifndef HG_REP_C
#define HG_REP_C 1
#endif
        for (int rb_ = 0; rb_ < HG_REP_B; ++rb_) {
            const int tb = wid >> 2, vb = wid & 3;
            f32x16 o;
#pragma unroll
            for (int i = 0; i < 16; ++i) o[i] = 0.f;
#pragma unroll
            for (int ks = 0; ks < 4; ++ks) { if (ks < 2 || tb == 1) {
                const bf16x8 a = *(const LAS bf16x8*)(lds + L_PM + (32 * tb + r) * PM_PITCH + (16 * ks + 8 * hh) * 2); const bf16x8 bi = tr_frag(lds + L_IV, vb, ks, lane); o = HG_MFMA(a, bi, o); } }
#pragma unroll
            for (int s = 0; s < 8; ++s) { const bf16x8 a = row_frag(lds + L_QP, 32 * tb, s, lane), bs = row_frag(lds + L_SP, 32 * vb, s, lane); o = HG_MFMA(a, bs, o); }
#pragma unroll
            for (int i = 0; i < 16; ++i) { const int t = 32 * tb + (i & 3) + 8 * (i >> 2) + 4 * hh; *(LAS float*)(lds + L_O + (t * 128 + 32 * vb + r) * 4) = o[i]; }
        }
        LDS_BARRIER();
        for (int rc_ = 0; rc_ < HG_REP_C; ++rc_) {
            float ov[16];
#pragma unroll
            for (int g = 0; g < 4; ++g) { const f32x4 a = *(const LAS f32x4*)(lds + L_O + (ct * 128 + 16 * cpart + 4 * g) * 4); ov[4 * g] = a.x; ov[4 * g + 1] = a.y; ov[4 * g + 2] = a.z; ov[4 * g + 3] = a.w; }
            float ss = 0.f;
#pragma unroll
            for (int i = 0; i < 16; ++i) ss += ov[i] * ov[i];
            ss += pg8::dpp_row<0xB1>(ss); ss += pg8::dpp_row<0x4E>(ss); ss += pg8::dpp_row<0x141>(ss);
            const float rstd = 1.0f / sqrtf(ss * (1.0f / 128.0f) + 1e-6f);
            const unsigned gs[8] = {sg0.x, sg0.y, sg0.z, sg0.w, sg1.x, sg1.y, sg1.z, sg1.w};
            unsigned ow[8];
#pragma unroll
            for (int i = 0; i < 8; ++i) ow[i] = pkbf(ov[2 * i] * rstd * nwv[2 * i] * pg8::bf_lo(gs[i]), ov[2 * i + 1] * rstd * nwv[2 * i + 1] * pg8::bf_hi(gs[i]));
            bf16* op = OA + ((size_t)b * SEQL + (size_t)c * 64 + ct) * DM + colb + 16 * cpart;
            *(GAS v4u*)(op) = (v4u){ow[0], ow[1], ow[2], ow[3]}; *(GAS v4u*)(op + 8) = (v4u){ow[4], ow[5], ow[6], ow[7]};
        }
    }
#undef HG_LOAD
    if (st_slot >= 0) {
        const size_t so = (size_t)st_slot * ((size_t)64 * 8 * 2 * 16 * 64) + ((size_t)bh8 * 8 + wid) * 2 * 16 * 64 + lane;
#pragma unroll
        for (int tl = 0; tl < 2; ++tl)
#pragma unroll
            for (int i = 0; i < 16; ++i) HST[so + (size_t)(tl * 16 + i) * 64] = Sacc[tl][i];
        if (st_slot >= 1 && wid == 0) *(GAS f32x2*)(HTD + ((size_t)(st_slot - 1) * 64 + bh8) * 128 + 2 * lane) = (f32x2){td0, td1};
    }
    LDS_BARRIER();
}
}

#ifndef PH_SKIP
#define PH_SKIP 0u
#endif
struct Args { Ptrs p; };
typedef __attribute__((address_space(4))) const unsigned long long* KArgWords;
__device__ __forceinline__ Ptrs opq_ptrs(KArgWords p) {
    Ptrs r;
#if defined(__HIP_DEVICE_COMPILE__)
    asm volatile("" : "+s"(p));
    unsigned long long* d = (unsigned long long*)&r;
#pragma unroll
    for (int i = 0; i < (int)(sizeof(Ptrs) / 8); ++i) d[i] = p[i];
#else
    (void)p; r = Ptrs{};
#endif
    return r;
}
__global__ void __launch_bounds__(512, 2) mk_fwd(Args args) {
    extern __shared__ __attribute__((aligned(16))) unsigned char lds_raw[];
    LAS unsigned char* lds = (LAS unsigned char*)lds_raw;
    const KArgWords Pk_ = (KArgWords)__builtin_amdgcn_kernarg_segment_ptr();
    (void)args;
#define P (opq_ptrs(Pk_))
    unsigned char* ws = P.ws;
    const int wv = __builtin_amdgcn_readfirstlane((int)threadIdx.x >> 6), G = gridDim.x;
#define tid (wv * 64 + (int)__builtin_amdgcn_mbcnt_hi(~0u, __builtin_amdgcn_mbcnt_lo(~0u, 0u)))
    volatile LAS unsigned* MISC = (volatile LAS unsigned*)(lds + T_MISC);
    gu32* ctl = (gu32*)(ws + WS_CTL);
    for (int u = tid; u < (LDS_BYTES - TAB_OFF) / 4; u += 512) ((LAS unsigned*)(lds + TAB_OFF))[u] = 0u;
    __syncthreads();
    (void)xcd_barrier_post((unsigned*)(ws + WS_CTL) + CW_BAR, MISC + 8);
#define GRID_BAR() do { XcdBarrier bar_; bar_.bar = (unsigned*)(ws + WS_CTL) + CW_BAR; bar_.x = xb_xcc_id(); bar_.st = (volatile LAS unsigned*)(lds + T_MISC) + 8; for (int rb_ = 0; rb_ < NREP(11); ++rb_) xcd_barrier(bar_); } while (0)
#define RUN(k) (((PH_SKIP >> (k)) & 1u) == 0u)
#ifndef PH_REP
#define PH_REP 0u
#endif
#define NREP(k) (1 + (int)((PH_REP >> (k)) & 1u))

    if (RUN(0)) for (int rp = 0; rp < NREP(0); ++rp) p0_prologue(P, lds, G, wv);
    GRID_BAR();
    if (RUN(1)) for (int rp = 0; rp < NREP(1); ++rp) phase_a0(P, lds, G, wv);
    GRID_BAR();

    for (int l = 0; l < NLAYER; ++l) {
        bf16* PROJ = (bf16*)(ws + WS_PROJ);
        if (RUN(2)) for (int rp = 0; rp < NREP(2); ++rp) {
            if (G == 256) fscan(P, lds, wv);
            pg8::Gemm g{(const pg8::bf16_t*)(ws + WS_HB), (const pg8::bf16_t*)(ws + WS_WIN) + (size_t)l * NPROJ * DM, NTOK, NPROJ, DM};
            pg8::StaticOrder S; S.init(NTOK, NPROJ, G, (int)blockIdx.x);
            pg8::EpiInProj E{(pg8::bf16_t*)PROJ, (float*)(ws + WS_EB), (const float*)(ws + WS_LB) + (size_t)l * DM, 0.125f * LOG2E, (unsigned*)(ws + WS_CTL) + CW_NRM + l * 2 * 128 * 128};
            pg8::gemm_phase<pg8::EpiInProj, pg8::StaticOrder, true, true, false>(lds + RING_OFF, g, S, E, wv);
        }
        GRID_BAR();
        if (RUN(3)) for (int rp = 0; rp < NREP(3); ++rp) {
            constexpr int ATT_Q1 = 1152;
            const bf16* aQ = PROJ + 4 * (size_t)NTOK * DM; const bf16* aK = PROJ + 5 * (size_t)NTOK * DM; const bf16* aV = PROJ + 6 * (size_t)NTOK * DM;
#define HG_CALL(bh_, seg_, out_, slot_) hg::hgrn_unit((bh_) >> 3, (bh_) & 7, (seg_), (out_), (slot_), PROJ + 0 * (size_t)NTOK * DM, (const float*)(ws + WS_EB), PROJ + 1 * (size_t)NTOK * DM, PROJ + 2 * (size_t)NTOK * DM, \
                PROJ + 3 * (size_t)NTOK * DM, P.hg_norm_w + (size_t)l * 128, (bf16*)(ws + WS_OAB), (float*)(ws + WS_HST), (float*)(ws + WS_HTD), lds + RING_OFF, wv)
#define AT_CALL(j_) do { const int qb_ = 15 - ((j_) & 15), bh_ = (j_) >> 4;     \
                attn_body::attn_unit<8>(bh_ >> 4, bh_ & 15, qb_, (const attn_body::bf16*)aQ, (const attn_body::bf16*)aK, (const attn_body::bf16*)aV, (attn_body::bf16*)(ws + WS_OAB + SZB), (const float*)(ws + WS_FP), \
                    (const LAS unsigned char*)(lds + T_ASG), (unsigned*)wqp_, MISC + 1 + (par_ ^= 1), (char*)lds_raw + RING_OFF, wv); } while (0)
#define WQ_WORD(word_) (ctl + CW_WQ + 64 * ((word_) * 4 + l) + 1024 * rp + 2048 * rx)
#define WQ_NEXT(word_) do { __syncthreads(); if (tid == 0) MISC[0] = __hip_atomic_fetch_add(WQ_WORD(word_), 1u, RLX_AGENT); __syncthreads(); } while (0)
            attn_body::attn_jstart_table((LAS unsigned char*)(lds + T_ASG), (const unsigned*)(ws + WS_CTL) + CW_NRM + (size_t)l * 2 * 128 * 128, (const float*)(ws + WS_FP), wv);
            for (int rx = 0; rx < NREP(10); ++rx) for (;;) { WQ_NEXT(0); const int it = __builtin_amdgcn_readfirstlane((int)MISC[0]); if (it >= 192) break;
                if (it < 64) HG_CALL(it, 0, true, 0); else HG_CALL((it - 64) >> 1, 1 + ((it - 64) & 1), false, 1 + ((it - 64) & 1)); }
            for (int rx = 0; rx < NREP(12); ++rx) { int par_ = 0; gu32* wqp_ = WQ_WORD(1); WQ_NEXT(1); int j = __builtin_amdgcn_readfirstlane((int)MISC[0]);
              while (j < ATT_Q1) { AT_CALL(j); j = __builtin_amdgcn_readfirstlane((int)MISC[1 + par_]); } }
            GRID_BAR();
            for (int rx = 0; rx < NREP(10); ++rx) for (;;) { WQ_NEXT(2); const int it = __builtin_amdgcn_readfirstlane((int)MISC[0]); if (it >= 192) break; HG_CALL(it & 63, 1 + (it >> 6), true, -1); }
            for (int rx = 0; rx < NREP(12); ++rx) { int par_ = 0; gu32* wqp_ = WQ_WORD(3); WQ_NEXT(3); int j = __builtin_amdgcn_readfirstlane((int)MISC[0]) + ATT_Q1;
              while (j < 2048) { AT_CALL(j); j = __builtin_amdgcn_readfirstlane((int)MISC[1 + par_]) + ATT_Q1; } }
#undef HG_CALL
#undef AT_CALL
#undef WQ_NEXT
#undef WQ_WORD
        }
        GRID_BAR();
        if (RUN(4)) for (int rp = 0; rp < NREP(4); ++rp) {
            pg8::Gemm g{(const pg8::bf16_t*)(ws + WS_OAB), (const pg8::bf16_t*)(ws + WS_WBR) + (size_t)l * 2 * DM * DM, 2 * NTOK, 2 * DM, DM};
            pg8::PairOrder S; S.init(G, (int)blockIdx.x);
            pg8::EpiBranch E{(const pg8::bf16_t*)(PROJ + 7 * (size_t)NTOK * DM), (const pg8::bf16_t*)(PROJ + 8 * (size_t)NTOK * DM), (pg8::bf16_t*)(ws + WS_MG)};
            pg8::gemm_phase<pg8::EpiBranch, pg8::PairOrder, true, true, false>(lds + RING_OFF, g, S, E, wv);
        }
        GRID_BAR();
        if (RUN(5)) for (int rp = 0; rp < NREP(5); ++rp) {
            pg8::Gemm g{(const pg8::bf16_t*)(ws + WS_MG), (const pg8::bf16_t*)(ws + WS_WOUT) + (size_t)l * DM * DM, NTOK, DM, DM};
            pg8::StaticOrder S; S.init(NTOK, DM, G, (int)blockIdx.x);
            pg8::EpiBf16Plain E{(pg8::bf16_t*)(ws + WS_Y), DM};
            pg8::gemm_phase<pg8::EpiBf16Plain, pg8::StaticOrder, true, true, false>(lds + RING_OFF, g, S, E, wv);
        }
        GRID_BAR();
        if (RUN(6)) for (int rp = 0; rp < NREP(6); ++rp) phase_f(P, lds, l, l == 0 ? P.x : P.out, G, wv, rp == 0);
        GRID_BAR();
        if (RUN(7)) for (int rp = 0; rp < NREP(7); ++rp) {
            const int ntile = moe_tables(P, lds, l, wv);
            pg8::Gemm g{(const pg8::bf16_t*)(ws + WS_HB), (const pg8::bf16_t*)(ws + WS_WGU) + (size_t)l * NEXP * 2048 * DM, 0, 0, DM};
            pg8::MoeOrder S{G, (int)blockIdx.x, ntile, 8, (const LAS unsigned char*)(lds + T_RT2E), (const LAS int*)(lds + T_TBASE), (const LAS int*)(lds + T_CNT), (const int*)(ws + WS_LIST)};
            pg8::EpiMoe1 E{(pg8::bf16_t*)(ws + WS_ACT), P.b_gate + (size_t)l * NEXP * DM, P.b_up + (size_t)l * NEXP * DM};
            pg8::gemm_phase<pg8::EpiMoe1, pg8::MoeOrder, true, true, true>(lds + RING_OFF, g, S, E, wv);
        }
        GRID_BAR();
        if (RUN(8)) for (int rp = 0; rp < NREP(8); ++rp) {
            const int ntile = moe_tables(P, lds, l, wv);
            pg8::Gemm g{(const pg8::bf16_t*)(ws + WS_ACT), (const pg8::bf16_t*)(ws + WS_WD) + (size_t)l * NEXP * DM * DM, 0, 0, DM};
            pg8::MoeOrder S{G, (int)blockIdx.x, ntile, 4, (const LAS unsigned char*)(lds + T_RT2E), (const LAS int*)(lds + T_TBASE), (const LAS int*)(lds + T_CNT), (const int*)(ws + WS_LIST)};
            pg8::EpiMoe2 E{(pg8::bf16_t*)(ws + WS_YR), P.b_down + (size_t)l * NEXP * DM};
            pg8::gemm_phase<pg8::EpiMoe2, pg8::MoeOrder, true, true, false>(lds + RING_OFF, g, S, E, wv);
        }
        GRID_BAR();
        if (RUN(9)) for (int rp = 0; rp < NREP(9); ++rp) { (void)moe_tables(P, lds, l, wv); phase_j(P, lds, l, G, wv); }
        if (l + 1 < NLAYER) GRID_BAR();
    }
#undef GRID_BAR
#undef RUN
#undef tid
#undef P
#undef NREP
}

extern "C" void kernel_launch(void* const* d_in, const int* in_sizes, int n_in, void* d_out, int out_size, void* d_ws, size_t ws_size, hipStream_t stream) {
    static int grid = 0;
    if (grid == 0) {
        if (n_in != 22 || in_sizes[0] != NTOK * DM || out_size != NTOK * DM || ws_size < WS_END) {
            fprintf(stderr, "kernel_launch: built for 22 inputs, x/out of %d floats, >= %zu bytes of workspace; got n_in %d, in0 %d, out %d, ws %zu; nothing launched\n", NTOK * DM, (size_t)WS_END, n_in, n_in > 0 ? in_sizes[0] : -1, out_size, ws_size);
            grid = -1; return; }
        int dev = 0, cus = 0, per_cu = 0;
        if (hipGetDevice(&dev) != hipSuccess || hipDeviceGetAttribute(&cus, hipDeviceAttributeMultiprocessorCount, dev) != hipSuccess) { fprintf(stderr, "kernel_launch: device query failed\n"); grid = -1; return; }
        if (hipFuncSetAttribute((const void*)mk_fwd, hipFuncAttributeMaxDynamicSharedMemorySize, LDS_BYTES) != hipSuccess) { fprintf(stderr, "kernel_launch: hipFuncSetAttribute failed\n"); grid = -1; return; }
        if (hipOccupancyMaxActiveBlocksPerMultiprocessor(&per_cu, (const void*)mk_fwd, 512, LDS_BYTES) != hipSuccess || per_cu < 1) fprintf(stderr, "kernel_launch: note: occupancy query reports %d workgroups per CU\n", per_cu);
        (void)hipGetLastError();
        grid = cus;
        if (NTOK / (grid * 8) != 16 || NTOK % (grid * 8) != 0) { fprintf(stderr, "kernel_launch: %d CUs: the row-wise phases need NTOK %% (32 * CUs) == 0\n", grid); grid = -1; return; }
    }
    if (grid < 0) return;
    if (hipMemsetAsync((char*)d_ws + WS_CTL, 0, CTL_ZERO_BYTES, stream) != hipSuccess) { fprintf(stderr, "kernel_launch: hipMemsetAsync failed\n"); return; }
    Args a{};
    const float** pp = (const float**)&a.p;
    for (int i = 0; i < 22; ++i) pp[i] = (const float*)d_in[i];
    a.p.out = (float*)d_out; a.p.ws = (unsigned char*)d_ws;
    hipLaunchKernelGGL(mk_fwd, dim3(grid), dim3(512), LDS_BYTES, stream, a);
    const hipError_t le = hipPeekAtLastError();
    if (le != hipSuccess) fprintf(stderr, "kernel_launch: launch failed: %s (grid %d)\n", hipGetErrorName(le), grid);
}
```

```cpp
#include <hip/hip_runtime.h>
#include <hip/hip_bf16.h>
#include <cstdio>
#include <cstdint>
#include <cmath>

constexpr int NTOK = 32768, DM = 1024, NB = 8, SEQL = 4096, NLAYER = 4;
constexpr int NEXP = 32, TOPK = 4;
constexpr int PIN = 9232;
constexpr int NPROJ = 9216;
constexpr float DN_ALPHA = 1.6817928305074290f;
constexpr float LOG2E = 1.4426950408889634f;

namespace pg8 {
#define PG8_LAS __attribute__((address_space(3)))
typedef unsigned short bf16_t;
typedef short bf16x8 __attribute__((ext_vector_type(8)));
typedef float f32x4 __attribute__((ext_vector_type(4)));
typedef unsigned u32x4 __attribute__((ext_vector_type(4)));
constexpr int BM = 256, BK = 64, HALF = 128, HTB = HALF * BK * 2  , STAGE_BYTES = 8 * HTB, NXCD = 8, WGM = 4;

__host__ __device__ __forceinline__ int lds_byte(int r, int c) { const int st = (r >> 4) * 2 + (c >> 5), rr = r & 15, cc = c & 31, ob = rr * 64 + cc * 2; return st * 1024 + (ob ^ (((ob >> 9) & 1) << 5)); }
__host__ __device__ __forceinline__ void stage_rc(int b, int& R, int& C) { const int st = b / 1024, sb = b % 1024, swz = sb ^ (((sb >> 9) & 1) << 5); R = (st >> 1) * 16 + swz / 64; C = (st & 1) * 32 + (swz % 64) / 2; }
__host__ __device__ __forceinline__ int perm32(int rho) { const int n = rho >> 4, i = rho & 15; return 8 * (i >> 2) + 4 * n + (i & 3); }

struct Unit { int pm, pn; };
struct Gemm { const bf16_t* A; const bf16_t* Bt; int M, N, K; };

struct StaticOrder {
    int nM, nN, nwg, G, c;
    __host__ __device__ void init(int M, int N, int G_, int c_) { nM = M / BM; nN = N / BM; nwg = nM * nN; G = G_; c = c_; }
    __host__ __device__ bool map(long L, Unit& u) const {
        if (L >= nwg) return false;
        int wgid = (int)L; { const int q = nwg / NXCD, r = nwg % NXCD, xcd = wgid % NXCD, off = wgid / NXCD; wgid = (xcd < r ? xcd * (q + 1) : r * (q + 1) + (xcd - r) * q) + off; }
        const int nig = WGM * nN, gid = wgid / nig, fm = gid * WGM, gsz = (nM - fm) < WGM ? (nM - fm) : WGM;
        u.pm = fm + ((wgid % nig) % gsz); u.pn = (wgid % nig) / gsz; return true;
    }
    __host__ __device__ bool next(int i, Unit& u) const { return map((long)i * G + c, u); }
    __device__ __forceinline__ int arow(const Unit&, int) const { return 0; }
};
struct PairOrder {
    StaticOrder so;
    __device__ void init(int G_, int c_) { so.init(NTOK, DM, G_, c_); }
    __device__ bool next(int i, Unit& u) const { Unit t; if (!so.map((long)(i >> 1) * so.G + so.c, t)) return false; const int half = i & 1; u.pm = half * (NTOK / BM) + t.pm; u.pn = half * (DM / BM) + t.pn; return true; }
    __device__ __forceinline__ int arow(const Unit&, int) const { return 0; }
};
struct MoeOrder {
    int G, c, ntile, ncol;
    const PG8_LAS unsigned char* rt2e; const PG8_LAS int* tbase; const PG8_LAS int* cnt; const int* list;
    __device__ bool next(int i, Unit& u) const {
        if ((G & 7) != 0 || G < 256) { const long L = (long)i * G + c; if (L >= (long)ntile * ncol) return false; const int rt = (int)(L / ncol), pl = (int)(L % ncol); u.pm = rt; u.pn = (int)rt2e[rt] * ncol + pl; return true; }
        const int x = c & 7, k = c >> 3, per = G >> 5;
        const int nsub = ncol == 8 ? 4 : 8, sub = ncol == 8 ? (x >> 1) : x, pl = (ncol == 8 ? 4 * (x & 1) : 0) + (k & 3);
        const int Q = (ntile + nsub - 1) / nsub;
        const int rl = per * i + (k >> 2), rt = sub * Q + rl;
        if (rl >= Q || rt >= ntile) return false;
        u.pm = rt; u.pn = (int)rt2e[rt] * ncol + pl; return true; }
    __device__ __forceinline__ int arow(const Unit& u, int r) const { const int e = u.pn / ncol; const int pos = (u.pm - tbase[e]) * BM + r; return pos < cnt[e] ? list[e * NTOK + pos] : 0; }
};

__device__ __forceinline__ unsigned cvt_pk_bf16(float lo, float hi) { unsigned r; asm volatile("v_cvt_pk_bf16_f32 %0, %1, %2" : "=v"(r) : "v"(lo), "v"(hi)); return r; }
__device__ __forceinline__ float bf_lo(unsigned w) { return __uint_as_float(w << 16); }
__device__ __forceinline__ float bf_hi(unsigned w) { return __uint_as_float(w & 0xffff0000u); }
__device__ __forceinline__ float fast_sigmoid(float x) { return __builtin_amdgcn_rcpf(1.0f + __expf(-x)); }
template <int CTRL> __device__ __forceinline__ float dpp_row(float v) { return __int_as_float(__builtin_amdgcn_update_dpp(0, __float_as_int(v), CTRL, 0xF, 0xF, true)); }
__device__ __forceinline__ float row16_scan(float v) { v += dpp_row<0x111>(v); v += dpp_row<0x112>(v); v += dpp_row<0x114>(v); v += dpp_row<0x118>(v); return v; }
__device__ __forceinline__ float row16_sum(float v) { v += dpp_row<0x128>(v); v += dpp_row<0x124>(v); v += dpp_row<0x122>(v); v += dpp_row<0x121>(v); return v; }
__device__ __forceinline__ float row16_max(float v) { v = fmaxf(v, dpp_row<0x128>(v)); v = fmaxf(v, dpp_row<0x124>(v)); v = fmaxf(v, dpp_row<0x122>(v)); v = fmaxf(v, dpp_row<0x121>(v)); return v; }
__device__ __forceinline__ float rows4_sum(float v) {
    { auto r = __builtin_amdgcn_permlane32_swap(__float_as_uint(v), __float_as_uint(v), false, false); v = __uint_as_float(r[0]) + __uint_as_float(r[1]); }
    { auto r = __builtin_amdgcn_permlane16_swap(__float_as_uint(v), __float_as_uint(v), false, false); v = __uint_as_float(r[0]) + __uint_as_float(r[1]); }
    return v; }


struct EpiInProj {
    static constexpr bool PERM = true, AFTER_DRAIN = false;
#ifdef EPI_REP_INPROJ
    static constexpr int REPS = EPI_REP_INPROJ;
#else
    static constexpr int REPS = 1;
#endif
    bf16_t* proj; float* eb; const float* lb; float qscale; unsigned* nrm;
    __device__ __forceinline__ void operator()(const f32x4 (&acc)[2][2][4][2], const Unit& u, int wr, int wc, int fr, int fq) const {
        const int grp = u.pn >> 2, row0 = u.pm * BM + wr * 64 + fr, col0 = (u.pn & 3) * BM + wc * 32 + 8 * fq;
        bf16_t* base = proj + (size_t)grp * ((size_t)NTOK * DM);
        if (u.pn < 8) {
            const int hc0 = u.pn * HALF + wc * 32 + 8 * fq;
            bf16_t* qs = proj; bf16_t* kk_ = proj + (size_t)NTOK * DM;
            const f32x4 l0 = *(const f32x4*)(lb + hc0), l1 = *(const f32x4*)(lb + hc0 + 4);
#pragma unroll
            for (int ai = 0; ai < 2; ++ai)
#pragma unroll
                for (int jh = 0; jh < 2; ++jh) {
                    float qpv[4][4], kpv[4][4], ebm[4], ebl[4], blv[4];
#pragma unroll
                    for (int jj = 0; jj < 4; ++jj) {
                        const float lbv = jh == 0 ? l0[jj] : l1[jj];
                        float s[4], kk[4], tt[4];
#pragma unroll
                        for (int m = 0; m < 4; ++m) {
                            float x = acc[ai][1][m][jh][jj];
                            x = fminf(fmaxf(x, -30.f), 30.f);
                            const float e = __expf(-x), inv = __builtin_amdgcn_rcpf(1.0f + e), oms = e * inv;
                            const float f = lbv + (1.0f - lbv) * inv;
                            const float v = __logf(fmaxf(f, 1e-30f)); kk[m] = (1.0f - lbv) * oms;
                            s[m] = row16_scan(v); tt[m] = row16_sum(v);
                        }
                        const float t0 = tt[0], t1 = tt[1], t2 = tt[2], t3 = tt[3];
                        const float R = t0 + t1, BL = (t0 + t1) + (t2 + t3);
                        const float bq[4] = {s[0], s[1] + t0, s[2] + R, s[3] + (R + t2)};
#pragma unroll
                        for (int m = 0; m < 4; ++m) { const float qv = acc[ai][0][m][jh][jj];
                            qpv[m][jj] = qv * fast_sigmoid(qv) * __expf(fminf(bq[m] - R, 80.f)); kpv[m][jj] = kk[m] * __expf(fminf(R - bq[m], 80.f)); }
                        ebm[jj] = __expf(R); ebl[jj] = __expf(BL - R); blv[jj] = BL;
                    }
                    typedef unsigned u32x2_t __attribute__((ext_vector_type(2)));
#pragma unroll
                    for (int m = 0; m < 4; ++m) { const size_t off = ((size_t)u.pn * NTOK + (row0 + ai * HALF + m * 16)) * HALF + (wc * 32 + 8 * fq + 4 * jh);
                        u32x2_t w; w.x = cvt_pk_bf16(kpv[m][0], kpv[m][1]); w.y = cvt_pk_bf16(kpv[m][2], kpv[m][3]); *(u32x2_t*)(kk_ + off) = w;
                        u32x2_t q; q.x = cvt_pk_bf16(qpv[m][0], qpv[m][1]); q.y = cvt_pk_bf16(qpv[m][2], qpv[m][3]); *(u32x2_t*)(qs + off) = q; }
                    if (fr == 0) { const size_t eo = (size_t)((u.pm * BM + ai * HALF + wr * 64) >> 6) * DM + hc0 + 4 * jh; const size_t es = (size_t)(NTOK / 64) * DM;
                        *(f32x4*)(eb + eo) = (f32x4){ebm[0], ebm[1], ebm[2], ebm[3]}; *(f32x4*)(eb + es + eo) = (f32x4){ebl[0], ebl[1], ebl[2], ebl[3]}; *(f32x4*)(eb + 2 * es + eo) = (f32x4){blv[0], blv[1], blv[2], blv[3]}; }
                }
            return;
        }
        const int mode = grp == 3 ? 1 : (grp >= 7 ? 2 : 0);
        const float sc = grp == 4 ? qscale : 1.0f;
        const bool wantn = grp == 4 || grp == 5;
        float mx[2][2] = {{0.f, 0.f}, {0.f, 0.f}};
        size_t hoff[2]; int rstr;
        if (grp <= 3) { rstr = HALF; hoff[0] = (size_t)((u.pn & 3) * 2 + 0) * NTOK * HALF + wc * 32 + 8 * fq; hoff[1] = (size_t)((u.pn & 3) * 2 + 1) * NTOK * HALF + wc * 32 + 8 * fq; }
        else if (grp <= 6) { rstr = 64; hoff[0] = (size_t)((u.pn & 3) * 4 + 0 + (wc >> 1)) * NTOK * 64 + (wc & 1) * 32 + 8 * fq; hoff[1] = (size_t)((u.pn & 3) * 4 + 2 + (wc >> 1)) * NTOK * 64 + (wc & 1) * 32 + 8 * fq; }
        else { rstr = DM; hoff[0] = col0; hoff[1] = col0 + HALF; }
#pragma unroll
        for (int ai = 0; ai < 2; ++ai)
#pragma unroll
            for (int m = 0; m < 4; ++m) { bf16_t* rowp = base + (size_t)(row0 + ai * HALF + m * 16) * rstr;
#pragma unroll
                for (int bj = 0; bj < 2; ++bj) { f32x4 v0 = acc[ai][bj][m][0], v1 = acc[ai][bj][m][1];
                    if (mode != 0) {
#pragma unroll
                        for (int j = 0; j < 4; ++j) { const float s0 = fast_sigmoid(v0[j]), s1 = fast_sigmoid(v1[j]); v0[j] = mode == 1 ? v0[j] * s0 : s0; v1[j] = mode == 1 ? v1[j] * s1 : s1; }
                    } else { v0 = v0 * sc; v1 = v1 * sc; }
                    if (wantn) { float ss = (v0[0] * v0[0] + v0[1] * v0[1]) + (v0[2] * v0[2] + v0[3] * v0[3]) + (v1[0] * v1[0] + v1[1] * v1[1]) + (v1[2] * v1[2] + v1[3] * v1[3]);
                        ss = rows4_sum(ss); mx[ai][bj] = fmaxf(mx[ai][bj], ss); }
                    u32x4 w; w.x = cvt_pk_bf16(v0[0], v0[1]); w.y = cvt_pk_bf16(v0[2], v0[3]); w.z = cvt_pk_bf16(v1[0], v1[1]); w.w = cvt_pk_bf16(v1[2], v1[3]);
                    *(u32x4*)(rowp + hoff[bj]) = w; } }
        if (wantn) {
#pragma unroll
            for (int ai = 0; ai < 2; ++ai)
#pragma unroll
                for (int bj = 0; bj < 2; ++bj) { float v = mx[ai][bj];
                    v = row16_max(v);
                    if (fr == 0 && fq == 0) { const int R = u.pm * BM + ai * HALF + wr * 64, head = ((u.pn & 3) * BM + bj * HALF + wc * 32) >> 6;
                        atomicMax(nrm + ((((grp - 4) * 128 + (R >> 12) * 16 + head) * 64 + ((R & 4095) >> 6)) * 2 + (wc & 1)), __float_as_uint(v)); } }
        }
    }
};
struct EpiBranch {
    static constexpr bool PERM = true, AFTER_DRAIN = false;
    static constexpr int REPS = 1;
    const bf16_t* ga; const bf16_t* gb; bf16_t* mg;
    __device__ __forceinline__ void operator()(const f32x4 (&acc)[2][2][4][2], const Unit& u, int wr, int wc, int fr, int fq) const {
        const int half = u.pm >= (NTOK / BM) ? 1 : 0, pm = u.pm - half * (NTOK / BM), pn = u.pn - half * (DM / BM);
        const int row0 = pm * BM + wr * 64 + fr, col0 = pn * BM + wc * 32 + 8 * fq;
        const bf16_t* gp = half ? gb : ga;
#pragma unroll
        for (int ai = 0; ai < 2; ++ai)
#pragma unroll
            for (int m = 0; m < 4; ++m) { const size_t ro = (size_t)(row0 + ai * HALF + m * 16) * DM + col0;
#pragma unroll
                for (int bj = 0; bj < 2; ++bj) { const f32x4 v0 = acc[ai][bj][m][0], v1 = acc[ai][bj][m][1];
                    const u32x4 gw = *(const u32x4*)(gp + ro + bj * HALF);
                    float o[8];
                    o[0] = bf_lo(gw.x) * v0[0]; o[1] = bf_hi(gw.x) * v0[1]; o[2] = bf_lo(gw.y) * v0[2]; o[3] = bf_hi(gw.y) * v0[3];
                    o[4] = bf_lo(gw.z) * v1[0]; o[5] = bf_hi(gw.z) * v1[1]; o[6] = bf_lo(gw.w) * v1[2]; o[7] = bf_hi(gw.w) * v1[3];
                    if (half) { const u32x4 pw = *(const u32x4*)(mg + ro + bj * HALF);
                        o[0] += bf_lo(pw.x); o[1] += bf_hi(pw.x); o[2] += bf_lo(pw.y); o[3] += bf_hi(pw.y); o[4] += bf_lo(pw.z); o[5] += bf_hi(pw.z); o[6] += bf_lo(pw.w); o[7] += bf_hi(pw.w); }
                    u32x4 w; w.x = cvt_pk_bf16(o[0], o[1]); w.y = cvt_pk_bf16(o[2], o[3]); w.z = cvt_pk_bf16(o[4], o[5]); w.w = cvt_pk_bf16(o[6], o[7]);
                    *(u32x4*)(mg + ro + bj * HALF) = w; } }
    }
};
struct EpiBf16Plain {
    static constexpr bool PERM = true, AFTER_DRAIN = false;
    static constexpr int REPS = 1;
    bf16_t* O; int ldc;
    __device__ __forceinline__ void operator()(const f32x4 (&acc)[2][2][4][2], const Unit& u, int wr, int wc, int fr, int fq) const {
        const int row0 = u.pm * BM + wr * 64 + fr, col0 = u.pn * BM + wc * 32 + 8 * fq;
#pragma unroll
        for (int ai = 0; ai < 2; ++ai)
#pragma unroll
            for (int m = 0; m < 4; ++m) { bf16_t* rowp = O + (size_t)(row0 + ai * HALF + m * 16) * ldc + col0;
#pragma unroll
                for (int bj = 0; bj < 2; ++bj) { const f32x4 v0 = acc[ai][bj][m][0], v1 = acc[ai][bj][m][1];
                    u32x4 w; w.x = cvt_pk_bf16(v0[0], v0[1]); w.y = cvt_pk_bf16(v0[2], v0[3]); w.z = cvt_pk_bf16(v1[0], v1[1]); w.w = cvt_pk_bf16(v1[2], v1[3]);
                    *(u32x4*)(rowp + bj * HALF) = w; } }
    }
};
struct EpiF32 {
    static constexpr bool PERM = true, AFTER_DRAIN = false;
    static constexpr int REPS = 1;
    float* O; int ldc;
    __device__ __forceinline__ void operator()(const f32x4 (&acc)[2][2][4][2], const Unit& u, int wr, int wc, int fr, int fq) const {
        const int row0 = u.pm * BM + wr * 64 + fr, col0 = u.pn * BM + wc * 32 + 8 * fq;
#pragma unroll
        for (int ai = 0; ai < 2; ++ai)
#pragma unroll
            for (int m = 0; m < 4; ++m) { float* rowp = O + (size_t)(row0 + ai * HALF + m * 16) * ldc + col0;
#pragma unroll
                for (int bj = 0; bj < 2; ++bj) { *(f32x4*)(rowp + bj * HALF) = acc[ai][bj][m][0]; *(f32x4*)(rowp + bj * HALF + 4) = acc[ai][bj][m][1]; } }
    }
};
struct EpiMoe1 {
    static constexpr bool PERM = true, AFTER_DRAIN = false;
#ifdef EPI_REP_MOE
    static constexpr int REPS = EPI_REP_MOE;
#else
    static constexpr int REPS = 1;
#endif
    bf16_t* act; const float* bg; const float* bu;
    __device__ __forceinline__ void operator()(const f32x4 (&acc)[2][2][4][2], const Unit& u, int wr, int wc, int fr, int fq) const {
        const int row0 = u.pm * BM + wr * 64 + fr, cl = wc * 32 + 8 * fq, colo = (u.pn & 7) * HALF + cl;
        const size_t bo = (size_t)u.pn * HALF + cl;
        const f32x4 g0 = *(const f32x4*)(bg + bo), g1 = *(const f32x4*)(bg + bo + 4), u0 = *(const f32x4*)(bu + bo), u1 = *(const f32x4*)(bu + bo + 4);
#pragma unroll
        for (int ai = 0; ai < 2; ++ai)
#pragma unroll
            for (int m = 0; m < 4; ++m) {
                float o[8];
#pragma unroll
                for (int j = 0; j < 8; ++j) {
                    float gv = (j < 4 ? acc[ai][0][m][0][j & 3] : acc[ai][0][m][1][j & 3]) + (j < 4 ? g0[j & 3] : g1[j & 3]);
                    float uv = (j < 4 ? acc[ai][1][m][0][j & 3] : acc[ai][1][m][1][j & 3]) + (j < 4 ? u0[j & 3] : u1[j & 3]);
                    gv = fminf(gv, 7.0f); uv = fminf(fmaxf(uv, -7.0f), 7.0f);
                    o[j] = (uv + 1.0f) * (gv * fast_sigmoid(1.702f * gv));
                }
                u32x4 w; w.x = cvt_pk_bf16(o[0], o[1]); w.y = cvt_pk_bf16(o[2], o[3]); w.z = cvt_pk_bf16(o[4], o[5]); w.w = cvt_pk_bf16(o[6], o[7]);
                *(u32x4*)(act + (size_t)(row0 + ai * HALF + m * 16) * DM + colo) = w;
            }
    }
};
struct EpiMoe2 {
    static constexpr bool PERM = true, AFTER_DRAIN = false;
#ifdef EPI_REP_MOE
    static constexpr int REPS = EPI_REP_MOE;
#else
    static constexpr int REPS = 1;
#endif
    bf16_t* yr; const float* bd;
    __device__ __forceinline__ void operator()(const f32x4 (&acc)[2][2][4][2], const Unit& u, int wr, int wc, int fr, int fq) const {
        const int row0 = u.pm * BM + wr * 64 + fr, cl = wc * 32 + 8 * fq, colo = (u.pn & 3) * BM + cl;
        const size_t bo = (size_t)u.pn * BM + cl;
        f32x4 bv[2][2];
#pragma unroll
        for (int bj = 0; bj < 2; ++bj) { bv[bj][0] = *(const f32x4*)(bd + bo + bj * HALF); bv[bj][1] = *(const f32x4*)(bd + bo + bj * HALF + 4); }
#pragma unroll
        for (int ai = 0; ai < 2; ++ai)
#pragma unroll
            for (int m = 0; m < 4; ++m) { bf16_t* rowp = yr + (size_t)(row0 + ai * HALF + m * 16) * DM + colo;
#pragma unroll
                for (int bj = 0; bj < 2; ++bj) { const f32x4 v0 = acc[ai][bj][m][0] + bv[bj][0], v1 = acc[ai][bj][m][1] + bv[bj][1];
                    u32x4 w; w.x = cvt_pk_bf16(v0[0], v0[1]); w.y = cvt_pk_bf16(v0[2], v0[3]); w.z = cvt_pk_bf16(v1[0], v1[1]); w.w = cvt_pk_bf16(v1[2], v1[3]);
                    *(u32x4*)(rowp + bj * HALF) = w; } }
    }
};
template <class Epi, class Sched, bool ALIGN_EPI = false, bool SP2 = false, bool GATHER = false>
__device__ __forceinline__ void gemm_phase(PG8_LAS unsigned char* lds, const Gemm g, const Sched& S, const Epi& E, const int wv  ) {
    int tid_ = wv * 64 + (int)__builtin_amdgcn_mbcnt_hi(~0u, __builtin_amdgcn_mbcnt_lo(~0u, 0u)); asm volatile("" : "+v"(tid_));
    const int tid = tid_, wid = __builtin_amdgcn_readfirstlane(tid >> 6), lane = tid & 63, wr = wid >> 2, wc = wid & 3, fr = lane & 15, fq = lane >> 4;
    const int K = g.K, nt = K / BK;
    unsigned voffA[2], voffB[2]; int rA[2], cA2[2];
#pragma unroll
    for (int i = 0; i < 2; ++i) { int R, C; stage_rc(tid * 16 + i * 8192, R, C); const int Rb = Epi::PERM ? ((R & ~31) + perm32(R & 31)) : R;
        voffA[i] = (unsigned)(R * K + C) * 2u; voffB[i] = (unsigned)(Rb * K + C) * 2u; rA[i] = R; cA2[i] = C * 2; }
    unsigned cvo[2][2], nvo[2][2];
#define PG8_GVO(dst, un) do { _Pragma("unroll") for (int _h = 0; _h < 2; ++_h) _Pragma("unroll") for (int _i = 0; _i < 2; ++_i) \
        dst[_h][_i] = (unsigned)S.arow(un, _h * HALF + rA[_i]) * (unsigned)(K * 2) + (unsigned)cA2[_i]; } while (0)
    const size_t kstep = (size_t)(BK * 2);
    const size_t hstep = (size_t)HALF * K * 2;
    const size_t tstep = 2 * hstep;
    const unsigned ldsw = (unsigned)wid * 1024u;
    const int aoff = lds_byte(wr * 64 + fr, fq * 8), boff = lds_byte(wc * 32 + fr, fq * 8);
#define PG8_SA(b, h) (((b) * 2 + (h)) * HTB)
#define PG8_SB(b, h) ((4 + (b) * 2 + (h)) * HTB)
#define PG8_STAGE(bufoff, gbase, voff) do { _Pragma("unroll") for (int _i = 0; _i < 2; ++_i) \
        __builtin_amdgcn_global_load_lds((const unsigned*)((const char*)(gbase) + (voff)[_i]), (PG8_LAS unsigned*)(lds + (bufoff) + ldsw + _i * 8192), 16, 0, 0); } while (0)
#define PG8_STAGE_A(bufoff, gbase, hh, nx) do { if constexpr (GATHER) { _Pragma("unroll") for (int _i = 0; _i < 2; ++_i) { const unsigned _vo = (nx) ? nvo[hh][_i] : cvo[hh][_i]; \
        __builtin_amdgcn_global_load_lds((const unsigned*)((const char*)(gbase) + _vo), (PG8_LAS unsigned*)(lds + (bufoff) + ldsw + _i * 8192), 16, 0, 0); } } \
        else { PG8_STAGE(bufoff, (gbase) + (hh) * hstep, voffA); } } while (0)
#define PG8_LDA(dst, b, h) do { _Pragma("unroll") for (int m = 0; m < 4; ++m) _Pragma("unroll") for (int k = 0; k < 2; ++k) dst[m][k] = *(const PG8_LAS bf16x8*)(lds + PG8_SA(b, h) + aoff + m * 2048 + k * 1024); } while (0)
#define PG8_LDB(dst, b, h) do { _Pragma("unroll") for (int n = 0; n < 2; ++n) _Pragma("unroll") for (int k = 0; k < 2; ++k) dst[n][k] = *(const PG8_LAS bf16x8*)(lds + PG8_SB(b, h) + boff + n * 2048 + k * 1024); } while (0)
#define PG8_MMA(ai, bj, At, Bt) do { __builtin_amdgcn_s_setprio(1); _Pragma("unroll") for (int m = 0; m < 4; ++m) _Pragma("unroll") for (int n = 0; n < 2; ++n) _Pragma("unroll") for (int k = 0; k < 2; ++k) \
        acc[ai][bj][m][n] = __builtin_amdgcn_mfma_f32_16x16x32_bf16(Bt[n][k], At[m][k], acc[ai][bj][m][n], 0, 0, 0); __builtin_amdgcn_s_setprio(0); } while (0)
#define PG8_WAIT_V(n) asm volatile("s_waitcnt vmcnt(" #n ")" ::: "memory")
#define PG8_WAIT_L(n) asm volatile("s_waitcnt lgkmcnt(" #n ")" ::: "memory")
#define PG8_BAR __builtin_amdgcn_s_barrier()
#define PG8_SCHED __builtin_amdgcn_sched_barrier(0)
    Unit cur, nxt; int ui = 0;
    if (!S.next(0, cur)) return;
    f32x4 acc[2][2][4][2];
#pragma unroll
    for (int a = 0; a < 2; ++a)
#pragma unroll
        for (int b = 0; b < 2; ++b)
#pragma unroll
            for (int m = 0; m < 4; ++m)
#pragma unroll
                for (int n = 0; n < 2; ++n) acc[a][b][m][n] = (f32x4){0.f, 0.f, 0.f, 0.f};
    bf16x8 At[4][2], B0[2][2], B1[2][2];
    const char* cA = (const char*)g.A + (GATHER ? (size_t)0 : (size_t)cur.pm * tstep); const char* cB = (const char*)g.Bt + (size_t)cur.pn * tstep;
    if constexpr (GATHER) { PG8_GVO(cvo, cur); }
    if constexpr (SP2) {
        PG8_STAGE(PG8_SB(0, 0), cB, voffB); PG8_STAGE(PG8_SB(0, 1), cB + hstep, voffB); PG8_STAGE_A(PG8_SA(0, 0), cA, 0, false); PG8_STAGE_A(PG8_SA(0, 1), cA, 1, false);
        if (wr == 1) PG8_BAR;
        PG8_WAIT_V(2); PG8_BAR;
        PG8_STAGE(PG8_SB(1, 0), cB + kstep, voffB); PG8_STAGE_A(PG8_SA(1, 0), cA + kstep, 0, false); PG8_STAGE(PG8_SB(1, 1), cB + hstep + kstep, voffB);
        PG8_WAIT_V(6); PG8_BAR;
    } else {
        PG8_STAGE(PG8_SB(0, 0), cB, voffB); PG8_STAGE_A(PG8_SA(0, 0), cA, 0, false); PG8_STAGE(PG8_SB(0, 1), cB + hstep, voffB); PG8_STAGE_A(PG8_SA(0, 1), cA, 1, false);
        if (wr == 1) PG8_BAR;
        PG8_WAIT_V(4); PG8_BAR;
        PG8_STAGE(PG8_SB(1, 0), cB + kstep, voffB); PG8_STAGE_A(PG8_SA(1, 0), cA + kstep, 0, false); PG8_STAGE(PG8_SB(1, 1), cB + hstep + kstep, voffB);
        PG8_WAIT_V(6); PG8_BAR;
    }
    for (;;) {
        const bool has_next = S.next(ui + 1, nxt);
        const char* nA = GATHER ? cA : (has_next ? (const char*)g.A + (size_t)nxt.pm * tstep : cA); const char* nB = has_next ? (const char*)g.Bt + (size_t)nxt.pn * tstep : cB;
        if constexpr (GATHER) { if (has_next) { PG8_GVO(nvo, nxt); } else { _Pragma("unroll") for (int _h = 0; _h < 2; ++_h) _Pragma("unroll") for (int _i = 0; _i < 2; ++_i) nvo[_h][_i] = cvo[_h][_i]; } }
        for (int t = 0; t < nt; t += 2) {
            const bool last = (t == nt - 2);
            const char* a1 = cA + (size_t)(t + 1) * kstep;
            const char* a2 = last ? nA : cA + (size_t)(t + 2) * kstep; const char* b2 = last ? nB : cB + (size_t)(t + 2) * kstep;
            const char* a3 = a2 + kstep; const char* b3 = b2 + kstep;
            if constexpr (SP2) {
            PG8_LDB(B0, 0, 0); PG8_LDB(B1, 0, 1); PG8_SCHED; PG8_LDA(At, 0, 0); PG8_STAGE_A(PG8_SA(1, 1), a1, 1, false);
            PG8_WAIT_V(8); PG8_WAIT_L(0); PG8_BAR; PG8_MMA(0, 0, At, B0); PG8_MMA(0, 1, At, B1); PG8_BAR; PG8_SCHED;
            PG8_LDA(At, 0, 1); PG8_STAGE(PG8_SB(0, 0), b2, voffB); PG8_STAGE(PG8_SB(0, 1), b2 + hstep, voffB); PG8_STAGE_A(PG8_SA(0, 0), a2, 0, last);
            PG8_WAIT_V(8); PG8_WAIT_L(0); PG8_BAR; PG8_MMA(1, 0, At, B0); PG8_MMA(1, 1, At, B1); PG8_BAR; PG8_SCHED;
            PG8_LDB(B0, 1, 0); PG8_LDB(B1, 1, 1); PG8_SCHED; PG8_LDA(At, 1, 0); PG8_STAGE_A(PG8_SA(0, 1), a2, 1, last);
            PG8_WAIT_V(8); PG8_WAIT_L(0); PG8_BAR; PG8_MMA(0, 0, At, B0); PG8_MMA(0, 1, At, B1); PG8_BAR; PG8_SCHED;
            PG8_LDA(At, 1, 1); PG8_STAGE(PG8_SB(1, 0), b3, voffB); PG8_STAGE(PG8_SB(1, 1), b3 + hstep, voffB); PG8_STAGE_A(PG8_SA(1, 0), a3, 0, last);
            PG8_WAIT_V(8); PG8_WAIT_L(0); PG8_BAR; PG8_MMA(1, 0, At, B0); PG8_MMA(1, 1, At, B1); PG8_BAR; PG8_SCHED;
            } else {
            PG8_LDB(B0, 0, 0); PG8_SCHED; PG8_LDA(At, 0, 0); PG8_STAGE_A(PG8_SA(1, 1), a1, 1, false);
            PG8_WAIT_L(8); PG8_BAR; PG8_WAIT_L(0); PG8_MMA(0, 0, At, B0); PG8_BAR; PG8_SCHED;
            PG8_LDB(B1, 0, 1); PG8_STAGE(PG8_SB(0, 0), b2, voffB);
            PG8_BAR; PG8_WAIT_L(0); PG8_MMA(0, 1, At, B1); PG8_BAR;
            PG8_LDA(At, 0, 1); PG8_STAGE_A(PG8_SA(0, 0), a2, 0, last);
            PG8_BAR; PG8_WAIT_L(0); PG8_MMA(1, 0, At, B0); PG8_BAR; PG8_SCHED;
            PG8_STAGE(PG8_SB(0, 1), b2 + hstep, voffB);
            PG8_WAIT_V(6); PG8_BAR; PG8_MMA(1, 1, At, B1); PG8_BAR;
            PG8_LDB(B0, 1, 0); PG8_SCHED; PG8_LDA(At, 1, 0); PG8_STAGE_A(PG8_SA(0, 1), a2, 1, last);
            PG8_WAIT_L(8); PG8_BAR; PG8_WAIT_L(0); PG8_MMA(0, 0, At, B0); PG8_BAR; PG8_SCHED;
            PG8_LDB(B1, 1, 1); PG8_STAGE(PG8_SB(1, 0), b3, voffB);
            PG8_BAR; PG8_WAIT_L(0); PG8_MMA(0, 1, At, B1); PG8_BAR;
            PG8_LDA(At, 1, 1); PG8_STAGE_A(PG8_SA(1, 0), a3, 0, last);
            PG8_BAR; PG8_WAIT_L(0); PG8_MMA(1, 0, At, B0); PG8_BAR; PG8_SCHED;
            PG8_STAGE(PG8_SB(1, 1), b3 + hstep, voffB);
            PG8_WAIT_V(6); PG8_BAR; PG8_MMA(1, 1, At, B1); PG8_BAR;
            }
        }
        if constexpr (ALIGN_EPI) { if (wr == 0) PG8_BAR; }
        if constexpr (!Epi::AFTER_DRAIN) { E(acc, cur, wr, wc, fr, fq); if constexpr (Epi::REPS > 1) { asm volatile("" ::: "memory"); E(acc, cur, wr, wc, fr, fq); } }
        if (!has_next) break;
#pragma unroll
        for (int a = 0; a < 2; ++a)
#pragma unroll
            for (int b = 0; b < 2; ++b)
#pragma unroll
                for (int m = 0; m < 4; ++m)
#pragma unroll
                    for (int n = 0; n < 2; ++n) acc[a][b][m][n] = (f32x4){0.f, 0.f, 0.f, 0.f};
        cur = nxt; cA = nA; cB = nB; ++ui;
        if constexpr (GATHER) { _Pragma("unroll") for (int _h = 0; _h < 2; ++_h) _Pragma("unroll") for (int _i = 0; _i < 2; ++_i) cvo[_h][_i] = nvo[_h][_i]; }
        if constexpr (ALIGN_EPI) { if (wr == 1) PG8_BAR; }
    }
    PG8_WAIT_V(0);
    if constexpr (!ALIGN_EPI) { if (wr == 0) PG8_BAR; }
    PG8_BAR;
#undef PG8_SA
#undef PG8_SB
#undef PG8_STAGE
#undef PG8_STAGE_A
#undef PG8_GVO
#undef PG8_LDA
#undef PG8_LDB
#undef PG8_MMA
#undef PG8_WAIT_V
#undef PG8_WAIT_L
#undef PG8_BAR
#undef PG8_SCHED
}
}

namespace attn_body {
using bf16=__hip_bfloat16;
using bf16x8=__attribute__((ext_vector_type(8)))short;
using s16x4=__attribute__((ext_vector_type(4)))short;
using f32x16=__attribute__((ext_vector_type(16)))float;
using u32x4=__attribute__((ext_vector_type(4)))unsigned;
constexpr int BATCH=8,NHEAD=16,SEQ=4096,D=64,DM=NHEAD*D;
constexpr long HSTR=(long)BATCH*SEQ*D;
constexpr int NW=8,QBLK=32,QB=QBLK*NW,KVBLK=64,NQB=SEQ/QB;
constexpr int ATTN_PITCH=DM, ATTN_UNIT_ROWS=QB;
__device__ __forceinline__ int crow(int r,int hi){return (r&3)+8*(r>>2)+4*hi;}
#define SBAR() __builtin_amdgcn_sched_barrier(0)
__device__ __forceinline__ void cmask(f32x16&p0,f32x16&p1,int jb,int qrel,int hi){
  const float NEG=-INFINITY; int kb=64*jb+4*hi;
  #pragma unroll
  for(int r=0;r<16;++r){int kv=kb+(r&3)+8*(r>>2); if(kv>qrel)p0[r]=NEG; if(kv+32>qrel)p1[r]=NEG;}
}

constexpr int NSLOT=3, SLOTB=8192;
constexpr int LDS_K=0, LDS_V=NSLOT*SLOTB, LDS_WS=2*NSLOT*SLOTB, LDS_OST=LDS_WS+NW*64*4, LDS_FK=LDS_OST+NW*4096, LDS_BYTES=LDS_FK+SEQ*4;
constexpr float C2=0.125f*1.4426950408889634f;
__device__ __forceinline__ void glds16(const void*gsrc,unsigned lds_dst){unsigned keep;
  asm volatile("s_mov_b32 %0, m0\n\ts_mov_b32 m0, %2\n\ts_nop 0\n\tglobal_load_lds_dwordx4 %1, off\n\ts_mov_b32 m0, %0":"=&s"(keep):"v"(gsrc),"s"(lds_dst):"memory");}
__device__ __forceinline__ float max3f(float a,float b,float c){float r;asm("v_max3_f32 %0, %1, %2, %3":"=v"(r):"v"(a),"v"(b),"v"(c));return r;}
__device__ __forceinline__ float max2f(float a,float b){float r;asm("v_max_f32_e32 %0, %1, %2":"=v"(r):"v"(a),"v"(b));return r;}
__device__ __forceinline__ float fadd_s(float a,float b){float r;asm("v_add_f32_e32 %0, %1, %2":"=v"(r):"v"(a),"v"(b));return r;}
__device__ __forceinline__ float fsub_s(float a,float b){float r;asm("v_sub_f32_e32 %0, %1, %2":"=v"(r):"v"(a),"v"(b));return r;}
typedef float f32x2_t __attribute__((ext_vector_type(2))); typedef __bf16 bf16x2_t __attribute__((ext_vector_type(2)));
__device__ __forceinline__ unsigned cvtpk_s(float lo,float hi){f32x2_t v={lo,hi};bf16x2_t b=__builtin_convertvector(v,bf16x2_t);return __builtin_bit_cast(unsigned,b);}
#define WAIT_BAR(N) asm volatile("s_waitcnt vmcnt(" #N ") lgkmcnt(0)\n\ts_barrier":::"memory")

__device__ __forceinline__ void qkt(f32x16&p0,f32x16&p1,const char*Kslot,const bf16x8*qr,int r32,int hi){
  const char*kb=Kslot+hi*1024+r32*16;
  #pragma unroll
  for(int d0=0;d0<4;++d0){
    const bf16x8 b0=*reinterpret_cast<const bf16x8*>(kb+d0*2048);
    const bf16x8 b1=*reinterpret_cast<const bf16x8*>(kb+d0*2048+512);
    p0=__builtin_amdgcn_mfma_f32_32x32x16_bf16(b0,qr[d0],p0,0,0,0);p1=__builtin_amdgcn_mfma_f32_32x32x16_bf16(b1,qr[d0],p1,0,0,0);}
}
typedef __attribute__((address_space(3))) const char* lds_cptr;
typedef short v4i16_t __attribute__((ext_vector_type(4)));
__device__ __forceinline__ void kload8(bf16x8*kf,lds_cptr kp){
  kf[0]=*(const __attribute__((address_space(3))) bf16x8*)(kp);      kf[1]=*(const __attribute__((address_space(3))) bf16x8*)(kp+512);
  kf[2]=*(const __attribute__((address_space(3))) bf16x8*)(kp+2048); kf[3]=*(const __attribute__((address_space(3))) bf16x8*)(kp+2560);
  kf[4]=*(const __attribute__((address_space(3))) bf16x8*)(kp+4096); kf[5]=*(const __attribute__((address_space(3))) bf16x8*)(kp+4608);
  kf[6]=*(const __attribute__((address_space(3))) bf16x8*)(kp+6144); kf[7]=*(const __attribute__((address_space(3))) bf16x8*)(kp+6656);
}
__device__ __forceinline__ void kload2(bf16x8*kf,lds_cptr kp,int j){ kf[2*j]=*(const __attribute__((address_space(3))) bf16x8*)(kp+j*2048); kf[2*j+1]=*(const __attribute__((address_space(3))) bf16x8*)(kp+j*2048+512); }
__device__ __forceinline__ s16x4 vtr(lds_cptr p){ return __builtin_bit_cast(s16x4,__builtin_amdgcn_ds_read_tr16_b64_v4i16((__attribute__((address_space(3))) v4i16_t*)p)); }
__device__ __forceinline__ float rowmax(const f32x16&p0,const f32x16&p1){
  float a=max3f(p0[0],p0[1],p1[0]),b=max3f(p0[2],p0[3],p1[1]);a=max3f(a,p1[2],p1[3]);
  #pragma unroll
  for(int r=4;r<16;r+=4){a=max3f(a,p0[r],p0[r+1]);b=max3f(b,p0[r+2],p0[r+3]);a=max3f(a,p1[r],p1[r+1]);b=max3f(b,p1[r+2],p1[r+3]);}
  const float m=max2f(a,b);
  auto rr=__builtin_amdgcn_permlane32_swap(__float_as_uint(m),__float_as_uint(m),false,false);
  return max2f(__uint_as_float(rr[0]),__uint_as_float(rr[1]));
}
__device__ __forceinline__ void pv(f32x16*o,int vb,bf16x8 pa0,bf16x8 pa1,bf16x8 pa2,bf16x8 pa3){
  #pragma unroll
  for(int d0=0;d0<2;++d0){s16x4 lo[4],hi[4];
    #pragma unroll
    for(int ks=0;ks<4;++ks){
      asm volatile("ds_read_b64_tr_b16 %0,%1 offset:%c2":"=&v"(lo[ks]):"v"(vb),"i"(d0*4096+ks*1024):"memory");
      asm volatile("ds_read_b64_tr_b16 %0,%1 offset:%c2":"=&v"(hi[ks]):"v"(vb),"i"(d0*4096+ks*1024+512):"memory");}
    asm volatile("s_waitcnt lgkmcnt(0)":::"memory");SBAR();
    #define PK(k) (bf16x8){lo[k][0],lo[k][1],lo[k][2],lo[k][3],hi[k][0],hi[k][1],hi[k][2],hi[k][3]}
    o[d0]=__builtin_amdgcn_mfma_f32_32x32x16_bf16(pa0,PK(0),o[d0],0,0,0);
    o[d0]=__builtin_amdgcn_mfma_f32_32x32x16_bf16(pa1,PK(1),o[d0],0,0,0);
    o[d0]=__builtin_amdgcn_mfma_f32_32x32x16_bf16(pa2,PK(2),o[d0],0,0,0);
    o[d0]=__builtin_amdgcn_mfma_f32_32x32x16_bf16(pa3,PK(3),o[d0],0,0,0);
    #undef PK
  }
}

#ifndef ATTN_STORE16
#define ATTN_STORE16(p,v) (*(u32x4*)(p)=(v))
#endif
template<int THRL> __device__ __forceinline__ void attn_unit(int b,int h,int qb,const bf16*Q,const bf16*__restrict__ K,const bf16*__restrict__ V,bf16*O,const float*__restrict__ FP,const unsigned*__restrict__ NQ,const unsigned*__restrict__ NK,unsigned*wq,volatile __attribute__((address_space(3))) unsigned*wslot,char*shm,const int wv){
  int tid_ = wv * 64 + (int)__builtin_amdgcn_mbcnt_hi(~0u, __builtin_amdgcn_mbcnt_lo(~0u, 0u)); asm volatile("" : "+v"(tid_));
  const int tid=tid_,lane=tid&63,r32=lane&31,hi=lane>>5; const int wid=__builtin_amdgcn_readfirstlane(tid>>6);
  const long rowbase=(long)b*SEQ; const int q0=qb*QB;
  const bf16*Qw=Q+(long)h*HSTR+(rowbase+q0+wid*QBLK)*D;
  unsigned wnext=0u; if(tid==0)wnext=__hip_atomic_fetch_add(wq,1u,__ATOMIC_RELAXED,__HIP_MEMORY_SCOPE_AGENT);
  const float*Fbh=FP+(long)(b*NHEAD+h)*SEQ;
  const int NTfull=(q0+QB)/KVBLK; int jstart;
  { typedef float f32x2_t __attribute__((ext_vector_type(2)));
    const int jt=lane<NTfull?lane:NTfull-1;
    const f32x2_t nk=*reinterpret_cast<const f32x2_t*>(NK+2*jt); const float kn=sqrtf(nk.x+nk.y)*1.02f;
    float qn2=0.f,kd=0.f;
    #pragma unroll
    for(int t=0;t<4;++t){ const f32x2_t a=*reinterpret_cast<const f32x2_t*>(NQ+2*(4*qb+t)); qn2=fmaxf(qn2,a.x+a.y); kd=fmaxf(kd,__uint_as_float(__builtin_amdgcn_readlane(__float_as_uint(kn),4*qb+t))); }
    const float qn=sqrtf(qn2)*1.02f, lbv=-qn*kd, bias=Fbh[q0]-Fbh[64*jt+63];
    const bool need=(lane<NTfull)&&((lane>=NTfull-4)||!(qn*kn+bias<lbv-40.f));
    const unsigned long long bal=__ballot(need);
    jstart=bal?(__ffsll((long long)bal)-1):0; jstart=__builtin_amdgcn_readfirstlane(jstart)&~1; }
  if(tid==0)*wslot=wnext;
  const bf16*Kh=K+(long)h*HSTR+(rowbase+(long)jstart*KVBLK)*D,*Vh=V+(long)h*HSTR+(rowbase+(long)jstart*KVBLK)*D;
  const lds_cptr shm3=(lds_cptr)shm;
  const unsigned lds0=(unsigned)(uintptr_t)shm;
  float*wsf=(float*)(shm+LDS_WS)+wid*64;
  const bf16*ksrc=Kh+(long)lane*D+wid*8;
  const bf16*vsrc=Vh+(long)(16*(wid&3)+(lane>>2))*D+(wid>>2)*32+(lane&3)*8;
  const unsigned kdst=lds0+LDS_K+wid*1024, vdst=lds0+LDS_V+wid*1024;
  #define DMA_K(t,slot) glds16(ksrc+(long)(t)*KVBLK*D,(unsigned)__builtin_amdgcn_readfirstlane(kdst+(slot)))
  #define DMA_V(t,slot) glds16(vsrc+(long)(t)*KVBLK*D,(unsigned)__builtin_amdgcn_readfirstlane(vdst+(slot)))
  const int vb0=(int)(lds0+LDS_V)+((lane>>4)&1)*32+(lane&3)*8+(4*hi+((lane&15)>>2))*64;
  const char*Kbase=shm+LDS_K; bf16x8 kf[8];
  const lds_cptr kp0=shm3+LDS_K+hi*1024+r32*16; const lds_cptr vp0=shm3+LDS_V+((lane>>4)&1)*32+(lane&3)*8+(4*hi+((lane&15)>>2))*64;
  const int NT=NTfull-jstart;
  DMA_K(0,0);DMA_V(0,0);DMA_K(1,SLOTB);
  { typedef float f32x4_t __attribute__((ext_vector_type(4))); __attribute__((address_space(3))) f32x4_t*fdst=(__attribute__((address_space(3))) f32x4_t*)(shm3+LDS_FK);
    for(int i=tid;i<NT*(KVBLK/4);i+=NW*64)fdst[i]=*reinterpret_cast<const f32x4_t*>(Fbh+jstart*KVBLK+4*i); }
  const float fq=Fbh[q0+wid*QBLK+r32];
  const __attribute__((address_space(3))) float*fk3=(const __attribute__((address_space(3))) float*)(shm3+LDS_FK)+4*hi;
  #define FINIT(P0,P1,t) do{ typedef float f32x4_t __attribute__((ext_vector_type(4))); const __attribute__((address_space(3))) float*fk_=fk3+(t)*KVBLK; \
    _Pragma("unroll") for(int g_=0;g_<4;++g_){ const f32x4_t a_=*(const __attribute__((address_space(3))) f32x4_t*)(fk_+8*g_), b_=*(const __attribute__((address_space(3))) f32x4_t*)(fk_+32+8*g_); \
      _Pragma("unroll") for(int j_=0;j_<4;++j_){ P0[4*g_+j_]=tq-a_[j_]; P1[4*g_+j_]=tq-b_[j_]; } } }while(0)
  bf16x8 qr[4];
  #pragma unroll
  for(int d0=0;d0<4;++d0)qr[d0]=*reinterpret_cast<const bf16x8*>(&Qw[(long)r32*D+d0*16+hi*8]);
  float l_reg=0.f;f32x16 o[2];o[0]=f32x16{};o[1]=f32x16{};float tq=fq;
  const int qrel=wid*QBLK+r32;
  #define CMASK(P0,P1,t) do{int jb_=(t)-(NT-4); if(jb_>=0)cmask(P0,P1,jb_,qrel,hi);}while(0)
  bool resc=false;
  #define START(P0,P1) do{ const float rm=rowmax(P0,P1); resc=false; \
    { const float dl=rm; \
      _Pragma("unroll") for(int r=0;r<16;++r){P0[r]=fsub_s(P0[r],dl);P1[r]=fsub_s(P1[r],dl);} \
      tq=fsub_s(tq,dl); } \
    _Pragma("unroll") for(int r=0;r<16;++r)P0[r]=__builtin_amdgcn_exp2f(P0[r]); }while(0)
  #define RESC() do{ if(resc){ asm volatile("s_waitcnt lgkmcnt(0)":::"memory"); \
      _Pragma("unroll") for(int d_=0;d_<2;++d_) _Pragma("unroll") for(int r=0;r<16;++r)o[d_][r]*=wsf[crow(r,hi)]; } }while(0)
  f32x16 pA0,pA1,pB0,pB1;
  int sl_prev=0,sl_cur=0,sl_next=SLOTB;
  #define ROT() do{sl_prev=sl_cur;sl_cur=sl_next;sl_next=(sl_next==(NSLOT-1)*SLOTB)?0:sl_next+SLOTB;}while(0)
  DMA_K(2,2*SLOTB);
  WAIT_BAR(3);
  FINIT(pA0,pA1,0);
  qkt(pA0,pA1,Kbase,qr,r32,hi);asm volatile("s_nop 15\n\ts_nop 7":"+v"(pA0),"+v"(pA1));CMASK(pA0,pA1,0);
  START(pA0,pA1);
  _Pragma("unroll") for(int r=0;r<16;++r)pA1[r]=__builtin_amdgcn_exp2f(pA1[r]);
  WAIT_BAR(0);
  DMA_K(3,0);DMA_V(1,SLOTB);
  ROT();
  kload8(kf,kp0+sl_cur);
  WAIT_BAR(2);
  s16x4 vlo[8],vhi[8]; u32x4 pw0,pw1,pw2,pw3;
  #define PKW(P,B) cvtpk_s(P[B],P[B+1])
  #define PAF(k) __builtin_bit_cast(bf16x8,pw##k)
  #define VFR(i) (bf16x8){vlo[i][0],vlo[i][1],vlo[i][2],vlo[i][3],vhi[i][0],vhi[i][1],vhi[i][2],vhi[i][3]}
  #define PIN(x) asm volatile("":"+v"(x))
  #define MX3(a,b,c) __builtin_fmaxf(__builtin_fmaxf((a),(b)),(c))
  #define GAPA(MF,A0,A1,A2,A3,W0,W1,PW) do{ MF; sacc+=A0; sacc+=A1; sacc+=A2; sacc+=A3; PIN(sacc); W0; W1; PIN(PW); SBAR(); }while(0)
  #define EX(v) __builtin_amdgcn_exp2f(v)
  #define GAPB(MF,X,B) do{ MF; X[B]=EX(X[B]); X[B+1]=EX(X[B+1]); X[B+2]=EX(X[B+2]); X[B+3]=EX(X[B+3]); PIN(X); SBAR(); }while(0)
  #define VRD(i) do{ vlo[i]=vtr(vp_+(((i)>>2)*4096+((i)&3)*1024)); vhi[i]=vtr(vp_+(((i)>>2)*4096+((i)&3)*1024+512)); }while(0)
  #define KRD(G,j) do{ if(G){ kload2(kf,kp0+sl_next,j); SBAR(); } }while(0)
  #define STEP(C0,C1,P0,P1,t,GK,GV,GL) do{ SBAR(); FINIT(C0,C1,t); SBAR(); \
    const lds_cptr vp_=vp0+sl_prev; \
    VRD(0); SBAR(); float sacc=(P0[0]+P0[1]); \
    GAPA(C0=__builtin_amdgcn_mfma_f32_32x32x16_bf16(kf[0],qr[0],C0,0,0,0), P0[2],P0[3],P0[4],P0[5],     pw0[0]=PKW(P0,0), pw0[1]=PKW(P0,2), pw0); \
    VRD(4); SBAR(); GAPA(C1=__builtin_amdgcn_mfma_f32_32x32x16_bf16(kf[1],qr[0],C1,0,0,0), P0[6],P0[7],P0[8],P0[9],     pw0[2]=PKW(P0,4), pw0[3]=PKW(P0,6), pw0); \
    VRD(1); SBAR(); GAPA(C0=__builtin_amdgcn_mfma_f32_32x32x16_bf16(kf[2],qr[1],C0,0,0,0),   P0[10],P0[11],P0[12],P0[13], pw1[0]=PKW(P0,8), pw1[1]=PKW(P0,10), pw1); \
    VRD(5); SBAR(); GAPA(C1=__builtin_amdgcn_mfma_f32_32x32x16_bf16(kf[3],qr[1],C1,0,0,0),   P0[14],P0[15],P1[0],P1[1],   pw1[2]=PKW(P0,12),pw1[3]=PKW(P0,14), pw1); \
    VRD(2); SBAR(); GAPA(C0=__builtin_amdgcn_mfma_f32_32x32x16_bf16(kf[4],qr[2],C0,0,0,0),   P1[2],P1[3],P1[4],P1[5],     pw2[0]=PKW(P1,0), pw2[1]=PKW(P1,2), pw2); \
    VRD(6); SBAR(); GAPA(C1=__builtin_amdgcn_mfma_f32_32x32x16_bf16(kf[5],qr[2],C1,0,0,0),   P1[6],P1[7],P1[8],P1[9],     pw2[2]=PKW(P1,4), pw2[3]=PKW(P1,6), pw2); \
    VRD(3); SBAR(); GAPA(C0=__builtin_amdgcn_mfma_f32_32x32x16_bf16(kf[6],qr[3],C0,0,0,0),   P1[10],P1[11],P1[12],P1[13], pw3[0]=PKW(P1,8), pw3[1]=PKW(P1,10), pw3); \
    VRD(7); SBAR(); GAPA(C1=__builtin_amdgcn_mfma_f32_32x32x16_bf16(kf[7],qr[3],C1,0,0,0),   P1[14],P1[15],0.f,0.f,       pw3[2]=PKW(P1,12),pw3[3]=PKW(P1,14), pw3); \
    l_reg+=sacc; \
    if(GK){DMA_K((t)+3,sl_cur);} if(GV){DMA_V((t)+1,sl_next);} \
    CMASK(C0,C1,t); \
    { float a=MX3(C0[0],C0[1],C1[0]),b=MX3(C0[2],C0[3],C1[1]); a=MX3(a,C1[2],C1[3]); \
      _Pragma("unroll") for(int r=4;r<16;r+=4){a=MX3(a,C0[r],C0[r+1]);b=MX3(b,C0[r+2],C0[r+3]);a=MX3(a,C1[r],C1[r+1]);b=MX3(b,C1[r+2],C1[r+3]);} \
      float rm=__builtin_fmaxf(a,b); { auto rr=__builtin_amdgcn_permlane32_swap(__float_as_uint(rm),__float_as_uint(rm),false,false); rm=__builtin_fmaxf(__uint_as_float(rr[0]),__uint_as_float(rr[1])); } \
      resc=false; \
      if(__builtin_expect(__any(rm>(float)THRL),0)){ const float dl=__builtin_fmaxf(rm,0.f); \
        _Pragma("unroll") for(int r=0;r<16;++r){C0[r]-=dl;C1[r]-=dl;} \
        tq-=dl; \
        const float f=__builtin_amdgcn_exp2f(-dl); l_reg*=f; if(hi==0)wsf[r32]=f; resc=true; } } \
    SBAR(); \
    GAPB(o[0]=__builtin_amdgcn_mfma_f32_32x32x16_bf16(PAF(0),VFR(0),o[0],0,0,0), C0,0); \
    GAPB(o[1]=__builtin_amdgcn_mfma_f32_32x32x16_bf16(PAF(0),VFR(4),o[1],0,0,0), C0,4); \
    KRD(GL,0); GAPB(o[0]=__builtin_amdgcn_mfma_f32_32x32x16_bf16(PAF(1),VFR(1),o[0],0,0,0), C0,8); \
    KRD(GL,1); GAPB(o[1]=__builtin_amdgcn_mfma_f32_32x32x16_bf16(PAF(1),VFR(5),o[1],0,0,0), C0,12); \
    KRD(GL,2); GAPB(o[0]=__builtin_amdgcn_mfma_f32_32x32x16_bf16(PAF(2),VFR(2),o[0],0,0,0), C1,0); \
    KRD(GL,3); GAPB(o[1]=__builtin_amdgcn_mfma_f32_32x32x16_bf16(PAF(2),VFR(6),o[1],0,0,0), C1,4); \
    GAPB(o[0]=__builtin_amdgcn_mfma_f32_32x32x16_bf16(PAF(3),VFR(3),o[0],0,0,0), C1,8); \
    GAPB(o[1]=__builtin_amdgcn_mfma_f32_32x32x16_bf16(PAF(3),VFR(7),o[1],0,0,0), C1,12); \
    }while(0)
  int t=1;
  #undef CMASK
  #define CMASK(P0,P1,t) do{}while(0)
  for(;t+5<NT;t+=2){
    STEP(pB0,pB1,pA0,pA1,t,true,true,true);     WAIT_BAR(2); RESC(); ROT();
    STEP(pA0,pA1,pB0,pB1,t+1,true,true,true);   WAIT_BAR(2); RESC(); ROT();
  }
  #undef CMASK
  #define CMASK(P0,P1,t) do{int jb_=(t)-(NT-4); if(jb_>=0)cmask(P0,P1,jb_,qrel,hi);}while(0)
  #define ENDW(tt) do{ if((tt)+3<NT){WAIT_BAR(2);} else if((tt)+2<NT){WAIT_BAR(1);} else {WAIT_BAR(0);} }while(0)
  for(;t+1<NT;t+=2){
    STEP(pB0,pB1,pA0,pA1,t,(t+3<NT),(t+1<NT),(t+1<NT));       ENDW(t);   RESC(); ROT();
    STEP(pA0,pA1,pB0,pB1,t+1,(t+4<NT),(t+2<NT),(t+2<NT));     ENDW(t+1); RESC(); ROT();
  }
  STEP(pB0,pB1,pA0,pA1,NT-1,false,false,false); RESC();
  { float sacc=pB0[0]+pB0[1]; _Pragma("unroll") for(int r=2;r<16;++r)sacc+=pB0[r]; _Pragma("unroll") for(int r=0;r<16;++r)sacc+=pB1[r]; l_reg+=sacc;
    pw0=(u32x4){PKW(pB0,0),PKW(pB0,2),PKW(pB0,4),PKW(pB0,6)};pw1=(u32x4){PKW(pB0,8),PKW(pB0,10),PKW(pB0,12),PKW(pB0,14)};pw2=(u32x4){PKW(pB1,0),PKW(pB1,2),PKW(pB1,4),PKW(pB1,6)};pw3=(u32x4){PKW(pB1,8),PKW(pB1,10),PKW(pB1,12),PKW(pB1,14)};
    SBAR(); pv(o,vb0+sl_cur,PAF(0),PAF(1),PAF(2),PAF(3)); }
  #undef PKW
  #undef PAF
  #undef VFR
  #undef PIN
  #undef MX3
  #undef GAPA
  #undef GAPB
  #undef EX
  #undef VRD
  #undef KRD
  #undef STEP
  #undef ENDW
  {auto rr=__builtin_amdgcn_permlane32_swap(__float_as_uint(l_reg),__float_as_uint(l_reg),false,false);l_reg=__uint_as_float(rr[0])+__uint_as_float(rr[1]);}
  if(hi==0)wsf[32+r32]=l_reg;asm volatile("s_waitcnt lgkmcnt(0)":::"memory");
  float rli[16];
  #pragma unroll
  for(int r=0;r<16;++r)rli[r]=__builtin_amdgcn_rcpf(wsf[32+crow(r,hi)]);
  bf16*Ow=O+(rowbase+q0+wid*QBLK)*DM+h*D;
  { bf16*stg=(bf16*)(shm+LDS_OST)+wid*2048;
    #pragma unroll
    for(int r=0;r<16;++r){const int orow=crow(r,hi);
      #pragma unroll
      for(int d0=0;d0<2;++d0)stg[orow*64+d0*32+r32]=__float2bfloat16(o[d0][r]*rli[r]);}
    asm volatile("s_waitcnt lgkmcnt(0)":::"memory");
    #pragma unroll
    for(int i=0;i<4;++i){const int row=i*8+(lane>>3),ch=lane&7; const u32x4 v=*(const u32x4*)(stg+row*64+ch*8); ATTN_STORE16(Ow+(long)row*DM+ch*8,v);} }
  asm volatile("s_waitcnt lgkmcnt(0)\n\ts_barrier":::"memory");
  #undef FINIT
  #undef DMA_K
  #undef DMA_V
  #undef CMASK
  #undef START
  #undef RESC
  #undef ROT
}
constexpr int ATTN_LDS_BYTES=LDS_BYTES;
#undef SBAR
#undef WAIT_BAR
}
#define GAS __attribute__((address_space(1)))
#define LAS __attribute__((address_space(3)))
typedef unsigned short bf16;
typedef unsigned v4u __attribute__((ext_vector_type(4)));
typedef float f32x4 __attribute__((ext_vector_type(4)));
typedef short bf16x8 __attribute__((ext_vector_type(8)));
typedef GAS unsigned gu32;
typedef GAS unsigned long long gu64;
#define RLX_AGENT __ATOMIC_RELAXED, __HIP_MEMORY_SCOPE_AGENT
#define LDS_WAIT() asm volatile("s_waitcnt lgkmcnt(0)" ::: "memory")
#define VM_WAIT() asm volatile("s_waitcnt vmcnt(0)" ::: "memory")
__device__ __forceinline__ unsigned long long rt() { return __builtin_amdgcn_s_memrealtime(); }
__device__ __forceinline__ unsigned f2bf(float f) { unsigned u = __builtin_bit_cast(unsigned, f); return (u + 0x7fffu + ((u >> 16) & 1u)) >> 16; }
__device__ __forceinline__ unsigned pk2(float lo, float hi) { return f2bf(lo) | (f2bf(hi) << 16); }

#define XB_TMO      128
#define XB_XCNT(j)  (256  + 64 * (j))
#define XB_XSUB(j)  (1280 + 64 * (j))
#define XB_XGEN(j)  (2304 + 64 * (j))
#define XB_TOP      3328
#define XB_TOPGEN   3392
#define XCD_BAR_WORDS 3456
#define XB_SPIN_CAP (1u << 18)

__device__ __forceinline__ unsigned xb_ld(unsigned* p)              { return __hip_atomic_load(p, __ATOMIC_RELAXED, __HIP_MEMORY_SCOPE_AGENT); }
__device__ __forceinline__ unsigned xb_add(unsigned* p, unsigned v) { return __hip_atomic_fetch_add(p, v, __ATOMIC_RELAXED, __HIP_MEMORY_SCOPE_AGENT); }
__device__ __forceinline__ unsigned xb_xcc_id() { return (unsigned)__builtin_amdgcn_s_getreg((3 << 11) | 20) & 0xFu; }
#define XB_SPIN(cond, bar) do { unsigned _sp = 0; while (cond) { __builtin_amdgcn_s_sleep(1); \
    if ((++_sp & 255u) == 0u) { if (xb_ld(&(bar)[XB_TMO])) break; if (_sp > XB_SPIN_CAP) { atomicAdd(&(bar)[XB_TMO], 1u); break; } } } } while (0)

struct XcdBarrier {
    unsigned* bar; unsigned x;
    volatile LAS unsigned* st;
};

__device__ __forceinline__ XcdBarrier xcd_barrier_post(unsigned* bar, volatile LAS unsigned* st) {
    XcdBarrier b; b.bar = bar; b.x = xb_xcc_id(); b.st = st;
    if (threadIdx.x == 0) (void)xb_add(&bar[XB_XCNT(b.x)], 1u);
    return b;
}
__device__ __forceinline__ void xcd_barrier_complete(unsigned* bar, unsigned x, unsigned& nloc, unsigned& nx) {
    const unsigned G = gridDim.x * gridDim.y * gridDim.z;
    unsigned sum, cnt, mine, sp = 0u;
    for (;;) {
        sum = 0u; cnt = 0u; mine = 0u;
#pragma unroll
        for (unsigned j = 0; j < 16; ++j) { const unsigned c = xb_ld(&bar[XB_XCNT(j)]); sum += c; cnt += (c > 0u) ? 1u : 0u; mine = (j == x) ? c : mine; }
        if (sum == G) break;
        __builtin_amdgcn_s_sleep(1);
        if ((++sp & 255u) == 0u) { if (xb_ld(&bar[XB_TMO])) break; if (sp > XB_SPIN_CAP) { atomicAdd(&bar[XB_TMO], 1u); break; } }
    }
    nloc = mine > 0u ? mine : 1u; nx = cnt > 0u ? cnt : 1u;
}

__device__ __forceinline__ void xcd_barrier(const XcdBarrier& b) {
    asm volatile("s_waitcnt vmcnt(0)" ::: "memory");
    __syncthreads();
    if (threadIdx.x == 0) {
        unsigned* bar = b.bar;
        __builtin_amdgcn_s_waitcnt(0);
        unsigned nloc = b.st[0], nx = b.st[1];
        if (nloc == 0u) { xcd_barrier_complete(bar, b.x, nloc, nx); b.st[0] = nloc; b.st[1] = nx; }
        const unsigned old = xb_add(&bar[XB_XSUB(b.x)], 1u);
        const unsigned gen = old / nloc;
        if (old + 1u == (gen + 1u) * nloc) {
            __builtin_amdgcn_fence(__ATOMIC_RELEASE, "agent");
            asm volatile("s_waitcnt vmcnt(0)" ::: "memory");
            const unsigned og = xb_add(&bar[XB_TOP], 1u);
            const unsigned tg = og / nx;
            if (og + 1u == (tg + 1u) * nx) xb_add(&bar[XB_TOPGEN], 1u);
            else XB_SPIN(xb_ld(&bar[XB_TOPGEN]) == tg, bar);
            __builtin_amdgcn_fence(__ATOMIC_ACQUIRE, "agent");
            xb_add(&bar[XB_XGEN(b.x)], 1u);
            asm volatile("s_waitcnt vmcnt(0)" ::: "memory");
        } else {
            XB_SPIN(xb_ld(&bar[XB_XGEN(b.x)]) == gen, bar);
            __builtin_amdgcn_fence(__ATOMIC_ACQUIRE, "agent");
            asm volatile("s_waitcnt vmcnt(0)" ::: "memory");
        }
    }
    __syncthreads();
}

constexpr size_t MiB = 1u << 20;
constexpr size_t SZB = (size_t)NTOK * DM * 2;
constexpr size_t WS_CTL = 0, CTL_ZERO_BYTES = 1 * MiB;
constexpr size_t WS_MOD = 1 * MiB;
constexpr size_t WS_LB = WS_MOD + 768 * 1024;
constexpr size_t WS_FP = 2 * MiB;
constexpr size_t WS_LS = 4 * MiB;
constexpr size_t WS_LIST = 6 * MiB;
constexpr size_t WS_ASGE = 10 * MiB;
constexpr size_t WS_ASGW = 10 * MiB + 512 * 1024;
constexpr size_t WS_WRT = 11 * MiB;
constexpr size_t WS_WAFT = 11 * MiB + 512 * 1024;
constexpr size_t WS_WIN = 12 * MiB;
constexpr size_t WS_WBR = WS_WIN + 72 * MiB;
constexpr size_t WS_WOUT = WS_WBR + 16 * MiB;
constexpr size_t WS_WGU = WS_WOUT + 8 * MiB;
constexpr size_t WS_WD = WS_WGU + 512 * MiB;
constexpr size_t WS_X1 = WS_WD + 256 * MiB;
constexpr size_t WS_HB = WS_X1 + 128 * MiB;
constexpr size_t WS_PROJ = WS_HB + 64 * MiB;
constexpr size_t WS_LF = WS_PROJ + 576 * MiB;
constexpr size_t WS_OAB = WS_LF + 128 * MiB;
constexpr size_t WS_HST = WS_OAB + 128 * MiB;
constexpr size_t WS_HTD = WS_HST + 12 * MiB;
constexpr size_t WS_EB = WS_HTD + 1 * MiB;
constexpr size_t WS_END = WS_EB + 6 * MiB;
constexpr size_t WS_Y = WS_PROJ;
constexpr size_t WS_MG = WS_PROJ + 2 * SZB;
constexpr int MOE_TILES_MAX = 544;
constexpr size_t WS_ACT = WS_PROJ;
constexpr size_t WS_YR = WS_PROJ + 272 * MiB;
static_assert(WS_YR + 272 * MiB <= WS_LF, "MoE buffers fit over the projection buffers");
static_assert(WS_END <= (size_t)2048 * MiB, "workspace map fits in 2 GiB");
constexpr int CW_BAR = 4096;
constexpr int CW_WQ = 8192;
constexpr int CW_NRM = 131072;
constexpr int CW_CNT = 16384;

constexpr int RING_OFF = 0, RING_BYTES = 131072;
constexpr int SPITCH = 1032;
constexpr int SCR_WAVE = 16640;
constexpr int TAB_OFF = 139264;
constexpr int T_MISC = TAB_OFF;
constexpr int T_TBASE = TAB_OFF + 256;
constexpr int T_CNT = TAB_OFF + 512;
constexpr int T_LCNT = TAB_OFF + 640;
constexpr int T_GBASE = TAB_OFF + 768;
constexpr int T_RT2E = TAB_OFF + 1024;
constexpr int T_ASG = TAB_OFF + 2048;
constexpr int PART_OFF = 147456;
constexpr int LDS_BYTES = 163840;
static_assert(8 * SCR_WAVE <= TAB_OFF && 8 * 4 * SPITCH * 4 <= TAB_OFF && T_ASG + 8 * 512 <= PART_OFF && PART_OFF + 16384 <= LDS_BYTES, "LDS map");

typedef float f32x2 __attribute__((ext_vector_type(2)));
typedef unsigned u32x2 __attribute__((ext_vector_type(2)));
typedef float f32x16 __attribute__((ext_vector_type(16)));
typedef short v4i16_t __attribute__((ext_vector_type(4)));
#define LDS_BARRIER() do { asm volatile("s_waitcnt lgkmcnt(0)" ::: "memory"); __builtin_amdgcn_s_barrier(); asm volatile("" ::: "memory"); } while (0)

__device__ __forceinline__ float wave_sum(float v) { return pg8::rows4_sum(pg8::row16_sum(v)); }
__device__ __forceinline__ void pair32(float& v, int& i) { auto a = __builtin_amdgcn_permlane32_swap(__float_as_uint(v), __float_as_uint(v), false, false); auto b = __builtin_amdgcn_permlane32_swap((unsigned)i, (unsigned)i, false, false);
    const float v0 = __uint_as_float(a[0]), v1 = __uint_as_float(a[1]); const int i0 = (int)b[0], i1 = (int)b[1]; const bool t = v1 > v0 || (v1 == v0 && i1 < i0); v = t ? v1 : v0; i = t ? i1 : i0; }
__device__ __forceinline__ void pair16(float& v, int& i) { auto a = __builtin_amdgcn_permlane16_swap(__float_as_uint(v), __float_as_uint(v), false, false); auto b = __builtin_amdgcn_permlane16_swap((unsigned)i, (unsigned)i, false, false);
    const float v0 = __uint_as_float(a[0]), v1 = __uint_as_float(a[1]); const int i0 = (int)b[0], i1 = (int)b[1]; const bool t = v1 > v0 || (v1 == v0 && i1 < i0); v = t ? v1 : v0; i = t ? i1 : i0; }
__device__ __forceinline__ unsigned pkbf(float lo, float hi) { return pg8::cvt_pk_bf16(lo, hi); }

struct TpRegs { f32x4 v[16]; };
__device__ __forceinline__ void tp_load(TpRegs& t, const float* __restrict__ src, int ld, int lane) {
#pragma unroll
    for (int i = 0; i < 16; ++i) { const int kk = 4 * i + (lane >> 4), nn = 4 * (lane & 15); t.v[i] = *(const GAS f32x4*)(src + (size_t)kk * ld + nn); }
}
__device__ __forceinline__ void tp_store(const TpRegs& t, bf16* __restrict__ dst, LAS float* scr, int lane) {
#pragma unroll
    for (int i = 0; i < 16; ++i) { const int kk = 4 * i + (lane >> 4), nn = 4 * (lane & 15);
        scr[(nn + 0) * 65 + kk] = t.v[i].x; scr[(nn + 1) * 65 + kk] = t.v[i].y; scr[(nn + 2) * 65 + kk] = t.v[i].z; scr[(nn + 3) * 65 + kk] = t.v[i].w; }
    LDS_WAIT(); asm volatile("" ::: "memory");
    const int kc = lane & 7;
#pragma unroll
    for (int i2 = 0; i2 < 8; ++i2) { const int n = (lane >> 3) + 8 * i2; const LAS float* s = scr + n * 65 + 8 * kc;
        v4u o; o.x = pkbf(s[0], s[1]); o.y = pkbf(s[2], s[3]); o.z = pkbf(s[4], s[5]); o.w = pkbf(s[6], s[7]);
        *(GAS v4u*)(dst + (size_t)n * DM + 8 * kc) = o; }
    LDS_WAIT(); asm volatile("" ::: "memory");
}
struct TpItem { const float* src; int ld; bf16* dst; };

struct Ptrs {
    const float *x, *c, *w_in, *fox_f_bias, *hg_lb_logits, *hg_norm_w, *w_branch, *w_out, *ada_w, *ada_b, *ln1_g, *ln1_b, *w_router, *b_router,
                *w_gate, *b_gate, *w_up, *b_up, *w_down, *b_down, *ln2_g, *ln2_b;
    float* out; unsigned char* ws;
};

__device__ __forceinline__ void p0_prologue(const Ptrs& P, LAS unsigned char* lds, int G, const int wv) {
    int tid_ = wv * 64 + (int)__builtin_amdgcn_mbcnt_hi(~0u, __builtin_amdgcn_mbcnt_lo(~0u, 0u)); asm volatile("" : "+v"(tid_)); const int tid = tid_, lane = tid & 63, wave = __builtin_amdgcn_readfirstlane(tid >> 6);
    unsigned char* ws = P.ws;
    {
        LAS float* cact = (LAS float*)(lds);
        LAS float* part = (LAS float*)(lds + 32768);
        for (int idx = tid; idx < NB * DM; idx += 512) { const int b = idx >> 10, k = idx & 1023; const float v = P.c[idx]; cact[k * 8 + b] = v / (1.0f + __expf(-v)); }
        __syncthreads();
        float* MOD = (float*)(ws + WS_MOD);
        for (int u = blockIdx.x; u < NLAYER * 96; u += G) {
            const int l = u / 96, cc = u % 96, col = cc * 64 + lane;
            const float* wp = P.ada_w + ((size_t)l * DM + wave * 128) * 6144 + col;
            float acc[8];
#pragma unroll
            for (int b = 0; b < 8; ++b) acc[b] = 0.f;
#pragma unroll 8
            for (int k = 0; k < 128; ++k) { const float wv = wp[(size_t)k * 6144]; const f32x4 c0 = *(const LAS f32x4*)(cact + (wave * 128 + k) * 8), c1 = *(const LAS f32x4*)(cact + (wave * 128 + k) * 8 + 4);
                acc[0] += c0.x * wv; acc[1] += c0.y * wv; acc[2] += c0.z * wv; acc[3] += c0.w * wv; acc[4] += c1.x * wv; acc[5] += c1.y * wv; acc[6] += c1.z * wv; acc[7] += c1.w * wv; }
#pragma unroll
            for (int b = 0; b < 8; ++b) part[(wave * 8 + b) * 64 + lane] = acc[b];
            __syncthreads();
            { const int b = tid >> 6; float s = 0.f;
#pragma unroll
              for (int w = 0; w < 8; ++w) s += part[(w * 8 + b) * 64 + lane];
              MOD[((size_t)l * NB + b) * 6144 + col] = s + P.ada_b[(size_t)l * 6144 + col]; }
            __syncthreads();
        }
    }
    if (blockIdx.x == G - 1) {
        float* LB = (float*)(ws + WS_LB);
        for (int d = tid; d < DM; d += 512) {
            const float a0 = P.hg_lb_logits[d], a1 = P.hg_lb_logits[DM + d], a2 = P.hg_lb_logits[2 * DM + d], a3 = P.hg_lb_logits[3 * DM + d];
            const float mx = fmaxf(fmaxf(a0, a1), fmaxf(a2, a3));
            const float e0 = expf(a0 - mx), e1 = expf(a1 - mx), e2 = expf(a2 - mx), e3 = expf(a3 - mx), inv = 1.0f / (e0 + e1 + e2 + e3);
            const float p1 = e1 * inv, p2 = e2 * inv, p3 = e3 * inv;
            LB[d] = 0.f; LB[DM + d] = fminf(fmaxf(p1, 0.f), 1.f); LB[2 * DM + d] = fminf(fmaxf(p1 + p2, 0.f), 1.f); LB[3 * DM + d] = fminf(fmaxf(p1 + p2 + p3, 0.f), 1.f);
        }
    }
    {
        bf16* WRT = (bf16*)(ws + WS_WRT); bf16* WAFT = (bf16*)(ws + WS_WAFT);
        for (int idx = blockIdx.x * 512 + tid; idx < NLAYER * (NEXP + 16) * DM; idx += G * 512) {
            const int l = idx / ((NEXP + 16) * DM), r = idx % ((NEXP + 16) * DM), n = r / DM, k = r % DM;
            const float w = n < NEXP ? P.w_router[((size_t)l * DM + k) * NEXP + n] : P.w_in[((size_t)l * DM + k) * PIN + 7168 + (n - NEXP)];
            const unsigned hb = f2bf(w); const float hf = __uint_as_float(hb << 16); const unsigned lb_ = f2bf(w - hf);
            if (n < NEXP) { WRT[(((size_t)l * 2 + 0) * NEXP + n) * DM + k] = (bf16)hb; WRT[(((size_t)l * 2 + 1) * NEXP + n) * DM + k] = (bf16)lb_; }
            else { WAFT[(((size_t)l * 2 + 0) * 16 + (n - NEXP)) * DM + k] = (bf16)hb; WAFT[(((size_t)l * 2 + 1) * 16 + (n - NEXP)) * DM + k] = (bf16)lb_; }
        }
    }
    __syncthreads();
    {
        LAS float* scr = (LAS float*)(lds + wave * SCR_WAVE);
        const int gw = blockIdx.x * 8 + wave, NGW = G * 8;
        constexpr int I_IN1 = 16 * 112, I_IN2 = 16 * 32, I_BR = 2 * 256, I_OUT = 256, I_EXP = 768, I_MOE = NEXP * I_EXP;
        constexpr int I_LAYER = I_IN1 + I_IN2 + I_BR + I_OUT + I_MOE, I_ALL = NLAYER * I_LAYER;
        auto decode = [&](int it) -> TpItem {
            const int l = it / I_LAYER; int r = it % I_LAYER; TpItem t;
            if (r < I_IN1) { const int kb = r / 112, nb = r % 112;
                const int n0 = nb * 64, drow = n0 < 1024 ? 256 * (n0 >> 7) + (n0 & 127) : (n0 < 2048 ? 256 * ((n0 - 1024) >> 7) + 128 + (n0 & 127) : n0);
                t.src = P.w_in + ((size_t)l * DM + kb * 64) * PIN + n0; t.ld = PIN; t.dst = (bf16*)(ws + WS_WIN) + ((size_t)l * NPROJ + drow) * DM + kb * 64; return t; }
            r -= I_IN1;
            if (r < I_IN2) { const int kb = r / 32, nb = r % 32;
                t.src = P.w_in + ((size_t)l * DM + kb * 64) * PIN + 7184 + nb * 64; t.ld = PIN; t.dst = (bf16*)(ws + WS_WIN) + ((size_t)l * NPROJ + 7168 + nb * 64) * DM + kb * 64; return t; }
            r -= I_IN2;
            if (r < I_BR) { const int half = r / 256, q = r % 256, kb = q / 16, nb = q % 16;
                t.src = P.w_branch + ((size_t)l * 2048 + half * 1024 + kb * 64) * DM + nb * 64; t.ld = DM; t.dst = (bf16*)(ws + WS_WBR) + (((size_t)l * 2 + half) * DM + nb * 64) * DM + kb * 64; return t; }
            r -= I_BR;
            if (r < I_OUT) { const int kb = r / 16, nb = r % 16;
                t.src = P.w_out + ((size_t)l * DM + kb * 64) * DM + nb * 64; t.ld = DM; t.dst = (bf16*)(ws + WS_WOUT) + ((size_t)l * DM + nb * 64) * DM + kb * 64; return t; }
            r -= I_OUT;
            const int e = r / I_EXP, q = r % I_EXP, which = q / 256, q2 = q % 256, kb = q2 / 16, nb = q2 % 16;
            const size_t le = (size_t)l * NEXP + e; t.ld = DM;
            if (which == 0) { t.src = P.w_gate + (le * DM + kb * 64) * DM + nb * 64; t.dst = (bf16*)(ws + WS_WGU) + (le * 2048 + 256 * (nb >> 1) + 64 * (nb & 1)) * DM + kb * 64; }
            else if (which == 1) { t.src = P.w_up + (le * DM + kb * 64) * DM + nb * 64; t.dst = (bf16*)(ws + WS_WGU) + (le * 2048 + 256 * (nb >> 1) + 128 + 64 * (nb & 1)) * DM + kb * 64; }
            else { t.src = P.w_down + (le * DM + kb * 64) * DM + nb * 64; t.dst = (bf16*)(ws + WS_WD) + (le * DM + nb * 64) * DM + kb * 64; }
            return t;
        };
        TpRegs cur, nxt; TpItem ci, ni;
        int it = gw;
        if (it < I_ALL) { ci = decode(it); tp_load(cur, ci.src, ci.ld, lane); }
        for (; it < I_ALL; it += NGW) {
            const bool more = it + NGW < I_ALL;
            if (more) { ni = decode(it + NGW); tp_load(nxt, ni.src, ni.ld, lane); }
            tp_store(cur, ci.dst, scr, lane);
            if (more) { cur = nxt; ci = ni; }
        }
    }
    __syncthreads();
}

struct RowV { f32x4 v[4]; };
__device__ __forceinline__ RowV ld_row(const float* p, int lane) { RowV r; const GAS f32x4* q = (const GAS f32x4*)p + lane;
#pragma unroll
    for (int j = 0; j < 4; ++j) r.v[j] = q[64 * j];
    return r; }
struct RowB { u32x2 v[4]; };
__device__ __forceinline__ RowB ld_row_bf16(const bf16* p, int lane) { RowB r; const GAS u32x2* q = (const GAS u32x2*)p + lane;
#pragma unroll
    for (int j = 0; j < 4; ++j) r.v[j] = q[64 * j];
    return r; }
__device__ __forceinline__ RowV row_b2f(const RowB& b) { RowV r;
#pragma unroll
    for (int j = 0; j < 4; ++j) r.v[j] = (f32x4){pg8::bf_lo(b.v[j].x), pg8::bf_hi(b.v[j].x), pg8::bf_lo(b.v[j].y), pg8::bf_hi(b.v[j].y)};
    return r; }
__device__ __forceinline__ void st_row(float* p, int lane, const RowV& r) { GAS f32x4* q = (GAS f32x4*)p + lane;
#pragma unroll
    for (int j = 0; j < 4; ++j) q[64 * j] = r.v[j]; }
__device__ __forceinline__ void st_row_bf16(bf16* p, int lane, const RowV& r) { GAS u32x2* q = (GAS u32x2*)p + lane;
#pragma unroll
    for (int j = 0; j < 4; ++j) { u32x2 w; w.x = pkbf(r.v[j].x, r.v[j].y); w.y = pkbf(r.v[j].z, r.v[j].w); q[64 * j] = w; } }
__device__ __forceinline__ void st_row_lds(LAS float* p, int lane, const RowV& r) { LAS f32x4* q = (LAS f32x4*)p + lane;
#pragma unroll
    for (int j = 0; j < 4; ++j) q[64 * j] = r.v[j]; }
__device__ __forceinline__ void ln_stats(const RowV& r, float& mean, float& rstd, float eps) {
    float s = 0.f;
#pragma unroll
    for (int j = 0; j < 4; ++j) s += (r.v[j].x + r.v[j].y) + (r.v[j].z + r.v[j].w);
    mean = wave_sum(s) * (1.0f / DM); float q = 0.f;
#pragma unroll
    for (int j = 0; j < 4; ++j) { const f32x4 d = r.v[j] - mean; q += (d.x * d.x + d.y * d.y) + (d.z * d.z + d.w * d.w); }
    rstd = 1.0f / sqrtf(wave_sum(q) * (1.0f / DM) + eps);
}
__device__ __forceinline__ float log_sigmoid(float x) { return fminf(x, 0.f) - log1pf(expf(-fabsf(x))); }
template <int NT>
__device__ __forceinline__ void dots_partial(const LAS float* stage0, const bf16* __restrict__ whi, const bf16* __restrict__ wlo, LAS f32x4* part, int wave, int lane) {
    const int rt = wave & 1, kq = wave >> 1, fr = lane & 15, fq = lane >> 4; const LAS float* hp = stage0 + (16 * rt + fr) * SPITCH + 256 * kq + 8 * fq;
    f32x4 acc[NT];
#pragma unroll
    for (int t = 0; t < NT; ++t) acc[t] = (f32x4){0.f, 0.f, 0.f, 0.f};
    const bf16* wh = whi + (size_t)fr * DM + 256 * kq + 8 * fq; const bf16* wl = wlo + (size_t)fr * DM + 256 * kq + 8 * fq;
#pragma unroll
    for (int s = 0; s < 8; ++s) {
        const f32x4 h0 = *(const LAS f32x4*)(hp + 32 * s), h1 = *(const LAS f32x4*)(hp + 32 * s + 4);
        v4u hi; hi.x = pkbf(h0.x, h0.y); hi.y = pkbf(h0.z, h0.w); hi.z = pkbf(h1.x, h1.y); hi.w = pkbf(h1.z, h1.w);
        v4u lo; lo.x = pkbf(h0.x - pg8::bf_lo(hi.x), h0.y - pg8::bf_hi(hi.x)); lo.y = pkbf(h0.z - pg8::bf_lo(hi.y), h0.w - pg8::bf_hi(hi.y));
        lo.z = pkbf(h1.x - pg8::bf_lo(hi.z), h1.y - pg8::bf_hi(hi.z)); lo.w = pkbf(h1.z - pg8::bf_lo(hi.w), h1.w - pg8::bf_hi(hi.w));
        const bf16x8 hhi = __builtin_bit_cast(bf16x8, hi), hlo = __builtin_bit_cast(bf16x8, lo);
#pragma unroll
        for (int t = 0; t < NT; ++t) {
            const bf16x8 a_hi = *(const GAS bf16x8*)(wh + (size_t)t * 16 * DM + 32 * s), a_lo = *(const GAS bf16x8*)(wl + (size_t)t * 16 * DM + 32 * s);
            acc[t] = __builtin_amdgcn_mfma_f32_16x16x32_bf16(a_hi, hhi, acc[t], 0, 0, 0);
            acc[t] = __builtin_amdgcn_mfma_f32_16x16x32_bf16(a_hi, hlo, acc[t], 0, 0, 0);
            acc[t] = __builtin_amdgcn_mfma_f32_16x16x32_bf16(a_lo, hhi, acc[t], 0, 0, 0);
        }
    }
#pragma unroll
    for (int t = 0; t < NT; ++t) part[((kq * 2 + rt) * NT + t) * 64 + lane] = acc[t];
}
template <int NT>
__device__ __forceinline__ void dots_final(const LAS f32x4* part, f32x4 (&out)[NT], int rt, int lane) {
#pragma unroll
    for (int t = 0; t < NT; ++t) { f32x4 a = part[((0 * 2 + rt) * NT + t) * 64 + lane];
#pragma unroll
        for (int kq = 1; kq < 4; ++kq) a += part[((kq * 2 + rt) * NT + t) * 64 + lane];
        out[t] = a; }
}
__device__ __forceinline__ int staged_tok(int j, int it, int RPW) { return (blockIdx.x * 8 + (j >> 2)) * RPW + 4 * it + (j & 3); }
__device__ __forceinline__ void af_block(LAS unsigned char* lds, const bf16* __restrict__ waft, const float* __restrict__ fbias, float* LS, int it, int RPW, int wave, int lane) {
    LAS f32x4* part = (LAS f32x4*)(lds + PART_OFF);
    dots_partial<1>((const LAS float*)lds, waft, waft + 16 * DM, part, wave, lane);
    LDS_BARRIER();
    if (wave < 2) { f32x4 acc[1]; dots_final<1>(part, acc, wave, lane);
        const int fr = lane & 15, fq = lane >> 4; const f32x4 bv = *(const GAS f32x4*)(fbias + 4 * fq);
        *(GAS f32x4*)(LS + (size_t)staged_tok(16 * wave + fr, it, RPW) * 16 + 4 * fq) = (f32x4){log_sigmoid(acc[0].x + bv.x), log_sigmoid(acc[0].y + bv.y), log_sigmoid(acc[0].z + bv.z), log_sigmoid(acc[0].w + bv.w)}; }
}

__device__ __forceinline__ void phase_a0(const Ptrs& P, LAS unsigned char* lds, int G, const int wv) {
    int tid_ = wv * 64 + (int)__builtin_amdgcn_mbcnt_hi(~0u, __builtin_amdgcn_mbcnt_lo(~0u, 0u)); asm volatile("" : "+v"(tid_)); const int tid = tid_, lane = tid & 63, wave = __builtin_amdgcn_readfirstlane(tid >> 6); (void)tid;
    unsigned char* ws = P.ws; const int RPW = NTOK / (G * 8); const int m0 = (blockIdx.x * 8 + wave) * RPW, b = m0 / SEQL;
    const float* MOD = (const float*)(ws + WS_MOD) + (size_t)(0 * NB + b) * 6144;
    const RowV sh1 = ld_row(MOD, lane), sc1 = ld_row(MOD + DM, lane);
    LAS float* stage = (LAS float*)(lds + wave * (4 * SPITCH * 4));
    RowV xnext = ld_row(P.x + (size_t)m0 * DM, lane);
    for (int rg = 0; rg < RPW / 4; ++rg) {
        for (int r = 0; r < 4; ++r) { const int m = m0 + rg * 4 + r; RowV xv = xnext;
            if (rg * 4 + r + 1 < RPW) xnext = ld_row(P.x + (size_t)(m + 1) * DM, lane);
#pragma unroll
            for (int j = 0; j < 4; ++j) xv.v[j] = xv.v[j] * (sc1.v[j] + 1.0f) + sh1.v[j];
            st_row_bf16((bf16*)(ws + WS_HB) + (size_t)m * DM, lane, xv); st_row_lds(stage + r * SPITCH, lane, xv); }
        LDS_BARRIER();
        af_block(lds, (const bf16*)(ws + WS_WAFT), P.fox_f_bias, (float*)(ws + WS_LS), rg, RPW, wave, lane);
        LDS_BARRIER();
    }
}

__device__ __forceinline__ void phase_f(const Ptrs& P, LAS unsigned char* lds, int l, const float* xcur, int G, const int wv, bool build_lists = true) {
    int tid_ = wv * 64 + (int)__builtin_amdgcn_mbcnt_hi(~0u, __builtin_amdgcn_mbcnt_lo(~0u, 0u)); asm volatile("" : "+v"(tid_)); const int tid = tid_, lane = tid & 63, wave = __builtin_amdgcn_readfirstlane(tid >> 6);
    unsigned char* ws = P.ws; const int RPW = NTOK / (G * 8); const int m0 = (blockIdx.x * 8 + wave) * RPW, b = m0 / SEQL;
    LAS int* lcnt = (LAS int*)(lds + T_LCNT); LAS int* gbase = (LAS int*)(lds + T_GBASE);
    LAS int* aE = (LAS int*)(lds + T_ASG); LAS float* aW = (LAS float*)(lds + T_ASG + 2048);
    if (tid < 32) lcnt[tid] = 0;
    __syncthreads();
    {
        const float* MOD = (const float*)(ws + WS_MOD) + (size_t)(l * NB + b) * 6144;
        const RowV g1 = ld_row(MOD + 2 * DM, lane), sh2 = ld_row(MOD + 3 * DM, lane), sc2 = ld_row(MOD + 4 * DM, lane);
        const RowV lng = ld_row(P.ln1_g + (size_t)l * DM, lane), lnb = ld_row(P.ln1_b + (size_t)l * DM, lane);
        LAS float* stage = (LAS float*)(lds + wave * (4 * SPITCH * 4));
        const bf16* wrt = (const bf16*)(ws + WS_WRT) + (size_t)l * 2 * NEXP * DM; const float* br = P.b_router + (size_t)l * NEXP;
        const bf16* Y = (const bf16*)(ws + WS_Y);
        RowV xnext = ld_row(xcur + (size_t)m0 * DM, lane); RowB ynext = ld_row_bf16(Y + (size_t)m0 * DM, lane);
        for (int rg = 0; rg < RPW / 4; ++rg) {
            for (int r = 0; r < 4; ++r) { const int m = m0 + rg * 4 + r;
                RowV xv = xnext; const RowV yv = row_b2f(ynext);
                if (rg * 4 + r + 1 < RPW) { xnext = ld_row(xcur + (size_t)(m + 1) * DM, lane); ynext = ld_row_bf16(Y + (size_t)(m + 1) * DM, lane); }
#pragma unroll
                for (int j = 0; j < 4; ++j) xv.v[j] = xv.v[j] * DN_ALPHA + (g1.v[j] + 1.0f) * yv.v[j];
                float mean, rstd; ln_stats(xv, mean, rstd, 1e-5f);
#pragma unroll
                for (int j = 0; j < 4; ++j) xv.v[j] = (xv.v[j] - mean) * rstd * lng.v[j] + lnb.v[j];
                st_row_bf16((bf16*)(ws + WS_X1) + (size_t)m * DM, lane, xv);
#pragma unroll
                for (int j = 0; j < 4; ++j) xv.v[j] = xv.v[j] * (sc2.v[j] + 1.0f) + sh2.v[j];
                st_row_bf16((bf16*)(ws + WS_HB) + (size_t)m * DM, lane, xv); st_row_lds(stage + r * SPITCH, lane, xv); }
            LDS_BARRIER();
            LAS f32x4* part = (LAS f32x4*)(lds + PART_OFF);
            dots_partial<2>((const LAS float*)lds, wrt, wrt + (size_t)NEXP * DM, part, wave, lane);
            LDS_BARRIER();
            if (wave < 2) {
                f32x4 lg[2]; dots_final<2>(part, lg, wave, lane);
                const int fr = lane & 15, fq = lane >> 4;
                float cv[8]; int ci[8];
                { const f32x4 b0 = *(const GAS f32x4*)(br + 4 * fq), b1 = *(const GAS f32x4*)(br + 16 + 4 * fq);
#pragma unroll
                  for (int i = 0; i < 4; ++i) { cv[i] = lg[0][i] + b0[i]; ci[i] = 4 * fq + i; cv[4 + i] = lg[1][i] + b1[i]; ci[4 + i] = 16 + 4 * fq + i; } }
                float tv[4]; int ti[4];
#pragma unroll
                for (int k = 0; k < 4; ++k) {
                    float bv = cv[0]; int bi = ci[0];
#pragma unroll
                    for (int i = 1; i < 8; ++i) if (cv[i] > bv) { bv = cv[i]; bi = ci[i]; }
                    pair16(bv, bi); pair32(bv, bi);
                    tv[k] = bv; ti[k] = bi;
#pragma unroll
                    for (int i = 0; i < 8; ++i) if (ci[i] == bi) cv[i] = -INFINITY;
                }
                const float e1 = expf(tv[1] - tv[0]), e2 = expf(tv[2] - tv[0]), e3 = expf(tv[3] - tv[0]), inv = 1.0f / (1.0f + e1 + e2 + e3);
                const int slot = rg * 128 + (16 * wave + fr) * 4;
                if (fq == 0) { aE[slot] = ti[0]; aW[slot] = inv; } else if (fq == 1) { aE[slot + 1] = ti[1]; aW[slot + 1] = e1 * inv; }
                else if (fq == 2) { aE[slot + 2] = ti[2]; aW[slot + 2] = e2 * inv; } else { aE[slot + 3] = ti[3]; aW[slot + 3] = e3 * inv; }
            }
            LDS_BARRIER();
        }
    }
    if (!build_lists) { __syncthreads(); return; }
    const int nasg = RPW * 32; int e = 0, lpos = 0; float w = 0.f;
    if (tid < nasg) { e = aE[tid]; w = aW[tid]; lpos = __hip_atomic_fetch_add(lcnt + e, 1, __ATOMIC_RELAXED, __HIP_MEMORY_SCOPE_WORKGROUP); }
    __syncthreads();
    if (tid < 32) { const int n = lcnt[tid]; gbase[tid] = n ? (int)__hip_atomic_fetch_add((unsigned*)(ws + WS_CTL) + CW_CNT + (l * NEXP + tid) * 64, (unsigned)n, __ATOMIC_RELAXED, __HIP_MEMORY_SCOPE_AGENT) : 0; }
    __syncthreads();
    if (tid < nasg) { const int pos = gbase[e] + lpos, tok = staged_tok((tid >> 2) & 31, tid >> 7, RPW);
        ((int*)(ws + WS_LIST))[(size_t)e * NTOK + pos] = tok; ((int*)(ws + WS_ASGE))[(size_t)tok * 4 + (tid & 3)] = (e << 16) | pos; ((float*)(ws + WS_ASGW))[(size_t)tok * 4 + (tid & 3)] = w; }
}

__device__ __forceinline__ int moe_tables(const Ptrs& P, LAS unsigned char* lds, int l, const int wv) {
    int tid_ = wv * 64 + (int)__builtin_amdgcn_mbcnt_hi(~0u, __builtin_amdgcn_mbcnt_lo(~0u, 0u)); asm volatile("" : "+v"(tid_)); const int tid = tid_;
    LAS int* tbase = (LAS int*)(lds + T_TBASE); LAS int* cnt = (LAS int*)(lds + T_CNT); LAS unsigned char* rt2e = (LAS unsigned char*)(lds + T_RT2E);
    __syncthreads();
    if (tid < 32) cnt[tid] = (int)__hip_atomic_load((unsigned*)(P.ws + WS_CTL) + CW_CNT + (l * NEXP + tid) * 64, __ATOMIC_RELAXED, __HIP_MEMORY_SCOPE_AGENT);
    __syncthreads();
    if (tid == 0) { int s = 0; for (int e = 0; e < NEXP; ++e) { tbase[e] = s; s += (cnt[e] + 255) >> 8; } tbase[NEXP] = s; }
    __syncthreads();
    if (tid < 32) { for (int rt = tbase[tid]; rt < tbase[tid + 1]; ++rt) rt2e[rt] = (unsigned char)tid; }
    __syncthreads();
    return tbase[NEXP];
}

__device__ __forceinline__ void phase_j(const Ptrs& P, LAS unsigned char* lds, int l, int G, const int wv) {
    int tid_ = wv * 64 + (int)__builtin_amdgcn_mbcnt_hi(~0u, __builtin_amdgcn_mbcnt_lo(~0u, 0u)); asm volatile("" : "+v"(tid_)); const int tid = tid_, lane = tid & 63, wave = __builtin_amdgcn_readfirstlane(tid >> 6); (void)tid;
    unsigned char* ws = P.ws; const int RPW = NTOK / (G * 8); const int m0 = (blockIdx.x * 8 + wave) * RPW, b = m0 / SEQL;
    const LAS int* tbase = (const LAS int*)(lds + T_TBASE);
    const float* MOD = (const float*)(ws + WS_MOD) + (size_t)(l * NB + b) * 6144;
    const RowV g2 = ld_row(MOD + 5 * DM, lane);
    const RowV lng = ld_row(P.ln2_g + (size_t)l * DM, lane), lnb = ld_row(P.ln2_b + (size_t)l * DM, lane);
    const bool more = l + 1 < NLAYER;
    RowV sh1, sc1;
    { const float* MODN = (const float*)(ws + WS_MOD) + (size_t)((more ? l + 1 : l) * NB + b) * 6144; sh1 = ld_row(MODN, lane); sc1 = ld_row(MODN + DM, lane); }
    LAS float* stage = (LAS float*)(lds + wave * (4 * SPITCH * 4));
    const bf16* YR = (const bf16*)(ws + WS_YR); const bf16* X1 = (const bf16*)(ws + WS_X1);
    const unsigned asge = ((const unsigned*)(ws + WS_ASGE))[(size_t)m0 * 4 + lane]; const float asgw = ((const float*)(ws + WS_ASGW))[(size_t)m0 * 4 + lane];
    struct JRow { u32x2 y[4][4]; RowB x; };
    auto jload = [&](int i, JRow& R) {
#pragma unroll
        for (int k = 0; k < 4; ++k) { const unsigned a = __builtin_amdgcn_readlane(asge, 4 * i + k); const int e = (int)(a >> 16), pos = (int)(a & 0xffffu); const size_t slot = (size_t)tbase[e] * 256 + pos;
            const GAS u32x2* q = (const GAS u32x2*)(YR + slot * DM) + lane;
#pragma unroll
            for (int j = 0; j < 4; ++j) R.y[k][j] = q[64 * j]; }
        R.x = ld_row_bf16(X1 + (size_t)(m0 + i) * DM, lane);
    };
    JRow rnext; jload(0, rnext);
    for (int rg = 0; rg < RPW / 4; ++rg) {
        for (int r = 0; r < 4; ++r) { const int i = rg * 4 + r, m = m0 + i;
            const JRow rc = rnext;
            if (i + 1 < RPW) jload(i + 1, rnext);
            RowV y;
#pragma unroll
            for (int j = 0; j < 4; ++j) y.v[j] = (f32x4){0.f, 0.f, 0.f, 0.f};
#pragma unroll
            for (int k = 0; k < 4; ++k) { const float wk = __uint_as_float(__builtin_amdgcn_readlane(__float_as_uint(asgw), 4 * i + k));
#pragma unroll
                for (int j = 0; j < 4; ++j) { const u32x2 t = rc.y[k][j]; y.v[j].x += wk * pg8::bf_lo(t.x); y.v[j].y += wk * pg8::bf_hi(t.x); y.v[j].z += wk * pg8::bf_lo(t.y); y.v[j].w += wk * pg8::bf_hi(t.y); } }
            RowV xv = row_b2f(rc.x);
#pragma unroll
            for (int j = 0; j < 4; ++j) xv.v[j] = xv.v[j] * DN_ALPHA + (g2.v[j] + 1.0f) * y.v[j];
            float mean, rstd; ln_stats(xv, mean, rstd, 1e-5f);
#pragma unroll
            for (int j = 0; j < 4; ++j) xv.v[j] = (xv.v[j] - mean) * rstd * lng.v[j] + lnb.v[j];
            st_row(P.out + (size_t)m * DM, lane, xv);
            if (more) {
#pragma unroll
                for (int j = 0; j < 4; ++j) xv.v[j] = xv.v[j] * (sc1.v[j] + 1.0f) + sh1.v[j];
                st_row_bf16((bf16*)(ws + WS_HB) + (size_t)m * DM, lane, xv); st_row_lds(stage + r * SPITCH, lane, xv); }
        }
        if (more) {
            LDS_BARRIER();
            af_block(lds, (const bf16*)(ws + WS_WAFT) + (size_t)(l + 1) * 2 * 16 * DM, P.fox_f_bias + (l + 1) * 16, (float*)(ws + WS_LS), rg, RPW, wave, lane);
            LDS_BARRIER();
        }
    }
}

__device__ __forceinline__ void fscan(const Ptrs& P, LAS unsigned char* lds, const int wv) {
    int tid_ = wv * 64 + (int)__builtin_amdgcn_mbcnt_hi(~0u, __builtin_amdgcn_mbcnt_lo(~0u, 0u)); asm volatile("" : "+v"(tid_)); const int tid = tid_, lane = tid & 63, wave = __builtin_amdgcn_readfirstlane(tid >> 6);
    const int bh = blockIdx.x >> 1, hf = blockIdx.x & 1, b = bh >> 4, h = bh & 15;
    const float* LS = (const float*)(P.ws + WS_LS) + ((size_t)b * SEQL + 2048 * hf + 4 * tid) * 16 + h; float* FP = (float*)(P.ws + WS_FP) + (size_t)bh * SEQL + 2048 * hf + 4 * tid;
    LAS float* wt = (LAS float*)(lds);
    float v[4], pre = 0.f;
#pragma unroll
    for (int j = 0; j < 4; ++j) v[j] = LS[j * 16];
    if (hf) { const float* L0 = (const float*)(P.ws + WS_LS) + ((size_t)b * SEQL + 4 * tid) * 16 + h; pre = (L0[0] + L0[16]) + (L0[32] + L0[48]); }
#pragma unroll
    for (int j = 1; j < 4; ++j) v[j] += v[j - 1];
    pre = wave_sum(pre);
    float inc = v[3];
    { const float rs = pg8::row16_scan(inc), rt = pg8::row16_sum(inc);
      const float r0 = __uint_as_float(__builtin_amdgcn_readlane(__float_as_uint(rt), 15)), r1 = __uint_as_float(__builtin_amdgcn_readlane(__float_as_uint(rt), 31)), r2 = __uint_as_float(__builtin_amdgcn_readlane(__float_as_uint(rt), 47));
      inc = rs + (lane >= 16 ? r0 : 0.f) + (lane >= 32 ? r1 : 0.f) + (lane >= 48 ? r2 : 0.f); }
    if (lane == 63) { wt[wave] = inc; wt[8 + wave] = pre; }
    __syncthreads();
    float off = inc - v[3];
    for (int w = 0; w < wave; ++w) off += wt[w];
    for (int w = 0; w < 8; ++w) off += wt[8 + w];
    *(GAS f32x4*)(FP) = (f32x4){(off + v[0]) * LOG2E, (off + v[1]) * LOG2E, (off + v[2]) * LOG2E, (off + v[3]) * LOG2E};
    __syncthreads();
}

namespace hg {
constexpr int L_QP = 0, L_KP = 16384, L_IV = 32768, L_SP = 49152, L_PM = 81920, L_O = 91136, L_TOT = 123904, L_EBM = 128000, L_EBL = 128512;
constexpr int PM_PITCH = 144;
static_assert(L_EBL + 512 <= RING_BYTES, "HGRN LDS map");
__device__ __forceinline__ int off_b(int row, int ch) { return 256 * row + 16 * (ch ^ (((row & 3) << 2) | ((row >> 2) & 3))); }
__device__ __forceinline__ bf16x8 row_frag(const LAS unsigned char* img, int row0, int s, int lane) { return *(const LAS bf16x8*)(img + off_b(row0 + (lane & 31), 2 * s + (lane >> 5))); }
__device__ __forceinline__ bf16x8 tr_frag(const LAS unsigned char* img, int c, int ks, int lane) {
    const int hh = lane >> 5, blk = (lane >> 4) & 1, q = (lane & 15) >> 2, p = lane & 3;
    const LAS unsigned char* a0 = img + off_b(16 * ks + 8 * hh + q, 4 * c + 2 * blk + (p >> 1)) + 8 * (p & 1);
    const LAS unsigned char* a1 = img + off_b(16 * ks + 8 * hh + 4 + q, 4 * c + 2 * blk + (p >> 1)) + 8 * (p & 1);
    const v4i16_t lo = __builtin_amdgcn_ds_read_tr16_b64_v4i16((LAS v4i16_t*)a0), hi = __builtin_amdgcn_ds_read_tr16_b64_v4i16((LAS v4i16_t*)a1);
    return (bf16x8){lo[0], lo[1], lo[2], lo[3], hi[0], hi[1], hi[2], hi[3]};
}
#define HG_MFMA(a, b, c) __builtin_amdgcn_mfma_f32_32x32x16_bf16((a), (b), (c), 0, 0, 0)

__device__ __forceinline__ void hgrn_unit(int b, int h, int seg, bool do_out, int st_slot, const bf16* __restrict__ QS, const float* __restrict__ EB, const bf16* __restrict__ KK, const bf16* __restrict__ IV, const bf16* __restrict__ SG,
                                          const float* __restrict__ nw, bf16* __restrict__ OA, float* __restrict__ HST, float* __restrict__ HTD, LAS unsigned char* lds, const int wv) {
    int tid_ = wv * 64 + (int)__builtin_amdgcn_mbcnt_hi(~0u, __builtin_amdgcn_mbcnt_lo(~0u, 0u)); asm volatile("" : "+v"(tid_));
    const int tid = tid_, lane = tid & 63, wid = __builtin_amdgcn_readfirstlane(tid >> 6);
    const int r = lane & 31, hh = lane >> 5;
    const size_t colb = (size_t)h * 128;
    const size_t hbase = (size_t)h * NTOK * 128;
    const int ct = tid >> 3, cpart = tid & 7;
    float nwv[16];
#pragma unroll
    for (int i = 0; i < 16; ++i) nwv[i] = nw[16 * cpart + i];
    f32x16 Sacc[2];
#pragma unroll
    for (int i = 0; i < 16; ++i) { Sacc[0][i] = 0.f; Sacc[1][i] = 0.f; }
    const int bh8 = b * 8 + h;
    if (do_out && seg > 0) {
        const size_t so = ((size_t)bh8 * 8 + wid) * 2 * 16 * 64 + lane; const size_t slot = (size_t)64 * 8 * 2 * 16 * 64;
        float d1[16], d2[16];
#pragma unroll
        for (int i = 0; i < 16; ++i) { const int d = 32 * (wid >> 1) + (i & 3) + 8 * (i >> 2) + 4 * hh; d1[i] = seg >= 2 ? __expf(HTD[(size_t)bh8 * 128 + d]) : 1.f; d2[i] = seg >= 3 ? __expf(HTD[(size_t)(64 + bh8) * 128 + d]) : 1.f; }
#pragma unroll
        for (int tl = 0; tl < 2; ++tl)
#pragma unroll
            for (int i = 0; i < 16; ++i) { float v = HST[so + (size_t)(tl * 16 + i) * 64];
                if (seg >= 2) v = v * d1[i] + HST[slot + so + (size_t)(tl * 16 + i) * 64];
                if (seg >= 3) v = v * d2[i] + HST[2 * slot + so + (size_t)(tl * 16 + i) * 64];
                Sacc[tl][i] = v; }
    }
    float td0 = 0.f, td1 = 0.f;
    const int cbeg = 16 * seg, cend = 16 * seg + 16;
    v4u qv[2], kv[2], ivr[2], sgr[2]; f32x2 eb0 = {0.f, 0.f}, eb1 = {0.f, 0.f}, eb2 = {0.f, 0.f};
#define HG_LOAD(c) do { const size_t rb_ = (size_t)b * SEQL + (size_t)(c) * 64; \
        _Pragma("unroll") for (int i = 0; i < 2; ++i) { const int idx_ = tid + 512 * i; const size_t o_ = hbase + rb_ * 128 + 8 * (size_t)idx_; \
            if (do_out) qv[i] = *(const GAS v4u*)(QS + o_); kv[i] = *(const GAS v4u*)(KK + o_); ivr[i] = *(const GAS v4u*)(IV + o_); } \
        if (do_out) { _Pragma("unroll") for (int i = 0; i < 2; ++i) sgr[i] = *(const GAS v4u*)(SG + hbase + (rb_ + ct) * 128 + 16 * cpart + 8 * i); } \
        if (wid == 0) { const size_t eo_ = (rb_ >> 6) * DM + colb + 2 * lane; const size_t es_ = (size_t)(NTOK / 64) * DM; \
            eb0 = *(const GAS f32x2*)(EB + eo_); eb1 = *(const GAS f32x2*)(EB + es_ + eo_); eb2 = *(const GAS f32x2*)(EB + 2 * es_ + eo_); } } while (0)
    HG_LOAD(cbeg);
    for (int c = cbeg; c < cend; ++c) {
#pragma unroll
        for (int i = 0; i < 2; ++i) { const int idx_ = tid + 512 * i, o_ = off_b(idx_ >> 4, idx_ & 15);
            *(LAS v4u*)(lds + L_KP + o_) = kv[i]; *(LAS v4u*)(lds + L_IV + o_) = ivr[i];
            if (do_out) *(LAS v4u*)(lds + L_QP + o_) = qv[i]; }
        if (wid == 0) { *(LAS f32x2*)(lds + L_EBM + 8 * lane) = eb0; *(LAS f32x2*)(lds + L_EBL + 8 * lane) = eb1; td0 += eb2.x; td1 += eb2.y; }
        const v4u sg0 = sgr[0], sg1 = sgr[1];
#ifdef HG_REP_LOAD
        if (c + 1 < cend) { HG_LOAD(c + 1); asm volatile("" ::: "memory"); }
#endif
        if (c + 1 < cend) HG_LOAD(c + 1);
        LDS_BARRIER();
        {
            const int db = wid >> 1, vb0 = 2 * (wid & 1);
            float em[16], el[16];
#pragma unroll
            for (int g = 0; g < 4; ++g) { const f32x4 a = *(const LAS f32x4*)(lds + L_EBM + (32 * db + 8 * g + 4 * hh) * 4), e2 = *(const LAS f32x4*)(lds + L_EBL + (32 * db + 8 * g + 4 * hh) * 4);
                em[4 * g] = a.x; em[4 * g + 1] = a.y; em[4 * g + 2] = a.z; em[4 * g + 3] = a.w; el[4 * g] = e2.x; el[4 * g + 1] = e2.y; el[4 * g + 2] = e2.z; el[4 * g + 3] = e2.w; }
#pragma unroll
            for (int tl = 0; tl < 2; ++tl) { const int vb = vb0 + tl;
#pragma unroll
                for (int i = 0; i < 16; ++i) Sacc[tl][i] *= em[i];
                if (do_out) {
#pragma unroll
                for (int g = 0; g < 4; ++g) { u32x2 w; w.x = pkbf(Sacc[tl][4 * g], Sacc[tl][4 * g + 1]); w.y = pkbf(Sacc[tl][4 * g + 2], Sacc[tl][4 * g + 3]);
                    *(LAS u32x2*)(lds + L_SP + off_b(32 * vb + r, 4 * db + g) + 8 * hh) = w; } } }
            if (do_out && wid < 3) {
                const int tb = wid > 0 ? 1 : 0, sb = wid > 1 ? 1 : 0;
                f32x16 sc;
#pragma unroll
                for (int i = 0; i < 16; ++i) sc[i] = 0.f;
#pragma unroll
                for (int s = 0; s < 8; ++s) { const bf16x8 a = row_frag(lds + L_KP, 32 * sb, s, lane), bq = row_frag(lds + L_QP, 32 * tb, s, lane); sc = HG_MFMA(a, bq, sc); }
                const int t = 32 * tb + r;
#pragma unroll
                for (int g = 0; g < 4; ++g) { float x[4];
#pragma unroll
                    for (int j = 0; j < 4; ++j) { const int s_ = 32 * sb + 8 * g + 4 * hh + j; x[j] = s_ <= t ? sc[4 * g + j] : 0.f; }
                    u32x2 w; w.x = pkbf(x[0], x[1]); w.y = pkbf(x[2], x[3]);
                    *(LAS u32x2*)(lds + L_PM + t * PM_PITCH + (32 * sb + 8 * g + 4 * hh) * 2) = w; }
            }
#pragma unroll
            for (int ks = 0; ks < 4; ++ks) { const bf16x8 a = tr_frag(lds + L_KP, db, ks, lane);
#pragma unroll
                for (int tl = 0; tl < 2; ++tl) { const bf16x8 bi = tr_frag(lds + L_IV, vb0 + tl, ks, lane); Sacc[tl] = HG_MFMA(a, bi, Sacc[tl]); } }
#pragma unroll
            for (int tl = 0; tl < 2; ++tl)
#pragma unroll
                for (int i = 0; i < 16; ++i) Sacc[tl][i] *= el[i];
        }
        if (!do_out) continue;
        LDS_BARRIER();
#ifndef HG_REP_B
#define HG_REP_B 1
#endif
#ifndef HG_REP_C
#define HG_REP_C 1
#endif
        for (int rb_ = 0; rb_ < HG_REP_B; ++rb_) {
            const int tb = wid >> 2, vb = wid & 3;
            f32x16 o;
#pragma unroll
            for (int i = 0; i < 16; ++i) o[i] = 0.f;
#pragma unroll
            for (int ks = 0; ks < 4; ++ks) { if (ks < 2 || tb == 1) {
                const bf16x8 a = *(const LAS bf16x8*)(lds + L_PM + (32 * tb + r) * PM_PITCH + (16 * ks + 8 * hh) * 2); const bf16x8 bi = tr_frag(lds + L_IV, vb, ks, lane); o = HG_MFMA(a, bi, o); } }
#pragma unroll
            for (int s = 0; s < 8; ++s) { const bf16x8 a = row_frag(lds + L_QP, 32 * tb, s, lane), bs = row_frag(lds + L_SP, 32 * vb, s, lane); o = HG_MFMA(a, bs, o); }
#pragma unroll
            for (int i = 0; i < 16; ++i) { const int t = 32 * tb + (i & 3) + 8 * (i >> 2) + 4 * hh; *(LAS float*)(lds + L_O + (t * 128 + 32 * vb + r) * 4) = o[i]; }
        }
        LDS_BARRIER();
        for (int rc_ = 0; rc_ < HG_REP_C; ++rc_) {
            float ov[16];
#pragma unroll
            for (int g = 0; g < 4; ++g) { const f32x4 a = *(const LAS f32x4*)(lds + L_O + (ct * 128 + 16 * cpart + 4 * g) * 4); ov[4 * g] = a.x; ov[4 * g + 1] = a.y; ov[4 * g + 2] = a.z; ov[4 * g + 3] = a.w; }
            float ss = 0.f;
#pragma unroll
            for (int i = 0; i < 16; ++i) ss += ov[i] * ov[i];
            ss += pg8::dpp_row<0xB1>(ss); ss += pg8::dpp_row<0x4E>(ss); ss += pg8::dpp_row<0x141>(ss);
            const float rstd = 1.0f / sqrtf(ss * (1.0f / 128.0f) + 1e-6f);
            const unsigned gs[8] = {sg0.x, sg0.y, sg0.z, sg0.w, sg1.x, sg1.y, sg1.z, sg1.w};
            unsigned ow[8];
#pragma unroll
            for (int i = 0; i < 8; ++i) ow[i] = pkbf(ov[2 * i] * rstd * nwv[2 * i] * pg8::bf_lo(gs[i]), ov[2 * i + 1] * rstd * nwv[2 * i + 1] * pg8::bf_hi(gs[i]));
            bf16* op = OA + ((size_t)b * SEQL + (size_t)c * 64 + ct) * DM + colb + 16 * cpart;
            *(GAS v4u*)(op) = (v4u){ow[0], ow[1], ow[2], ow[3]}; *(GAS v4u*)(op + 8) = (v4u){ow[4], ow[5], ow[6], ow[7]};
        }
    }
#undef HG_LOAD
    if (st_slot >= 0) {
        const size_t so = (size_t)st_slot * ((size_t)64 * 8 * 2 * 16 * 64) + ((size_t)bh8 * 8 + wid) * 2 * 16 * 64 + lane;
#pragma unroll
        for (int tl = 0; tl < 2; ++tl)
#pragma unroll
            for (int i = 0; i < 16; ++i) HST[so + (size_t)(tl * 16 + i) * 64] = Sacc[tl][i];
        if (st_slot >= 1 && wid == 0) *(GAS f32x2*)(HTD + ((size_t)(st_slot - 1) * 64 + bh8) * 128 + 2 * lane) = (f32x2){td0, td1};
    }
    LDS_BARRIER();
}
}

#ifndef PH_SKIP
#define PH_SKIP 0u
#endif
struct Args { Ptrs p; };
typedef __attribute__((address_space(4))) const unsigned long long* KArgWords;
__device__ __forceinline__ Ptrs opq_ptrs(KArgWords p) {
    Ptrs r;
#if defined(__HIP_DEVICE_COMPILE__)
    asm volatile("" : "+s"(p));
    unsigned long long* d = (unsigned long long*)&r;
#pragma unroll
    for (int i = 0; i < (int)(sizeof(Ptrs) / 8); ++i) d[i] = p[i];
#else
    (void)p; r = Ptrs{};
#endif
    return r;
}
__global__ void __launch_bounds__(512, 2) mk_fwd(Args args) {
    extern __shared__ __attribute__((aligned(16))) unsigned char lds_raw[];
    LAS unsigned char* lds = (LAS unsigned char*)lds_raw;
    const KArgWords Pk_ = (KArgWords)__builtin_amdgcn_kernarg_segment_ptr();
    (void)args;
#define P (opq_ptrs(Pk_))
    unsigned char* ws = P.ws;
    const int wv = __builtin_amdgcn_readfirstlane((int)threadIdx.x >> 6), G = gridDim.x;
#define tid (wv * 64 + (int)__builtin_amdgcn_mbcnt_hi(~0u, __builtin_amdgcn_mbcnt_lo(~0u, 0u)))
    volatile LAS unsigned* MISC = (volatile LAS unsigned*)(lds + T_MISC);
    gu32* ctl = (gu32*)(ws + WS_CTL);
    for (int u = tid; u < (LDS_BYTES - TAB_OFF) / 4; u += 512) ((LAS unsigned*)(lds + TAB_OFF))[u] = 0u;
    __syncthreads();
    (void)xcd_barrier_post((unsigned*)(ws + WS_CTL) + CW_BAR, MISC + 8);
#define GRID_BAR() do { XcdBarrier bar_; bar_.bar = (unsigned*)(ws + WS_CTL) + CW_BAR; bar_.x = xb_xcc_id(); bar_.st = (volatile LAS unsigned*)(lds + T_MISC) + 8; for (int rb_ = 0; rb_ < NREP(11); ++rb_) xcd_barrier(bar_); } while (0)
#define RUN(k) (((PH_SKIP >> (k)) & 1u) == 0u)
#ifndef PH_REP
#define PH_REP 0u
#endif
#define NREP(k) (1 + (int)((PH_REP >> (k)) & 1u))

    if (RUN(0)) for (int rp = 0; rp < NREP(0); ++rp) p0_prologue(P, lds, G, wv);
    GRID_BAR();
    if (RUN(1)) for (int rp = 0; rp < NREP(1); ++rp) phase_a0(P, lds, G, wv);
    GRID_BAR();

    for (int l = 0; l < NLAYER; ++l) {
        bf16* PROJ = (bf16*)(ws + WS_PROJ);
        if (RUN(2)) for (int rp = 0; rp < NREP(2); ++rp) {
            if (G == 256) fscan(P, lds, wv);
            pg8::Gemm g{(const pg8::bf16_t*)(ws + WS_HB), (const pg8::bf16_t*)(ws + WS_WIN) + (size_t)l * NPROJ * DM, NTOK, NPROJ, DM};
            pg8::StaticOrder S; S.init(NTOK, NPROJ, G, (int)blockIdx.x);
            pg8::EpiInProj E{(pg8::bf16_t*)PROJ, (float*)(ws + WS_EB), (const float*)(ws + WS_LB) + (size_t)l * DM, 0.125f * LOG2E, (unsigned*)(ws + WS_CTL) + CW_NRM + l * 2 * 128 * 128};
            pg8::gemm_phase<pg8::EpiInProj, pg8::StaticOrder, true, true, false>(lds + RING_OFF, g, S, E, wv);
        }
        GRID_BAR();
        if (RUN(3)) for (int rp = 0; rp < NREP(3); ++rp) {
            constexpr int ATT_Q1 = 1152;
            const bf16* aQ = PROJ + 4 * (size_t)NTOK * DM; const bf16* aK = PROJ + 5 * (size_t)NTOK * DM; const bf16* aV = PROJ + 6 * (size_t)NTOK * DM;
#define HG_CALL(bh_, seg_, out_, slot_) hg::hgrn_unit((bh_) >> 3, (bh_) & 7, (seg_), (out_), (slot_), PROJ + 0 * (size_t)NTOK * DM, (const float*)(ws + WS_EB), PROJ + 1 * (size_t)NTOK * DM, PROJ + 2 * (size_t)NTOK * DM, \
                PROJ + 3 * (size_t)NTOK * DM, P.hg_norm_w + (size_t)l * 128, (bf16*)(ws + WS_OAB), (float*)(ws + WS_HST), (float*)(ws + WS_HTD), lds + RING_OFF, wv)
#define AT_CALL(j_) do { const int qb_ = 15 - ((j_) & 15), bh_ = (j_) >> 4;     \
                attn_body::attn_unit<8>(bh_ >> 4, bh_ & 15, qb_, (const attn_body::bf16*)aQ, (const attn_body::bf16*)aK, (const attn_body::bf16*)aV, (attn_body::bf16*)(ws + WS_OAB + SZB), (const float*)(ws + WS_FP), \
                    (const unsigned*)(ws + WS_CTL) + CW_NRM + ((l * 2 + 0) * 128 + bh_) * 128, (const unsigned*)(ws + WS_CTL) + CW_NRM + ((l * 2 + 1) * 128 + bh_) * 128, (unsigned*)wqp_, MISC + 1 + (par_ ^= 1), (char*)lds_raw + RING_OFF, wv); } while (0)
#define WQ_WORD(word_) (ctl + CW_WQ + 64 * ((word_) * 4 + l) + 1024 * rp + 2048 * rx)
#define WQ_NEXT(word_) do { __syncthreads(); if (tid == 0) MISC[0] = __hip_atomic_fetch_add(WQ_WORD(word_), 1u, RLX_AGENT); __syncthreads(); } while (0)
            for (int rx = 0; rx < NREP(10); ++rx) for (;;) { WQ_NEXT(0); const int it = __builtin_amdgcn_readfirstlane((int)MISC[0]); if (it >= 192) break;
                if (it < 64) HG_CALL(it, 0, true, 0); else HG_CALL((it - 64) >> 1, 1 + ((it - 64) & 1), false, 1 + ((it - 64) & 1)); }
            for (int rx = 0; rx < NREP(12); ++rx) { int par_ = 0; gu32* wqp_ = WQ_WORD(1); WQ_NEXT(1); int j = __builtin_amdgcn_readfirstlane((int)MISC[0]);
              while (j < ATT_Q1) { AT_CALL(j); j = __builtin_amdgcn_readfirstlane((int)MISC[1 + par_]); } }
            GRID_BAR();
            for (int rx = 0; rx < NREP(10); ++rx) for (;;) { WQ_NEXT(2); const int it = __builtin_amdgcn_readfirstlane((int)MISC[0]); if (it >= 192) break; HG_CALL(it & 63, 1 + (it >> 6), true, -1); }
            for (int rx = 0; rx < NREP(12); ++rx) { int par_ = 0; gu32* wqp_ = WQ_WORD(3); WQ_NEXT(3); int j = __builtin_amdgcn_readfirstlane((int)MISC[0]) + ATT_Q1;
              while (j < 2048) { AT_CALL(j); j = __builtin_amdgcn_readfirstlane((int)MISC[1 + par_]) + ATT_Q1; } }
#undef HG_CALL
#undef AT_CALL
#undef WQ_NEXT
#undef WQ_WORD
        }
        GRID_BAR();
        if (RUN(4)) for (int rp = 0; rp < NREP(4); ++rp) {
            pg8::Gemm g{(const pg8::bf16_t*)(ws + WS_OAB), (const pg8::bf16_t*)(ws + WS_WBR) + (size_t)l * 2 * DM * DM, 2 * NTOK, 2 * DM, DM};
            pg8::PairOrder S; S.init(G, (int)blockIdx.x);
            pg8::EpiBranch E{(const pg8::bf16_t*)(PROJ + 7 * (size_t)NTOK * DM), (const pg8::bf16_t*)(PROJ + 8 * (size_t)NTOK * DM), (pg8::bf16_t*)(ws + WS_MG)};
            pg8::gemm_phase<pg8::EpiBranch, pg8::PairOrder, true, true, false>(lds + RING_OFF, g, S, E, wv);
        }
        GRID_BAR();
        if (RUN(5)) for (int rp = 0; rp < NREP(5); ++rp) {
            pg8::Gemm g{(const pg8::bf16_t*)(ws + WS_MG), (const pg8::bf16_t*)(ws + WS_WOUT) + (size_t)l * DM * DM, NTOK, DM, DM};
            pg8::StaticOrder S; S.init(NTOK, DM, G, (int)blockIdx.x);
            pg8::EpiBf16Plain E{(pg8::bf16_t*)(ws + WS_Y), DM};
            pg8::gemm_phase<pg8::EpiBf16Plain, pg8::StaticOrder, true, true, false>(lds + RING_OFF, g, S, E, wv);
        }
        GRID_BAR();
        if (RUN(6)) for (int rp = 0; rp < NREP(6); ++rp) phase_f(P, lds, l, l == 0 ? P.x : P.out, G, wv, rp == 0);
        GRID_BAR();
        if (RUN(7)) for (int rp = 0; rp < NREP(7); ++rp) {
            const int ntile = moe_tables(P, lds, l, wv);
            pg8::Gemm g{(const pg8::bf16_t*)(ws + WS_HB), (const pg8::bf16_t*)(ws + WS_WGU) + (size_t)l * NEXP * 2048 * DM, 0, 0, DM};
            pg8::MoeOrder S{G, (int)blockIdx.x, ntile, 8, (const LAS unsigned char*)(lds + T_RT2E), (const LAS int*)(lds + T_TBASE), (const LAS int*)(lds + T_CNT), (const int*)(ws + WS_LIST)};
            pg8::EpiMoe1 E{(pg8::bf16_t*)(ws + WS_ACT), P.b_gate + (size_t)l * NEXP * DM, P.b_up + (size_t)l * NEXP * DM};
            pg8::gemm_phase<pg8::EpiMoe1, pg8::MoeOrder, true, true, true>(lds + RING_OFF, g, S, E, wv);
        }
        GRID_BAR();
        if (RUN(8)) for (int rp = 0; rp < NREP(8); ++rp) {
            const int ntile = moe_tables(P, lds, l, wv);
            pg8::Gemm g{(const pg8::bf16_t*)(ws + WS_ACT), (const pg8::bf16_t*)(ws + WS_WD) + (size_t)l * NEXP * DM * DM, 0, 0, DM};
            pg8::MoeOrder S{G, (int)blockIdx.x, ntile, 4, (const LAS unsigned char*)(lds + T_RT2E), (const LAS int*)(lds + T_TBASE), (const LAS int*)(lds + T_CNT), (const int*)(ws + WS_LIST)};
            pg8::EpiMoe2 E{(pg8::bf16_t*)(ws + WS_YR), P.b_down + (size_t)l * NEXP * DM};
            pg8::gemm_phase<pg8::EpiMoe2, pg8::MoeOrder, true, true, false>(lds + RING_OFF, g, S, E, wv);
        }
        GRID_BAR();
        if (RUN(9)) for (int rp = 0; rp < NREP(9); ++rp) { (void)moe_tables(P, lds, l, wv); phase_j(P, lds, l, G, wv); }
        if (l + 1 < NLAYER) GRID_BAR();
    }
#undef GRID_BAR
#undef RUN
#undef tid
#undef P
#undef NREP
}

extern "C" void kernel_launch(void* const* d_in, const int* in_sizes, int n_in, void* d_out, int out_size, void* d_ws, size_t ws_size, hipStream_t stream) {
    static int grid = 0;
    if (grid == 0) {
        if (n_in != 22 || in_sizes[0] != NTOK * DM || out_size != NTOK * DM || ws_size < WS_END) {
            fprintf(stderr, "kernel_launch: built for 22 inputs, x/out of %d floats, >= %zu bytes of workspace; got n_in %d, in0 %d, out %d, ws %zu; nothing launched\n", NTOK * DM, (size_t)WS_END, n_in, n_in > 0 ? in_sizes[0] : -1, out_size, ws_size);
            grid = -1; return; }
        int dev = 0, cus = 0, per_cu = 0;
        if (hipGetDevice(&dev) != hipSuccess || hipDeviceGetAttribute(&cus, hipDeviceAttributeMultiprocessorCount, dev) != hipSuccess) { fprintf(stderr, "kernel_launch: device query failed\n"); grid = -1; return; }
        if (hipFuncSetAttribute((const void*)mk_fwd, hipFuncAttributeMaxDynamicSharedMemorySize, LDS_BYTES) != hipSuccess) { fprintf(stderr, "kernel_launch: hipFuncSetAttribute failed\n"); grid = -1; return; }
        if (hipOccupancyMaxActiveBlocksPerMultiprocessor(&per_cu, (const void*)mk_fwd, 512, LDS_BYTES) != hipSuccess || per_cu < 1) fprintf(stderr, "kernel_launch: note: occupancy query reports %d workgroups per CU\n", per_cu);
        (void)hipGetLastError();
        grid = cus;
        if (NTOK / (grid * 8) != 16 || NTOK % (grid * 8) != 0) { fprintf(stderr, "kernel_launch: %d CUs: the row-wise phases need NTOK %% (32 * CUs) == 0\n", grid); grid = -1; return; }
    }
    if (grid < 0) return;
    if (hipMemsetAsync((char*)d_ws + WS_CTL, 0, CTL_ZERO_BYTES, stream) != hipSuccess) { fprintf(stderr, "kernel_launch: hipMemsetAsync failed\n"); return; }
    Args a{};
    const float** pp = (const float**)&a.p;
    for (int i = 0; i < 22; ++i) pp[i] = (const float*)d_in[i];
    a.p.out = (float*)d_out; a.p.ws = (unsigned char*)d_ws;
    hipLaunchKernelGGL(mk_fwd, dim3(grid), dim3(512), LDS_BYTES, stream, a);
    const hipError_t le = hipPeekAtLastError();
    if (le != hipSuccess) fprintf(stderr, "kernel_launch: launch failed: %s (grid %d)\n", hipGetErrorName(le), grid);
}
```

```cpp
#include <hip/hip_runtime.h>
#include <hip/hip_bf16.h>
#include <cstdio>
#include <cstdint>
#include <cmath>

constexpr int NTOK = 32768, DM = 1024, NB = 8, SEQL = 4096, NLAYER = 4;
constexpr int NEXP = 32, TOPK = 4;
constexpr int PIN = 9232;
constexpr int NPROJ = 9216;
constexpr float DN_ALPHA = 1.6817928305074290f;
constexpr float LOG2E = 1.4426950408889634f;

namespace pg8 {
#define PG8_LAS __attribute__((address_space(3)))
typedef unsigned short bf16_t;
typedef short bf16x8 __attribute__((ext_vector_type(8)));
typedef float f32x4 __attribute__((ext_vector_type(4)));
typedef unsigned u32x4 __attribute__((ext_vector_type(4)));
constexpr int BM = 256, BK = 64, HALF = 128, HTB = HALF * BK * 2  , STAGE_BYTES = 8 * HTB, NXCD = 8, WGM = 4;

__host__ __device__ __forceinline__ int lds_byte(int r, int c) { const int st = (r >> 4) * 2 + (c >> 5), rr = r & 15, cc = c & 31, ob = rr * 64 + cc * 2; return st * 1024 + (ob ^ (((ob >> 9) & 1) << 5)); }
__host__ __device__ __forceinline__ void stage_rc(int b, int& R, int& C) { const int st = b / 1024, sb = b % 1024, swz = sb ^ (((sb >> 9) & 1) << 5); R = (st >> 1) * 16 + swz / 64; C = (st & 1) * 32 + (swz % 64) / 2; }
__host__ __device__ __forceinline__ int perm32(int rho) { const int n = rho >> 4, i = rho & 15; return 8 * (i >> 2) + 4 * n + (i & 3); }

struct Unit { int pm, pn; };
struct Gemm { const bf16_t* A; const bf16_t* Bt; int M, N, K; };

struct StaticOrder {
    int nM, nN, nwg, G, c;
    __host__ __device__ void init(int M, int N, int G_, int c_) { nM = M / BM; nN = N / BM; nwg = nM * nN; G = G_; c = c_; }
    __host__ __device__ bool map(long L, Unit& u) const {
        if (L >= nwg) return false;
        int wgid = (int)L; { const int q = nwg / NXCD, r = nwg % NXCD, xcd = wgid % NXCD, off = wgid / NXCD; wgid = (xcd < r ? xcd * (q + 1) : r * (q + 1) + (xcd - r) * q) + off; }
        const int nig = WGM * nN, gid = wgid / nig, fm = gid * WGM, gsz = (nM - fm) < WGM ? (nM - fm) : WGM;
        u.pm = fm + ((wgid % nig) % gsz); u.pn = (wgid % nig) / gsz; return true;
    }
    __host__ __device__ bool next(int i, Unit& u) const { return map((long)i * G + c, u); }
    __device__ __forceinline__ int arow(const Unit&, int) const { return 0; }
};
struct PairOrder {
    StaticOrder so;
    __device__ void init(int G_, int c_) { so.init(NTOK, DM, G_, c_); }
    __device__ bool next(int i, Unit& u) const { Unit t; if (!so.map((long)(i >> 1) * so.G + so.c, t)) return false; const int half = i & 1; u.pm = half * (NTOK / BM) + t.pm; u.pn = half * (DM / BM) + t.pn; return true; }
    __device__ __forceinline__ int arow(const Unit&, int) const { return 0; }
};
struct MoeOrder {
    int G, c, ntile, ncol;
    const PG8_LAS unsigned char* rt2e; const PG8_LAS int* tbase; const PG8_LAS int* cnt; const int* list;
    __device__ bool next(int i, Unit& u) const {
        if ((G & 7) != 0 || G < 256) { const long L = (long)i * G + c; if (L >= (long)ntile * ncol) return false; const int rt = (int)(L / ncol), pl = (int)(L % ncol); u.pm = rt; u.pn = (int)rt2e[rt] * ncol + pl; return true; }
        const int x = c & 7, k = c >> 3, per = G >> 5;
        const int nsub = ncol == 8 ? 4 : 8, sub = ncol == 8 ? (x >> 1) : x, pl = (ncol == 8 ? 4 * (x & 1) : 0) + (k & 3);
        const int Q = (ntile + nsub - 1) / nsub;
        const int rl = per * i + (k >> 2), rt = sub * Q + rl;
        if (rl >= Q || rt >= ntile) return false;
        u.pm = rt; u.pn = (int)rt2e[rt] * ncol + pl; return true; }
    __device__ __forceinline__ int arow(const Unit& u, int r) const { const int e = u.pn / ncol; const int pos = (u.pm - tbase[e]) * BM + r; return pos < cnt[e] ? list[e * NTOK + pos] : 0; }
};

__device__ __forceinline__ unsigned cvt_pk_bf16(float lo, float hi) { unsigned r; asm volatile("v_cvt_pk_bf16_f32 %0, %1, %2" : "=v"(r) : "v"(lo), "v"(hi)); return r; }
__device__ __forceinline__ float bf_lo(unsigned w) { return __uint_as_float(w << 16); }
__device__ __forceinline__ float bf_hi(unsigned w) { return __uint_as_float(w & 0xffff0000u); }
__device__ __forceinline__ float fast_sigmoid(float x) { return __builtin_amdgcn_rcpf(1.0f + __expf(-x)); }
template <int CTRL> __device__ __forceinline__ float dpp_row(float v) { return __int_as_float(__builtin_amdgcn_update_dpp(0, __float_as_int(v), CTRL, 0xF, 0xF, true)); }
__device__ __forceinline__ float row16_scan(float v) { v += dpp_row<0x111>(v); v += dpp_row<0x112>(v); v += dpp_row<0x114>(v); v += dpp_row<0x118>(v); return v; }
__device__ __forceinline__ float row16_sum(float v) { v += dpp_row<0x128>(v); v += dpp_row<0x124>(v); v += dpp_row<0x122>(v); v += dpp_row<0x121>(v); return v; }
__device__ __forceinline__ float row16_max(float v) { v = fmaxf(v, dpp_row<0x128>(v)); v = fmaxf(v, dpp_row<0x124>(v)); v = fmaxf(v, dpp_row<0x122>(v)); v = fmaxf(v, dpp_row<0x121>(v)); return v; }
__device__ __forceinline__ float rows4_sum(float v) {
    { auto r = __builtin_amdgcn_permlane32_swap(__float_as_uint(v), __float_as_uint(v), false, false); v = __uint_as_float(r[0]) + __uint_as_float(r[1]); }
    { auto r = __builtin_amdgcn_permlane16_swap(__float_as_uint(v), __float_as_uint(v), false, false); v = __uint_as_float(r[0]) + __uint_as_float(r[1]); }
    return v; }


struct EpiInProj {
    static constexpr bool PERM = true, AFTER_DRAIN = false;
#ifdef EPI_REP_INPROJ
    static constexpr int REPS = EPI_REP_INPROJ;
#else
    static constexpr int REPS = 1;
#endif
    bf16_t* proj; float* eb; const float* lb; float qscale; unsigned* nrm;
    __device__ __forceinline__ void operator()(const f32x4 (&acc)[2][2][4][2], const Unit& u, int wr, int wc, int fr, int fq) const {
        const int grp = u.pn >> 2, row0 = u.pm * BM + wr * 64 + fr, col0 = (u.pn & 3) * BM + wc * 32 + 8 * fq;
        bf16_t* base = proj + (size_t)grp * ((size_t)NTOK * DM);
        if (u.pn < 8) {
            const int hc0 = u.pn * HALF + wc * 32 + 8 * fq;
            bf16_t* qs = proj; bf16_t* kk_ = proj + (size_t)NTOK * DM;
            const f32x4 l0 = *(const f32x4*)(lb + hc0), l1 = *(const f32x4*)(lb + hc0 + 4);
#pragma unroll
            for (int ai = 0; ai < 2; ++ai)
#pragma unroll
                for (int jh = 0; jh < 2; ++jh) {
                    float qpv[4][4], kpv[4][4], ebm[4], ebl[4], blv[4];
#pragma unroll
                    for (int jj = 0; jj < 4; ++jj) {
                        const float lbv = jh == 0 ? l0[jj] : l1[jj];
                        float s[4], kk[4], tt[4];
#pragma unroll
                        for (int m = 0; m < 4; ++m) {
                            float x = acc[ai][1][m][jh][jj];
                            x = fminf(fmaxf(x, -30.f), 30.f);
                            const float e = __expf(-x), inv = __builtin_amdgcn_rcpf(1.0f + e), oms = e * inv;
                            const float f = lbv + (1.0f - lbv) * inv;
                            const float v = __logf(fmaxf(f, 1e-30f)); kk[m] = (1.0f - lbv) * oms;
                            s[m] = row16_scan(v); tt[m] = row16_sum(v);
                        }
                        const float t0 = tt[0], t1 = tt[1], t2 = tt[2], t3 = tt[3];
                        const float R = t0 + t1, BL = (t0 + t1) + (t2 + t3);
                        const float bq[4] = {s[0], s[1] + t0, s[2] + R, s[3] + (R + t2)};
#pragma unroll
                        for (int m = 0; m < 4; ++m) { const float qv = acc[ai][0][m][jh][jj];
                            qpv[m][jj] = qv * fast_sigmoid(qv) * __expf(fminf(bq[m] - R, 80.f)); kpv[m][jj] = kk[m] * __expf(fminf(R - bq[m], 80.f)); }
                        ebm[jj] = __expf(R); ebl[jj] = __expf(BL - R); blv[jj] = BL;
                    }
                    typedef unsigned u32x2_t __attribute__((ext_vector_type(2)));
#pragma unroll
                    for (int m = 0; m < 4; ++m) { const size_t off = ((size_t)u.pn * NTOK + (row0 + ai * HALF + m * 16)) * HALF + (wc * 32 + 8 * fq + 4 * jh);
                        u32x2_t w; w.x = cvt_pk_bf16(kpv[m][0], kpv[m][1]); w.y = cvt_pk_bf16(kpv[m][2], kpv[m][3]); *(u32x2_t*)(kk_ + off) = w;
                        u32x2_t q; q.x = cvt_pk_bf16(qpv[m][0], qpv[m][1]); q.y = cvt_pk_bf16(qpv[m][2], qpv[m][3]); *(u32x2_t*)(qs + off) = q; }
                    if (fr == 0) { const size_t eo = (size_t)((u.pm * BM + ai * HALF + wr * 64) >> 6) * DM + hc0 + 4 * jh; const size_t es = (size_t)(NTOK / 64) * DM;
                        *(f32x4*)(eb + eo) = (f32x4){ebm[0], ebm[1], ebm[2], ebm[3]}; *(f32x4*)(eb + es + eo) = (f32x4){ebl[0], ebl[1], ebl[2], ebl[3]}; *(f32x4*)(eb + 2 * es + eo) = (f32x4){blv[0], blv[1], blv[2], blv[3]}; }
                }
            return;
        }
        const int mode = grp == 3 ? 1 : (grp >= 7 ? 2 : 0);
        const float sc = grp == 4 ? qscale : 1.0f;
        const bool wantn = grp == 4 || grp == 5;
        float mx[2][2] = {{0.f, 0.f}, {0.f, 0.f}};
        size_t hoff[2]; int rstr;
        if (grp <= 3) { rstr = HALF; hoff[0] = (size_t)((u.pn & 3) * 2 + 0) * NTOK * HALF + wc * 32 + 8 * fq; hoff[1] = (size_t)((u.pn & 3) * 2 + 1) * NTOK * HALF + wc * 32 + 8 * fq; }
        else if (grp <= 6) { rstr = 64; hoff[0] = (size_t)((u.pn & 3) * 4 + 0 + (wc >> 1)) * NTOK * 64 + (wc & 1) * 32 + 8 * fq; hoff[1] = (size_t)((u.pn & 3) * 4 + 2 + (wc >> 1)) * NTOK * 64 + (wc & 1) * 32 + 8 * fq; }
        else { rstr = DM; hoff[0] = col0; hoff[1] = col0 + HALF; }
#pragma unroll
        for (int ai = 0; ai < 2; ++ai)
#pragma unroll
            for (int m = 0; m < 4; ++m) { bf16_t* rowp = base + (size_t)(row0 + ai * HALF + m * 16) * rstr;
#pragma unroll
                for (int bj = 0; bj < 2; ++bj) { f32x4 v0 = acc[ai][bj][m][0], v1 = acc[ai][bj][m][1];
                    if (mode != 0) {
#pragma unroll
                        for (int j = 0; j < 4; ++j) { const float s0 = fast_sigmoid(v0[j]), s1 = fast_sigmoid(v1[j]); v0[j] = mode == 1 ? v0[j] * s0 : s0; v1[j] = mode == 1 ? v1[j] * s1 : s1; }
                    } else { v0 = v0 * sc; v1 = v1 * sc; }
                    if (wantn) { float ss = (v0[0] * v0[0] + v0[1] * v0[1]) + (v0[2] * v0[2] + v0[3] * v0[3]) + (v1[0] * v1[0] + v1[1] * v1[1]) + (v1[2] * v1[2] + v1[3] * v1[3]);
                        ss = rows4_sum(ss); mx[ai][bj] = fmaxf(mx[ai][bj], ss); }
                    u32x4 w; w.x = cvt_pk_bf16(v0[0], v0[1]); w.y = cvt_pk_bf16(v0[2], v0[3]); w.z = cvt_pk_bf16(v1[0], v1[1]); w.w = cvt_pk_bf16(v1[2], v1[3]);
                    *(u32x4*)(rowp + hoff[bj]) = w; } }
        if (wantn) {
#pragma unroll
            for (int ai = 0; ai < 2; ++ai)
#pragma unroll
                for (int bj = 0; bj < 2; ++bj) { float v = mx[ai][bj];
                    v = row16_max(v);
                    if (fr == 0 && fq == 0) { const int R = u.pm * BM + ai * HALF + wr * 64, head = ((u.pn & 3) * BM + bj * HALF + wc * 32) >> 6;
                        atomicMax(nrm + ((((grp - 4) * 128 + (R >> 12) * 16 + head) * 64 + ((R & 4095) >> 6)) * 2 + (wc & 1)), __float_as_uint(v)); } }
        }
    }
};
struct EpiBranch {
    static constexpr bool PERM = true, AFTER_DRAIN = false;
    static constexpr int REPS = 1;
    const bf16_t* ga; const bf16_t* gb; bf16_t* mg;
    __device__ __forceinline__ void operator()(const f32x4 (&acc)[2][2][4][2], const Unit& u, int wr, int wc, int fr, int fq) const {
        const int half = u.pm >= (NTOK / BM) ? 1 : 0, pm = u.pm - half * (NTOK / BM), pn = u.pn - half * (DM / BM);
        const int row0 = pm * BM + wr * 64 + fr, col0 = pn * BM + wc * 32 + 8 * fq;
        const bf16_t* gp = half ? gb : ga;
#pragma unroll
        for (int ai = 0; ai < 2; ++ai)
#pragma unroll
            for (int m = 0; m < 4; ++m) { const size_t ro = (size_t)(row0 + ai * HALF + m * 16) * DM + col0;
#pragma unroll
                for (int bj = 0; bj < 2; ++bj) { const f32x4 v0 = acc[ai][bj][m][0], v1 = acc[ai][bj][m][1];
                    const u32x4 gw = *(const u32x4*)(gp + ro + bj * HALF);
                    float o[8];
                    o[0] = bf_lo(gw.x) * v0[0]; o[1] = bf_hi(gw.x) * v0[1]; o[2] = bf_lo(gw.y) * v0[2]; o[3] = bf_hi(gw.y) * v0[3];
                    o[4] = bf_lo(gw.z) * v1[0]; o[5] = bf_hi(gw.z) * v1[1]; o[6] = bf_lo(gw.w) * v1[2]; o[7] = bf_hi(gw.w) * v1[3];
                    if (half) { const u32x4 pw = *(const u32x4*)(mg + ro + bj * HALF);
                        o[0] += bf_lo(pw.x); o[1] += bf_hi(pw.x); o[2] += bf_lo(pw.y); o[3] += bf_hi(pw.y); o[4] += bf_lo(pw.z); o[5] += bf_hi(pw.z); o[6] += bf_lo(pw.w); o[7] += bf_hi(pw.w); }
                    u32x4 w; w.x = cvt_pk_bf16(o[0], o[1]); w.y = cvt_pk_bf16(o[2], o[3]); w.z = cvt_pk_bf16(o[4], o[5]); w.w = cvt_pk_bf16(o[6], o[7]);
                    *(u32x4*)(mg + ro + bj * HALF) = w; } }
    }
};
struct EpiBf16Plain {
    static constexpr bool PERM = true, AFTER_DRAIN = false;
    static constexpr int REPS = 1;
    bf16_t* O; int ldc;
    __device__ __forceinline__ void operator()(const f32x4 (&acc)[2][2][4][2], const Unit& u, int wr, int wc, int fr, int fq) const {
        const int row0 = u.pm * BM + wr * 64 + fr, col0 = u.pn * BM + wc * 32 + 8 * fq;
#pragma unroll
        for (int ai = 0; ai < 2; ++ai)
#pragma unroll
            for (int m = 0; m < 4; ++m) { bf16_t* rowp = O + (size_t)(row0 + ai * HALF + m * 16) * ldc + col0;
#pragma unroll
                for (int bj = 0; bj < 2; ++bj) { const f32x4 v0 = acc[ai][bj][m][0], v1 = acc[ai][bj][m][1];
                    u32x4 w; w.x = cvt_pk_bf16(v0[0], v0[1]); w.y = cvt_pk_bf16(v0[2], v0[3]); w.z = cvt_pk_bf16(v1[0], v1[1]); w.w = cvt_pk_bf16(v1[2], v1[3]);
                    *(u32x4*)(rowp + bj * HALF) = w; } }
    }
};
struct EpiF32 {
    static constexpr bool PERM = true, AFTER_DRAIN = false;
    static constexpr int REPS = 1;
    float* O; int ldc;
    __device__ __forceinline__ void operator()(const f32x4 (&acc)[2][2][4][2], const Unit& u, int wr, int wc, int fr, int fq) const {
        const int row0 = u.pm * BM + wr * 64 + fr, col0 = u.pn * BM + wc * 32 + 8 * fq;
#pragma unroll
        for (int ai = 0; ai < 2; ++ai)
#pragma unroll
            for (int m = 0; m < 4; ++m) { float* rowp = O + (size_t)(row0 + ai * HALF + m * 16) * ldc + col0;
#pragma unroll
                for (int bj = 0; bj < 2; ++bj) { *(f32x4*)(rowp + bj * HALF) = acc[ai][bj][m][0]; *(f32x4*)(rowp + bj * HALF + 4) = acc[ai][bj][m][1]; } }
    }
};
struct EpiMoe1 {
    static constexpr bool PERM = true, AFTER_DRAIN = false;
#ifdef EPI_REP_MOE
    static constexpr int REPS = EPI_REP_MOE;
#else
    static constexpr int REPS = 1;
#endif
    bf16_t* act; const float* bg; const float* bu;
    __device__ __forceinline__ void operator()(const f32x4 (&acc)[2][2][4][2], const Unit& u, int wr, int wc, int fr, int fq) const {
        const int row0 = u.pm * BM + wr * 64 + fr, cl = wc * 32 + 8 * fq, colo = (u.pn & 7) * HALF + cl;
        const size_t bo = (size_t)u.pn * HALF + cl;
        const f32x4 g0 = *(const f32x4*)(bg + bo), g1 = *(const f32x4*)(bg + bo + 4), u0 = *(const f32x4*)(bu + bo), u1 = *(const f32x4*)(bu + bo + 4);
#pragma unroll
        for (int ai = 0; ai < 2; ++ai)
#pragma unroll
            for (int m = 0; m < 4; ++m) {
                float o[8];
#pragma unroll
                for (int j = 0; j < 8; ++j) {
                    float gv = (j < 4 ? acc[ai][0][m][0][j & 3] : acc[ai][0][m][1][j & 3]) + (j < 4 ? g0[j & 3] : g1[j & 3]);
                    float uv = (j < 4 ? acc[ai][1][m][0][j & 3] : acc[ai][1][m][1][j & 3]) + (j < 4 ? u0[j & 3] : u1[j & 3]);
                    gv = fminf(gv, 7.0f); uv = fminf(fmaxf(uv, -7.0f), 7.0f);
                    o[j] = (uv + 1.0f) * (gv * fast_sigmoid(1.702f * gv));
                }
                u32x4 w; w.x = cvt_pk_bf16(o[0], o[1]); w.y = cvt_pk_bf16(o[2], o[3]); w.z = cvt_pk_bf16(o[4], o[5]); w.w = cvt_pk_bf16(o[6], o[7]);
                *(u32x4*)(act + (size_t)(row0 + ai * HALF + m * 16) * DM + colo) = w;
            }
    }
};
struct EpiMoe2 {
    static constexpr bool PERM = true, AFTER_DRAIN = false;
#ifdef EPI_REP_MOE
    static constexpr int REPS = EPI_REP_MOE;
#else
    static constexpr int REPS = 1;
#endif
    bf16_t* yr; const float* bd;
    __device__ __forceinline__ void operator()(const f32x4 (&acc)[2][2][4][2], const Unit& u, int wr, int wc, int fr, int fq) const {
        const int row0 = u.pm * BM + wr * 64 + fr, cl = wc * 32 + 8 * fq, colo = (u.pn & 3) * BM + cl;
        const size_t bo = (size_t)u.pn * BM + cl;
        f32x4 bv[2][2];
#pragma unroll
        for (int bj = 0; bj < 2; ++bj) { bv[bj][0] = *(const f32x4*)(bd + bo + bj * HALF); bv[bj][1] = *(const f32x4*)(bd + bo + bj * HALF + 4); }
#pragma unroll
        for (int ai = 0; ai < 2; ++ai)
#pragma unroll
            for (int m = 0; m < 4; ++m) { bf16_t* rowp = yr + (size_t)(row0 + ai * HALF + m * 16) * DM + colo;
#pragma unroll
                for (int bj = 0; bj < 2; ++bj) { const f32x4 v0 = acc[ai][bj][m][0] + bv[bj][0], v1 = acc[ai][bj][m][1] + bv[bj][1];
                    u32x4 w; w.x = cvt_pk_bf16(v0[0], v0[1]); w.y = cvt_pk_bf16(v0[2], v0[3]); w.z = cvt_pk_bf16(v1[0], v1[1]); w.w = cvt_pk_bf16(v1[2], v1[3]);
                    *(u32x4*)(rowp + bj * HALF) = w; } }
    }
};
template <class Epi, class Sched, bool ALIGN_EPI = false, bool SP2 = false, bool GATHER = false>
__device__ __forceinline__ void gemm_phase(PG8_LAS unsigned char* lds, const Gemm g, const Sched& S, const Epi& E, const int wv  ) {
    int tid_ = wv * 64 + (int)__builtin_amdgcn_mbcnt_hi(~0u, __builtin_amdgcn_mbcnt_lo(~0u, 0u)); asm volatile("" : "+v"(tid_));
    const int tid = tid_, wid = __builtin_amdgcn_readfirstlane(tid >> 6), lane = tid & 63, wr = wid >> 2, wc = wid & 3, fr = lane & 15, fq = lane >> 4;
    const int K = g.K, nt = K / BK;
    unsigned voffA[2], voffB[2]; int rA[2], cA2[2];
#pragma unroll
    for (int i = 0; i < 2; ++i) { int R, C; stage_rc(tid * 16 + i * 8192, R, C); const int Rb = Epi::PERM ? ((R & ~31) + perm32(R & 31)) : R;
        voffA[i] = (unsigned)(R * K + C) * 2u; voffB[i] = (unsigned)(Rb * K + C) * 2u; rA[i] = R; cA2[i] = C * 2; }
    unsigned cvo[2][2], nvo[2][2];
#define PG8_GVO(dst, un) do { _Pragma("unroll") for (int _h = 0; _h < 2; ++_h) _Pragma("unroll") for (int _i = 0; _i < 2; ++_i) \
        dst[_h][_i] = (unsigned)S.arow(un, _h * HALF + rA[_i]) * (unsigned)(K * 2) + (unsigned)cA2[_i]; } while (0)
    const size_t kstep = (size_t)(BK * 2);
    const size_t hstep = (size_t)HALF * K * 2;
    const size_t tstep = 2 * hstep;
    const unsigned ldsw = (unsigned)wid * 1024u;
    const int aoff = lds_byte(wr * 64 + fr, fq * 8), boff = lds_byte(wc * 32 + fr, fq * 8);
#define PG8_SA(b, h) (((b) * 2 + (h)) * HTB)
#define PG8_SB(b, h) ((4 + (b) * 2 + (h)) * HTB)
#define PG8_STAGE(bufoff, gbase, voff) do { _Pragma("unroll") for (int _i = 0; _i < 2; ++_i) \
        __builtin_amdgcn_global_load_lds((const unsigned*)((const char*)(gbase) + (voff)[_i]), (PG8_LAS unsigned*)(lds + (bufoff) + ldsw + _i * 8192), 16, 0, 0); } while (0)
#define PG8_STAGE_A(bufoff, gbase, hh, nx) do { if constexpr (GATHER) { _Pragma("unroll") for (int _i = 0; _i < 2; ++_i) { const unsigned _vo = (nx) ? nvo[hh][_i] : cvo[hh][_i]; \
        __builtin_amdgcn_global_load_lds((const unsigned*)((const char*)(gbase) + _vo), (PG8_LAS unsigned*)(lds + (bufoff) + ldsw + _i * 8192), 16, 0, 0); } } \
        else { PG8_STAGE(bufoff, (gbase) + (hh) * hstep, voffA); } } while (0)
#define PG8_LDA(dst, b, h) do { _Pragma("unroll") for (int m = 0; m < 4; ++m) _Pragma("unroll") for (int k = 0; k < 2; ++k) dst[m][k] = *(const PG8_LAS bf16x8*)(lds + PG8_SA(b, h) + aoff + m * 2048 + k * 1024); } while (0)
#define PG8_LDB(dst, b, h) do { _Pragma("unroll") for (int n = 0; n < 2; ++n) _Pragma("unroll") for (int k = 0; k < 2; ++k) dst[n][k] = *(const PG8_LAS bf16x8*)(lds + PG8_SB(b, h) + boff + n * 2048 + k * 1024); } while (0)
#define PG8_MMA(ai, bj, At, Bt) do { __builtin_amdgcn_s_setprio(1); _Pragma("unroll") for (int m = 0; m < 4; ++m) _Pragma("unroll") for (int n = 0; n < 2; ++n) _Pragma("unroll") for (int k = 0; k < 2; ++k) \
        acc[ai][bj][m][n] = __builtin_amdgcn_mfma_f32_16x16x32_bf16(Bt[n][k], At[m][k], acc[ai][bj][m][n], 0, 0, 0); __builtin_amdgcn_s_setprio(0); } while (0)
#define PG8_WAIT_V(n) asm volatile("s_waitcnt vmcnt(" #n ")" ::: "memory")
#define PG8_WAIT_L(n) asm volatile("s_waitcnt lgkmcnt(" #n ")" ::: "memory")
#define PG8_BAR __builtin_amdgcn_s_barrier()
#define PG8_SCHED __builtin_amdgcn_sched_barrier(0)
    Unit cur, nxt; int ui = 0;
    if (!S.next(0, cur)) return;
    f32x4 acc[2][2][4][2];
#pragma unroll
    for (int a = 0; a < 2; ++a)
#pragma unroll
        for (int b = 0; b < 2; ++b)
#pragma unroll
            for (int m = 0; m < 4; ++m)
#pragma unroll
                for (int n = 0; n < 2; ++n) acc[a][b][m][n] = (f32x4){0.f, 0.f, 0.f, 0.f};
    bf16x8 At[4][2], B0[2][2], B1[2][2];
    const char* cA = (const char*)g.A + (GATHER ? (size_t)0 : (size_t)cur.pm * tstep); const char* cB = (const char*)g.Bt + (size_t)cur.pn * tstep;
    if constexpr (GATHER) { PG8_GVO(cvo, cur); }
    if constexpr (SP2) {
        PG8_STAGE(PG8_SB(0, 0), cB, voffB); PG8_STAGE(PG8_SB(0, 1), cB + hstep, voffB); PG8_STAGE_A(PG8_SA(0, 0), cA, 0, false); PG8_STAGE_A(PG8_SA(0, 1), cA, 1, false);
        if (wr == 1) PG8_BAR;
        PG8_WAIT_V(2); PG8_BAR;
        PG8_STAGE(PG8_SB(1, 0), cB + kstep, voffB); PG8_STAGE_A(PG8_SA(1, 0), cA + kstep, 0, false); PG8_STAGE(PG8_SB(1, 1), cB + hstep + kstep, voffB);
        PG8_WAIT_V(6); PG8_BAR;
    } else {
        PG8_STAGE(PG8_SB(0, 0), cB, voffB); PG8_STAGE_A(PG8_SA(0, 0), cA, 0, false); PG8_STAGE(PG8_SB(0, 1), cB + hstep, voffB); PG8_STAGE_A(PG8_SA(0, 1), cA, 1, false);
        if (wr == 1) PG8_BAR;
        PG8_WAIT_V(4); PG8_BAR;
        PG8_STAGE(PG8_SB(1, 0), cB + kstep, voffB); PG8_STAGE_A(PG8_SA(1, 0), cA + kstep, 0, false); PG8_STAGE(PG8_SB(1, 1), cB + hstep + kstep, voffB);
        PG8_WAIT_V(6); PG8_BAR;
    }
    for (;;) {
        const bool has_next = S.next(ui + 1, nxt);
        const char* nA = GATHER ? cA : (has_next ? (const char*)g.A + (size_t)nxt.pm * tstep : cA); const char* nB = has_next ? (const char*)g.Bt + (size_t)nxt.pn * tstep : cB;
        if constexpr (GATHER) { if (has_next) { PG8_GVO(nvo, nxt); } else { _Pragma("unroll") for (int _h = 0; _h < 2; ++_h) _Pragma("unroll") for (int _i = 0; _i < 2; ++_i) nvo[_h][_i] = cvo[_h][_i]; } }
        for (int t = 0; t < nt; t += 2) {
            const bool last = (t == nt - 2);
            const char* a1 = cA + (size_t)(t + 1) * kstep;
            const char* a2 = last ? nA : cA + (size_t)(t + 2) * kstep; const char* b2 = last ? nB : cB + (size_t)(t + 2) * kstep;
            const char* a3 = a2 + kstep; const char* b3 = b2 + kstep;
            if constexpr (SP2) {
            PG8_LDB(B0, 0, 0); PG8_LDB(B1, 0, 1); PG8_SCHED; PG8_LDA(At, 0, 0); PG8_STAGE_A(PG8_SA(1, 1), a1, 1, false);
            PG8_WAIT_V(8); PG8_WAIT_L(0); PG8_BAR; PG8_MMA(0, 0, At, B0); PG8_MMA(0, 1, At, B1); PG8_BAR; PG8_SCHED;
            PG8_LDA(At, 0, 1); PG8_STAGE(PG8_SB(0, 0), b2, voffB); PG8_STAGE(PG8_SB(0, 1), b2 + hstep, voffB); PG8_STAGE_A(PG8_SA(0, 0), a2, 0, last);
            PG8_WAIT_V(8); PG8_WAIT_L(0); PG8_BAR; PG8_MMA(1, 0, At, B0); PG8_MMA(1, 1, At, B1); PG8_BAR; PG8_SCHED;
            PG8_LDB(B0, 1, 0); PG8_LDB(B1, 1, 1); PG8_SCHED; PG8_LDA(At, 1, 0); PG8_STAGE_A(PG8_SA(0, 1), a2, 1, last);
            PG8_WAIT_V(8); PG8_WAIT_L(0); PG8_BAR; PG8_MMA(0, 0, At, B0); PG8_MMA(0, 1, At, B1); PG8_BAR; PG8_SCHED;
            PG8_LDA(At, 1, 1); PG8_STAGE(PG8_SB(1, 0), b3, voffB); PG8_STAGE(PG8_SB(1, 1), b3 + hstep, voffB); PG8_STAGE_A(PG8_SA(1, 0), a3, 0, last);
            PG8_WAIT_V(8); PG8_WAIT_L(0); PG8_BAR; PG8_MMA(1, 0, At, B0); PG8_MMA(1, 1, At, B1); PG8_BAR; PG8_SCHED;
            } else {
            PG8_LDB(B0, 0, 0); PG8_SCHED; PG8_LDA(At, 0, 0); PG8_STAGE_A(PG8_SA(1, 1), a1, 1, false);
            PG8_WAIT_L(8); PG8_BAR; PG8_WAIT_L(0); PG8_MMA(0, 0, At, B0); PG8_BAR; PG8_SCHED;
            PG8_LDB(B1, 0, 1); PG8_STAGE(PG8_SB(0, 0), b2, voffB);
            PG8_BAR; PG8_WAIT_L(0); PG8_MMA(0, 1, At, B1); PG8_BAR;
            PG8_LDA(At, 0, 1); PG8_STAGE_A(PG8_SA(0, 0), a2, 0, last);
            PG8_BAR; PG8_WAIT_L(0); PG8_MMA(1, 0, At, B0); PG8_BAR; PG8_SCHED;
            PG8_STAGE(PG8_SB(0, 1), b2 + hstep, voffB);
            PG8_WAIT_V(6); PG8_BAR; PG8_MMA(1, 1, At, B1); PG8_BAR;
            PG8_LDB(B0, 1, 0); PG8_SCHED; PG8_LDA(At, 1, 0); PG8_STAGE_A(PG8_SA(0, 1), a2, 1, last);
            PG8_WAIT_L(8); PG8_BAR; PG8_WAIT_L(0); PG8_MMA(0, 0, At, B0); PG8_BAR; PG8_SCHED;
            PG8_LDB(B1, 1, 1); PG8_STAGE(PG8_SB(1, 0), b3, voffB);
            PG8_BAR; PG8_WAIT_L(0); PG8_MMA(0, 1, At, B1); PG8_BAR;
            PG8_LDA(At, 1, 1); PG8_STAGE_A(PG8_SA(1, 0), a3, 0, last);
            PG8_BAR; PG8_WAIT_L(0); PG8_MMA(1, 0, At, B0); PG8_BAR; PG8_SCHED;
            PG8_STAGE(PG8_SB(1, 1), b3 + hstep, voffB);
            PG8_WAIT_V(6); PG8_BAR; PG8_MMA(1, 1, At, B1); PG8_BAR;
            }
        }
        if constexpr (ALIGN_EPI) { if (wr == 0) PG8_BAR; }
        if constexpr (!Epi::AFTER_DRAIN) { E(acc, cur, wr, wc, fr, fq); if constexpr (Epi::REPS > 1) { asm volatile("" ::: "memory"); E(acc, cur, wr, wc, fr, fq); } }
        if (!has_next) break;
#pragma unroll
        for (int a = 0; a < 2; ++a)
#pragma unroll
            for (int b = 0; b < 2; ++b)
#pragma unroll
                for (int m = 0; m < 4; ++m)
#pragma unroll
                    for (int n = 0; n < 2; ++n) acc[a][b][m][n] = (f32x4){0.f, 0.f, 0.f, 0.f};
        cur = nxt; cA = nA; cB = nB; ++ui;
        if constexpr (GATHER) { _Pragma("unroll") for (int _h = 0; _h < 2; ++_h) _Pragma("unroll") for (int _i = 0; _i < 2; ++_i) cvo[_h][_i] = nvo[_h][_i]; }
        if constexpr (ALIGN_EPI) { if (wr == 1) PG8_BAR; }
    }
    PG8_WAIT_V(0);
    if constexpr (!ALIGN_EPI) { if (wr == 0) PG8_BAR; }
    PG8_BAR;
#undef PG8_SA
#undef PG8_SB
#undef PG8_STAGE
#undef PG8_STAGE_A
#undef PG8_GVO
#undef PG8_LDA
#undef PG8_LDB
#undef PG8_MMA
#undef PG8_WAIT_V
#undef PG8_WAIT_L
#undef PG8_BAR
#undef PG8_SCHED
}
}

namespace attn_body {
using bf16=__hip_bfloat16;
using bf16x8=__attribute__((ext_vector_type(8)))short;
using s16x4=__attribute__((ext_vector_type(4)))short;
using f32x16=__attribute__((ext_vector_type(16)))float;
using u32x4=__attribute__((ext_vector_type(4)))unsigned;
constexpr int BATCH=8,NHEAD=16,SEQ=4096,D=64,DM=NHEAD*D;
constexpr long HSTR=(long)BATCH*SEQ*D;
constexpr int NW=8,QBLK=32,QB=QBLK*NW,KVBLK=64,NQB=SEQ/QB;
constexpr int ATTN_PITCH=DM, ATTN_UNIT_ROWS=QB;
__device__ __forceinline__ int crow(int r,int hi){return (r&3)+8*(r>>2)+4*hi;}
#define SBAR() __builtin_amdgcn_sched_barrier(0)
__device__ __forceinline__ void cmask(f32x16&p0,f32x16&p1,int jb,int qrel,int hi){
  const float NEG=-INFINITY; int kb=64*jb+4*hi;
  #pragma unroll
  for(int r=0;r<16;++r){int kv=kb+(r&3)+8*(r>>2); if(kv>qrel)p0[r]=NEG; if(kv+32>qrel)p1[r]=NEG;}
}

constexpr int NSLOT=3, SLOTB=8192;
constexpr int LDS_K=0, LDS_V=NSLOT*SLOTB, LDS_WS=2*NSLOT*SLOTB, LDS_OST=LDS_WS+NW*64*4, LDS_FK=LDS_OST+NW*4096, LDS_BYTES=LDS_FK+SEQ*4;
constexpr float C2=0.125f*1.4426950408889634f;
__device__ __forceinline__ void glds16(const void*gsrc,unsigned lds_dst){unsigned keep;
  asm volatile("s_mov_b32 %0, m0\n\ts_mov_b32 m0, %2\n\ts_nop 0\n\tglobal_load_lds_dwordx4 %1, off\n\ts_mov_b32 m0, %0":"=&s"(keep):"v"(gsrc),"s"(lds_dst):"memory");}
__device__ __forceinline__ float max3f(float a,float b,float c){float r;asm("v_max3_f32 %0, %1, %2, %3":"=v"(r):"v"(a),"v"(b),"v"(c));return r;}
__device__ __forceinline__ float max2f(float a,float b){float r;asm("v_max_f32_e32 %0, %1, %2":"=v"(r):"v"(a),"v"(b));return r;}
__device__ __forceinline__ float fadd_s(float a,float b){float r;asm("v_add_f32_e32 %0, %1, %2":"=v"(r):"v"(a),"v"(b));return r;}
__device__ __forceinline__ float fsub_s(float a,float b){float r;asm("v_sub_f32_e32 %0, %1, %2":"=v"(r):"v"(a),"v"(b));return r;}
typedef float f32x2_t __attribute__((ext_vector_type(2))); typedef __bf16 bf16x2_t __attribute__((ext_vector_type(2)));
__device__ __forceinline__ unsigned cvtpk_s(float lo,float hi){f32x2_t v={lo,hi};bf16x2_t b=__builtin_convertvector(v,bf16x2_t);return __builtin_bit_cast(unsigned,b);}
#define WAIT_BAR(N) asm volatile("s_waitcnt vmcnt(" #N ") lgkmcnt(0)\n\ts_barrier":::"memory")

__device__ __forceinline__ void qkt(f32x16&p0,f32x16&p1,const char*Kslot,const bf16x8*qr,int r32,int hi){
  const char*kb=Kslot+hi*1024+r32*16;
  #pragma unroll
  for(int d0=0;d0<4;++d0){
    const bf16x8 b0=*reinterpret_cast<const bf16x8*>(kb+d0*2048);
    const bf16x8 b1=*reinterpret_cast<const bf16x8*>(kb+d0*2048+512);
    p0=__builtin_amdgcn_mfma_f32_32x32x16_bf16(b0,qr[d0],p0,0,0,0);p1=__builtin_amdgcn_mfma_f32_32x32x16_bf16(b1,qr[d0],p1,0,0,0);}
}
typedef __attribute__((address_space(3))) const char* lds_cptr;
typedef short v4i16_t __attribute__((ext_vector_type(4)));
__device__ __forceinline__ void kload8(bf16x8*kf,lds_cptr kp){
  kf[0]=*(const __attribute__((address_space(3))) bf16x8*)(kp);      kf[1]=*(const __attribute__((address_space(3))) bf16x8*)(kp+512);
  kf[2]=*(const __attribute__((address_space(3))) bf16x8*)(kp+2048); kf[3]=*(const __attribute__((address_space(3))) bf16x8*)(kp+2560);
  kf[4]=*(const __attribute__((address_space(3))) bf16x8*)(kp+4096); kf[5]=*(const __attribute__((address_space(3))) bf16x8*)(kp+4608);
  kf[6]=*(const __attribute__((address_space(3))) bf16x8*)(kp+6144); kf[7]=*(const __attribute__((address_space(3))) bf16x8*)(kp+6656);
}
__device__ __forceinline__ void kload2(bf16x8*kf,lds_cptr kp,int j){ kf[2*j]=*(const __attribute__((address_space(3))) bf16x8*)(kp+j*2048); kf[2*j+1]=*(const __attribute__((address_space(3))) bf16x8*)(kp+j*2048+512); }
__device__ __forceinline__ s16x4 vtr(lds_cptr p){ return __builtin_bit_cast(s16x4,__builtin_amdgcn_ds_read_tr16_b64_v4i16((__attribute__((address_space(3))) v4i16_t*)p)); }
__device__ __forceinline__ float rowmax(const f32x16&p0,const f32x16&p1){
  float a=max3f(p0[0],p0[1],p1[0]),b=max3f(p0[2],p0[3],p1[1]);a=max3f(a,p1[2],p1[3]);
  #pragma unroll
  for(int r=4;r<16;r+=4){a=max3f(a,p0[r],p0[r+1]);b=max3f(b,p0[r+2],p0[r+3]);a=max3f(a,p1[r],p1[r+1]);b=max3f(b,p1[r+2],p1[r+3]);}
  const float m=max2f(a,b);
  auto rr=__builtin_amdgcn_permlane32_swap(__float_as_uint(m),__float_as_uint(m),false,false);
  return max2f(__uint_as_float(rr[0]),__uint_as_float(rr[1]));
}
__device__ __forceinline__ void pv(f32x16*o,int vb,bf16x8 pa0,bf16x8 pa1,bf16x8 pa2,bf16x8 pa3){
  #pragma unroll
  for(int d0=0;d0<2;++d0){s16x4 lo[4],hi[4];
    #pragma unroll
    for(int ks=0;ks<4;++ks){
      asm volatile("ds_read_b64_tr_b16 %0,%1 offset:%c2":"=&v"(lo[ks]):"v"(vb),"i"(d0*4096+ks*1024):"memory");
      asm volatile("ds_read_b64_tr_b16 %0,%1 offset:%c2":"=&v"(hi[ks]):"v"(vb),"i"(d0*4096+ks*1024+512):"memory");}
    asm volatile("s_waitcnt lgkmcnt(0)":::"memory");SBAR();
    #define PK(k) (bf16x8){lo[k][0],lo[k][1],lo[k][2],lo[k][3],hi[k][0],hi[k][1],hi[k][2],hi[k][3]}
    o[d0]=__builtin_amdgcn_mfma_f32_32x32x16_bf16(pa0,PK(0),o[d0],0,0,0);
    o[d0]=__builtin_amdgcn_mfma_f32_32x32x16_bf16(pa1,PK(1),o[d0],0,0,0);
    o[d0]=__builtin_amdgcn_mfma_f32_32x32x16_bf16(pa2,PK(2),o[d0],0,0,0);
    o[d0]=__builtin_amdgcn_mfma_f32_32x32x16_bf16(pa3,PK(3),o[d0],0,0,0);
    #undef PK
  }
}

#ifndef ATTN_STORE16
#define ATTN_STORE16(p,v) (*(u32x4*)(p)=(v))
#endif
template<int THRL> __device__ __forceinline__ void attn_unit(int b,int h,int qb,const bf16*Q,const bf16*__restrict__ K,const bf16*__restrict__ V,bf16*O,const float*__restrict__ FP,const unsigned*__restrict__ NQ,const unsigned*__restrict__ NK,unsigned*wq,volatile __attribute__((address_space(3))) unsigned*wslot,char*shm,const int wv){
  int tid_ = wv * 64 + (int)__builtin_amdgcn_mbcnt_hi(~0u, __builtin_amdgcn_mbcnt_lo(~0u, 0u)); asm volatile("" : "+v"(tid_));
  const int tid=tid_,lane=tid&63,r32=lane&31,hi=lane>>5; const int wid=__builtin_amdgcn_readfirstlane(tid>>6);
  const long rowbase=(long)b*SEQ; const int q0=qb*QB;
  const bf16*Qw=Q+(long)h*HSTR+(rowbase+q0+wid*QBLK)*D;
  unsigned wnext=0u; if(tid==0)wnext=__hip_atomic_fetch_add(wq,1u,__ATOMIC_RELAXED,__HIP_MEMORY_SCOPE_AGENT);
  const float*Fbh=FP+(long)(b*NHEAD+h)*SEQ;
  const int NTfull=(q0+QB)/KVBLK; int jstart;
  { typedef float f32x2_t __attribute__((ext_vector_type(2)));
    const int jt=lane<NTfull?lane:NTfull-1;
    const f32x2_t nk=*reinterpret_cast<const f32x2_t*>(NK+2*jt); const float kn=sqrtf(nk.x+nk.y)*1.02f;
    float qn2=0.f,kd=0.f;
    #pragma unroll
    for(int t=0;t<4;++t){ const f32x2_t a=*reinterpret_cast<const f32x2_t*>(NQ+2*(4*qb+t)); qn2=fmaxf(qn2,a.x+a.y); kd=fmaxf(kd,__uint_as_float(__builtin_amdgcn_readlane(__float_as_uint(kn),4*qb+t))); }
    const float qn=sqrtf(qn2)*1.02f, lbv=-qn*kd, bias=Fbh[q0]-Fbh[64*jt+63];
    const bool need=(lane<NTfull)&&((lane>=NTfull-4)||!(qn*kn+bias<lbv-40.f));
    const unsigned long long bal=__ballot(need);
    jstart=bal?(__ffsll((long long)bal)-1):0; jstart=__builtin_amdgcn_readfirstlane(jstart)&~1; }
  if(tid==0)*wslot=wnext;
  const bf16*Kh=K+(long)h*HSTR+(rowbase+(long)jstart*KVBLK)*D,*Vh=V+(long)h*HSTR+(rowbase+(long)jstart*KVBLK)*D;
  const lds_cptr shm3=(lds_cptr)shm;
  const unsigned lds0=(unsigned)(uintptr_t)shm;
  float*wsf=(float*)(shm+LDS_WS)+wid*64;
  const bf16*ksrc=Kh+(long)lane*D+wid*8;
  const bf16*vsrc=Vh+(long)(16*(wid&3)+(lane>>2))*D+(wid>>2)*32+(lane&3)*8;
  const unsigned kdst=lds0+LDS_K+wid*1024, vdst=lds0+LDS_V+wid*1024;
  #define DMA_K(t,slot) glds16(ksrc+(long)(t)*KVBLK*D,(unsigned)__builtin_amdgcn_readfirstlane(kdst+(slot)))
  #define DMA_V(t,slot) glds16(vsrc+(long)(t)*KVBLK*D,(unsigned)__builtin_amdgcn_readfirstlane(vdst+(slot)))
  const int vb0=(int)(lds0+LDS_V)+((lane>>4)&1)*32+(lane&3)*8+(4*hi+((lane&15)>>2))*64;
  const char*Kbase=shm+LDS_K; bf16x8 kf[8];
  const lds_cptr kp0=shm3+LDS_K+hi*1024+r32*16; const lds_cptr vp0=shm3+LDS_V+((lane>>4)&1)*32+(lane&3)*8+(4*hi+((lane&15)>>2))*64;
  const int NT=NTfull-jstart;
  DMA_K(0,0);DMA_V(0,0);DMA_K(1,SLOTB);
  { typedef float f32x4_t __attribute__((ext_vector_type(4))); __attribute__((address_space(3))) f32x4_t*fdst=(__attribute__((address_space(3))) f32x4_t*)(shm3+LDS_FK);
    for(int i=tid;i<NT*(KVBLK/4);i+=NW*64)fdst[i]=*reinterpret_cast<const f32x4_t*>(Fbh+jstart*KVBLK+4*i); }
  const float fq=Fbh[q0+wid*QBLK+r32];
  const __attribute__((address_space(3))) float*fk3=(const __attribute__((address_space(3))) float*)(shm3+LDS_FK)+4*hi;
  #define FINIT(P0,P1,t) do{ typedef float f32x4_t __attribute__((ext_vector_type(4))); const __attribute__((address_space(3))) float*fk_=fk3+(t)*KVBLK; \
    _Pragma("unroll") for(int g_=0;g_<4;++g_){ const f32x4_t a_=*(const __attribute__((address_space(3))) f32x4_t*)(fk_+8*g_), b_=*(const __attribute__((address_space(3))) f32x4_t*)(fk_+32+8*g_); \
      _Pragma("unroll") for(int j_=0;j_<4;++j_){ P0[4*g_+j_]=tq-a_[j_]; P1[4*g_+j_]=tq-b_[j_]; } } }while(0)
  bf16x8 qr[4];
  #pragma unroll
  for(int d0=0;d0<4;++d0)qr[d0]=*reinterpret_cast<const bf16x8*>(&Qw[(long)r32*D+d0*16+hi*8]);
  float l_reg=0.f;f32x16 o[2];o[0]=f32x16{};o[1]=f32x16{};float tq=fq;
  const int qrel=wid*QBLK+r32;
  #define CMASK(P0,P1,t) do{int jb_=(t)-(NT-4); if(jb_>=0)cmask(P0,P1,jb_,qrel,hi);}while(0)
  bool resc=false;
  #define START(P0,P1) do{ const float rm=rowmax(P0,P1); resc=false; \
    { const float dl=rm; \
      _Pragma("unroll") for(int r=0;r<16;++r){P0[r]=fsub_s(P0[r],dl);P1[r]=fsub_s(P1[r],dl);} \
      tq=fsub_s(tq,dl); } \
    _Pragma("unroll") for(int r=0;r<16;++r)P0[r]=__builtin_amdgcn_exp2f(P0[r]); }while(0)
  #define RESC() do{ if(resc){ asm volatile("s_waitcnt lgkmcnt(0)":::"memory"); \
      _Pragma("unroll") for(int d_=0;d_<2;++d_) _Pragma("unroll") for(int r=0;r<16;++r)o[d_][r]*=wsf[crow(r,hi)]; } }while(0)
  f32x16 pA0,pA1,pB0,pB1;
  int sl_prev=0,sl_cur=0,sl_next=SLOTB;
  #define ROT() do{sl_prev=sl_cur;sl_cur=sl_next;sl_next=(sl_next==(NSLOT-1)*SLOTB)?0:sl_next+SLOTB;}while(0)
  DMA_K(2,2*SLOTB);
  WAIT_BAR(3);
  FINIT(pA0,pA1,0);
  qkt(pA0,pA1,Kbase,qr,r32,hi);asm volatile("s_nop 15\n\ts_nop 7":"+v"(pA0),"+v"(pA1));CMASK(pA0,pA1,0);
  START(pA0,pA1);
  _Pragma("unroll") for(int r=0;r<16;++r)pA1[r]=__builtin_amdgcn_exp2f(pA1[r]);
  WAIT_BAR(0);
  DMA_K(3,0);DMA_V(1,SLOTB);
  ROT();
  kload8(kf,kp0+sl_cur);
  WAIT_BAR(2);
  s16x4 vlo[8],vhi[8]; u32x4 pw0,pw1,pw2,pw3;
  #define PKW(P,B) cvtpk_s(P[B],P[B+1])
  #define PAF(k) __builtin_bit_cast(bf16x8,pw##k)
  #define VFR(i) (bf16x8){vlo[i][0],vlo[i][1],vlo[i][2],vlo[i][3],vhi[i][0],vhi[i][1],vhi[i][2],vhi[i][3]}
  #define PIN(x) asm volatile("":"+v"(x))
  #define MX3(a,b,c) __builtin_fmaxf(__builtin_fmaxf((a),(b)),(c))
  #define GAPA(MF,A0,A1,A2,A3,W0,W1,PW) do{ MF; sacc+=A0; sacc+=A1; sacc+=A2; sacc+=A3; PIN(sacc); W0; W1; PIN(PW); SBAR(); }while(0)
  #define EX(v) __builtin_amdgcn_exp2f(v)
  #define GAPB(MF,X,B) do{ MF; X[B]=EX(X[B]); X[B+1]=EX(X[B+1]); X[B+2]=EX(X[B+2]); X[B+3]=EX(X[B+3]); PIN(X); SBAR(); }while(0)
  #define VRD(i) do{ vlo[i]=vtr(vp_+(((i)>>2)*4096+((i)&3)*1024)); vhi[i]=vtr(vp_+(((i)>>2)*4096+((i)&3)*1024+512)); }while(0)
  #define KRD(G,j) do{ if(G){ kload2(kf,kp0+sl_next,j); SBAR(); } }while(0)
  #define STEP(C0,C1,P0,P1,t,GK,GV,GL) do{ SBAR(); FINIT(C0,C1,t); SBAR(); \
    const lds_cptr vp_=vp0+sl_prev; \
    VRD(0); SBAR(); float sacc=(P0[0]+P0[1]); \
    GAPA(C0=__builtin_amdgcn_mfma_f32_32x32x16_bf16(kf[0],qr[0],C0,0,0,0), P0[2],P0[3],P0[4],P0[5],     pw0[0]=PKW(P0,0), pw0[1]=PKW(P0,2), pw0); \
    VRD(4); SBAR(); GAPA(C1=__builtin_amdgcn_mfma_f32_32x32x16_bf16(kf[1],qr[0],C1,0,0,0), P0[6],P0[7],P0[8],P0[9],     pw0[2]=PKW(P0,4), pw0[3]=PKW(P0,6), pw0); \
    VRD(1); SBAR(); GAPA(C0=__builtin_amdgcn_mfma_f32_32x32x16_bf16(kf[2],qr[1],C0,0,0,0),   P0[10],P0[11],P0[12],P0[13], pw1[0]=PKW(P0,8), pw1[1]=PKW(P0,10), pw1); \
    VRD(5); SBAR(); GAPA(C1=__builtin_amdgcn_mfma_f32_32x32x16_bf16(kf[3],qr[1],C1,0,0,0),   P0[14],P0[15],P1[0],P1[1],   pw1[2]=PKW(P0,12),pw1[3]=PKW(P0,14), pw1); \
    VRD(2); SBAR(); GAPA(C0=__builtin_amdgcn_mfma_f32_32x32x16_bf16(kf[4],qr[2],C0,0,0,0),   P1[2],P1[3],P1[4],P1[5],     pw2[0]=PKW(P1,0), pw2[1]=PKW(P1,2), pw2); \
    VRD(6); SBAR(); GAPA(C1=__builtin_amdgcn_mfma_f32_32x32x16_bf16(kf[5],qr[2],C1,0,0,0),   P1[6],P1[7],P1[8],P1[9],     pw2[2]=PKW(P1,4), pw2[3]=PKW(P1,6), pw2); \
    VRD(3); SBAR(); GAPA(C0=__builtin_amdgcn_mfma_f32_32x32x16_bf16(kf[6],qr[3],C0,0,0,0),   P1[10],P1[11],P1[12],P1[13], pw3[0]=PKW(P1,8), pw3[1]=PKW(P1,10), pw3); \
    VRD(7); SBAR(); GAPA(C1=__builtin_amdgcn_mfma_f32_32x32x16_bf16(kf[7],qr[3],C1,0,0,0),   P1[14],P1[15],0.f,0.f,       pw3[2]=PKW(P1,12),pw3[3]=PKW(P1,14), pw3); \
    l_reg+=sacc; \
    if(GK){DMA_K((t)+3,sl_cur);} if(GV){DMA_V((t)+1,sl_next);} \
    CMASK(C0,C1,t); \
    { float a=MX3(C0[0],C0[1],C1[0]),b=MX3(C0[2],C0[3],C1[1]); a=MX3(a,C1[2],C1[3]); \
      _Pragma("unroll") for(int r=4;r<16;r+=4){a=MX3(a,C0[r],C0[r+1]);b=MX3(b,C0[r+2],C0[r+3]);a=MX3(a,C1[r],C1[r+1]);b=MX3(b,C1[r+2],C1[r+3]);} \
      float rm=__builtin_fmaxf(a,b); { auto rr=__builtin_amdgcn_permlane32_swap(__float_as_uint(rm),__float_as_uint(rm),false,false); rm=__builtin_fmaxf(__uint_as_float(rr[0]),__uint_as_float(rr[1])); } \
      resc=false; \
      if(__builtin_expect(__any(rm>(float)THRL),0)){ const float dl=__builtin_fmaxf(rm,0.f); \
        _Pragma("unroll") for(int r=0;r<16;++r){C0[r]-=dl;C1[r]-=dl;} \
        tq-=dl; \
        const float f=__builtin_amdgcn_exp2f(-dl); l_reg*=f; if(hi==0)wsf[r32]=f; resc=true; } } \
    SBAR(); \
    GAPB(o[0]=__builtin_amdgcn_mfma_f32_32x32x16_bf16(PAF(0),VFR(0),o[0],0,0,0), C0,0); \
    GAPB(o[1]=__builtin_amdgcn_mfma_f32_32x32x16_bf16(PAF(0),VFR(4),o[1],0,0,0), C0,4); \
    KRD(GL,0); GAPB(o[0]=__builtin_amdgcn_mfma_f32_32x32x16_bf16(PAF(1),VFR(1),o[0],0,0,0), C0,8); \
    KRD(GL,1); GAPB(o[1]=__builtin_amdgcn_mfma_f32_32x32x16_bf16(PAF(1),VFR(5),o[1],0,0,0), C0,12); \
    KRD(GL,2); GAPB(o[0]=__builtin_amdgcn_mfma_f32_32x32x16_bf16(PAF(2),VFR(2),o[0],0,0,0), C1,0); \
    KRD(GL,3); GAPB(o[1]=__builtin_amdgcn_mfma_f32_32x32x16_bf16(PAF(2),VFR(6),o[1],0,0,0), C1,4); \
    GAPB(o[0]=__builtin_amdgcn_mfma_f32_32x32x16_bf16(PAF(3),VFR(3),o[0],0,0,0), C1,8); \
    GAPB(o[1]=__builtin_amdgcn_mfma_f32_32x32x16_bf16(PAF(3),VFR(7),o[1],0,0,0), C1,12); \
    }while(0)
  int t=1;
  #undef CMASK
  #define CMASK(P0,P1,t) do{}while(0)
  for(;t+5<NT;t+=2){
    STEP(pB0,pB1,pA0,pA1,t,true,true,true);     WAIT_BAR(2); RESC(); ROT();
    STEP(pA0,pA1,pB0,pB1,t+1,true,true,true);   WAIT_BAR(2); RESC(); ROT();
  }
  #undef CMASK
  #define CMASK(P0,P1,t) do{int jb_=(t)-(NT-4); if(jb_>=0)cmask(P0,P1,jb_,qrel,hi);}while(0)
  #define ENDW(tt) do{ if((tt)+3<NT){WAIT_BAR(2);} else if((tt)+2<NT){WAIT_BAR(1);} else {WAIT_BAR(0);} }while(0)
  for(;t+1<NT;t+=2){
    STEP(pB0,pB1,pA0,pA1,t,(t+3<NT),(t+1<NT),(t+1<NT));       ENDW(t);   RESC(); ROT();
    STEP(pA0,pA1,pB0,pB1,t+1,(t+4<NT),(t+2<NT),(t+2<NT));     ENDW(t+1); RESC(); ROT();
  }
  STEP(pB0,pB1,pA0,pA1,NT-1,false,false,false); RESC();
  { float sacc=pB0[0]+pB0[1]; _Pragma("unroll") for(int r=2;r<16;++r)sacc+=pB0[r]; _Pragma("unroll") for(int r=0;r<16;++r)sacc+=pB1[r]; l_reg+=sacc;
    pw0=(u32x4){PKW(pB0,0),PKW(pB0,2),PKW(pB0,4),PKW(pB0,6)};pw1=(u32x4){PKW(pB0,8),PKW(pB0,10),PKW(pB0,12),PKW(pB0,14)};pw2=(u32x4){PKW(pB1,0),PKW(pB1,2),PKW(pB1,4),PKW(pB1,6)};pw3=(u32x4){PKW(pB1,8),PKW(pB1,10),PKW(pB1,12),PKW(pB1,14)};
    SBAR(); pv(o,vb0+sl_cur,PAF(0),PAF(1),PAF(2),PAF(3)); }
  #undef PKW
  #undef PAF
  #undef VFR
  #undef PIN
  #undef MX3
  #undef GAPA
  #undef GAPB
  #undef EX
  #undef VRD
  #undef KRD
  #undef STEP
  #undef ENDW
  {auto rr=__builtin_amdgcn_permlane32_swap(__float_as_uint(l_reg),__float_as_uint(l_reg),false,false);l_reg=__uint_as_float(rr[0])+__uint_as_float(rr[1]);}
  if(hi==0)wsf[32+r32]=l_reg;asm volatile("s_waitcnt lgkmcnt(0)":::"memory");
  float rli[16];
  #pragma unroll
  for(int r=0;r<16;++r)rli[r]=__builtin_amdgcn_rcpf(wsf[32+crow(r,hi)]);
  bf16*Ow=O+(rowbase+q0+wid*QBLK)*DM+h*D;
  { bf16*stg=(bf16*)(shm+LDS_OST)+wid*2048;
    #pragma unroll
    for(int r=0;r<16;++r){const int orow=crow(r,hi);
      #pragma unroll
      for(int d0=0;d0<2;++d0)stg[orow*64+d0*32+r32]=__float2bfloat16(o[d0][r]*rli[r]);}
    asm volatile("s_waitcnt lgkmcnt(0)":::"memory");
    #pragma unroll
    for(int i=0;i<4;++i){const int row=i*8+(lane>>3),ch=lane&7; const u32x4 v=*(const u32x4*)(stg+row*64+ch*8); ATTN_STORE16(Ow+(long)row*DM+ch*8,v);} }
  asm volatile("s_waitcnt lgkmcnt(0)\n\ts_barrier":::"memory");
  #undef FINIT
  #undef DMA_K
  #undef DMA_V
  #undef CMASK
  #undef START
  #undef RESC
  #undef ROT
}
constexpr int ATTN_LDS_BYTES=LDS_BYTES;
#undef SBAR
#undef WAIT_BAR
}
#define GAS __attribute__((address_space(1)))
#define LAS __attribute__((address_space(3)))
typedef unsigned short bf16;
typedef unsigned v4u __attribute__((ext_vector_type(4)));
typedef float f32x4 __attribute__((ext_vector_type(4)));
typedef short bf16x8 __attribute__((ext_vector_type(8)));
typedef GAS unsigned gu32;
typedef GAS unsigned long long gu64;
#define RLX_AGENT __ATOMIC_RELAXED, __HIP_MEMORY_SCOPE_AGENT
#define LDS_WAIT() asm volatile("s_waitcnt lgkmcnt(0)" ::: "memory")
#define VM_WAIT() asm volatile("s_waitcnt vmcnt(0)" ::: "memory")
__device__ __forceinline__ unsigned long long rt() { return __builtin_amdgcn_s_memrealtime(); }
__device__ __forceinline__ unsigned f2bf(float f) { unsigned u = __builtin_bit_cast(unsigned, f); return (u + 0x7fffu + ((u >> 16) & 1u)) >> 16; }
__device__ __forceinline__ unsigned pk2(float lo, float hi) { return f2bf(lo) | (f2bf(hi) << 16); }

#define XB_TMO      128
#define XB_XCNT(j)  (256  + 64 * (j))
#define XB_XSUB(j)  (1280 + 64 * (j))
#define XB_XGEN(j)  (2304 + 64 * (j))
#define XB_TOP      3328
#define XB_TOPGEN   3392
#define XCD_BAR_WORDS 3456
#define XB_SPIN_CAP (1u << 18)

__device__ __forceinline__ unsigned xb_ld(unsigned* p)              { return __hip_atomic_load(p, __ATOMIC_RELAXED, __HIP_MEMORY_SCOPE_AGENT); }
__device__ __forceinline__ unsigned xb_add(unsigned* p, unsigned v) { return __hip_atomic_fetch_add(p, v, __ATOMIC_RELAXED, __HIP_MEMORY_SCOPE_AGENT); }
__device__ __forceinline__ unsigned xb_xcc_id() { return (unsigned)__builtin_amdgcn_s_getreg((3 << 11) | 20) & 0xFu; }
#define XB_SPIN(cond, bar) do { unsigned _sp = 0; while (cond) { __builtin_amdgcn_s_sleep(1); \
    if ((++_sp & 255u) == 0u) { if (xb_ld(&(bar)[XB_TMO])) break; if (_sp > XB_SPIN_CAP) { atomicAdd(&(bar)[XB_TMO], 1u); break; } } } } while (0)

struct XcdBarrier {
    unsigned* bar; unsigned x;
    volatile LAS unsigned* st;
};

__device__ __forceinline__ XcdBarrier xcd_barrier_post(unsigned* bar, volatile LAS unsigned* st) {
    XcdBarrier b; b.bar = bar; b.x = xb_xcc_id(); b.st = st;
    if (threadIdx.x == 0) (void)xb_add(&bar[XB_XCNT(b.x)], 1u);
    return b;
}
__device__ __forceinline__ void xcd_barrier_complete(unsigned* bar, unsigned x, unsigned& nloc, unsigned& nx) {
    const unsigned G = gridDim.x * gridDim.y * gridDim.z;
    unsigned sum, cnt, mine, sp = 0u;
    for (;;) {
        sum = 0u; cnt = 0u; mine = 0u;
#pragma unroll
        for (unsigned j = 0; j < 16; ++j) { const unsigned c = xb_ld(&bar[XB_XCNT(j)]); sum += c; cnt += (c > 0u) ? 1u : 0u; mine = (j == x) ? c : mine; }
        if (sum == G) break;
        __builtin_amdgcn_s_sleep(1);
        if ((++sp & 255u) == 0u) { if (xb_ld(&bar[XB_TMO])) break; if (sp > XB_SPIN_CAP) { atomicAdd(&bar[XB_TMO], 1u); break; } }
    }
    nloc = mine > 0u ? mine : 1u; nx = cnt > 0u ? cnt : 1u;
}

__device__ __forceinline__ void xcd_barrier(const XcdBarrier& b) {
    asm volatile("s_waitcnt vmcnt(0)" ::: "memory");
    __syncthreads();
    if (threadIdx.x == 0) {
        unsigned* bar = b.bar;
        __builtin_amdgcn_s_waitcnt(0);
        unsigned nloc = b.st[0], nx = b.st[1];
        if (nloc == 0u) { xcd_barrier_complete(bar, b.x, nloc, nx); b.st[0] = nloc; b.st[1] = nx; }
        const unsigned old = xb_add(&bar[XB_XSUB(b.x)], 1u);
        const unsigned gen = old / nloc;
        if (old + 1u == (gen + 1u) * nloc) {
            __builtin_amdgcn_fence(__ATOMIC_RELEASE, "agent");
            asm volatile("s_waitcnt vmcnt(0)" ::: "memory");
            const unsigned og = xb_add(&bar[XB_TOP], 1u);
            const unsigned tg = og / nx;
            if (og + 1u == (tg + 1u) * nx) xb_add(&bar[XB_TOPGEN], 1u);
            else XB_SPIN(xb_ld(&bar[XB_TOPGEN]) == tg, bar);
            __builtin_amdgcn_fence(__ATOMIC_ACQUIRE, "agent");
            xb_add(&bar[XB_XGEN(b.x)], 1u);
            asm volatile("s_waitcnt vmcnt(0)" ::: "memory");
        } else {
            XB_SPIN(xb_ld(&bar[XB_XGEN(b.x)]) == gen, bar);
            __builtin_amdgcn_fence(__ATOMIC_ACQUIRE, "agent");
            asm volatile("s_waitcnt vmcnt(0)" ::: "memory");
        }
    }
    __syncthreads();
}

constexpr size_t MiB = 1u << 20;
constexpr size_t SZB = (size_t)NTOK * DM * 2;
constexpr size_t WS_CTL = 0, CTL_ZERO_BYTES = 1 * MiB;
constexpr size_t WS_MOD = 1 * MiB;
constexpr size_t WS_LB = WS_MOD + 768 * 1024;
constexpr size_t WS_FP = 2 * MiB;
constexpr size_t WS_LS = 4 * MiB;
constexpr size_t WS_LIST = 6 * MiB;
constexpr size_t WS_ASGE = 10 * MiB;
constexpr size_t WS_ASGW = 10 * MiB + 512 * 1024;
constexpr size_t WS_WRT = 11 * MiB;
constexpr size_t WS_WAFT = 11 * MiB + 512 * 1024;
constexpr size_t WS_WIN = 12 * MiB;
constexpr size_t WS_WBR = WS_WIN + 72 * MiB;
constexpr size_t WS_WOUT = WS_WBR + 16 * MiB;
constexpr size_t WS_WGU = WS_WOUT + 8 * MiB;
constexpr size_t WS_WD = WS_WGU + 512 * MiB;
constexpr size_t WS_X1 = WS_WD + 256 * MiB;
constexpr size_t WS_HB = WS_X1 + 128 * MiB;
constexpr size_t WS_PROJ = WS_HB + 64 * MiB;
constexpr size_t WS_LF = WS_PROJ + 576 * MiB;
constexpr size_t WS_OAB = WS_LF + 128 * MiB;
constexpr size_t WS_HST = WS_OAB + 128 * MiB;
constexpr size_t WS_HTD = WS_HST + 12 * MiB;
constexpr size_t WS_EB = WS_HTD + 1 * MiB;
constexpr size_t WS_END = WS_EB + 6 * MiB;
constexpr size_t WS_Y = WS_PROJ;
constexpr size_t WS_MG = WS_PROJ + 2 * SZB;
constexpr int MOE_TILES_MAX = 544;
constexpr size_t WS_ACT = WS_PROJ;
constexpr size_t WS_YR = WS_PROJ + 272 * MiB;
static_assert(WS_YR + 272 * MiB <= WS_LF, "MoE buffers fit over the projection buffers");
static_assert(WS_END <= (size_t)2048 * MiB, "workspace map fits in 2 GiB");
constexpr int CW_BAR = 4096;
constexpr int CW_WQ = 8192;
constexpr int CW_NRM = 131072;
constexpr int CW_CNT = 16384;

constexpr int RING_OFF = 0, RING_BYTES = 131072;
constexpr int SPITCH = 1032;
constexpr int SCR_WAVE = 16640;
constexpr int TAB_OFF = 139264;
constexpr int T_MISC = TAB_OFF;
constexpr int T_TBASE = TAB_OFF + 256;
constexpr int T_CNT = TAB_OFF + 512;
constexpr int T_LCNT = TAB_OFF + 640;
constexpr int T_GBASE = TAB_OFF + 768;
constexpr int T_RT2E = TAB_OFF + 1024;
constexpr int T_ASG = TAB_OFF + 2048;
constexpr int PART_OFF = 147456;
constexpr int LDS_BYTES = 163840;
static_assert(8 * SCR_WAVE <= TAB_OFF && 8 * 4 * SPITCH * 4 <= TAB_OFF && T_ASG + 8 * 512 <= PART_OFF && PART_OFF + 16384 <= LDS_BYTES, "LDS map");

typedef float f32x2 __attribute__((ext_vector_type(2)));
typedef unsigned u32x2 __attribute__((ext_vector_type(2)));
typedef float f32x16 __attribute__((ext_vector_type(16)));
typedef short v4i16_t __attribute__((ext_vector_type(4)));
#define LDS_BARRIER() do { asm volatile("s_waitcnt lgkmcnt(0)" ::: "memory"); __builtin_amdgcn_s_barrier(); asm volatile("" ::: "memory"); } while (0)

__device__ __forceinline__ float wave_sum(float v) { return pg8::rows4_sum(pg8::row16_sum(v)); }
__device__ __forceinline__ void pair32(float& v, int& i) { auto a = __builtin_amdgcn_permlane32_swap(__float_as_uint(v), __float_as_uint(v), false, false); auto b = __builtin_amdgcn_permlane32_swap((unsigned)i, (unsigned)i, false, false);
    const float v0 = __uint_as_float(a[0]), v1 = __uint_as_float(a[1]); const int i0 = (int)b[0], i1 = (int)b[1]; const bool t = v1 > v0 || (v1 == v0 && i1 < i0); v = t ? v1 : v0; i = t ? i1 : i0; }
__device__ __forceinline__ void pair16(float& v, int& i) { auto a = __builtin_amdgcn_permlane16_swap(__float_as_uint(v), __float_as_uint(v), false, false); auto b = __builtin_amdgcn_permlane16_swap((unsigned)i, (unsigned)i, false, false);
    const float v0 = __uint_as_float(a[0]), v1 = __uint_as_float(a[1]); const int i0 = (int)b[0], i1 = (int)b[1]; const bool t = v1 > v0 || (v1 == v0 && i1 < i0); v = t ? v1 : v0; i = t ? i1 : i0; }
__device__ __forceinline__ unsigned pkbf(float lo, float hi) { return pg8::cvt_pk_bf16(lo, hi); }

struct TpRegs { f32x4 v[16]; };
__device__ __forceinline__ void tp_load(TpRegs& t, const float* __restrict__ src, int ld, int lane) {
#pragma unroll
    for (int i = 0; i < 16; ++i) { const int kk = 4 * i + (lane >> 4), nn = 4 * (lane & 15); t.v[i] = __builtin_nontemporal_load((const GAS f32x4*)(src + (size_t)kk * ld + nn)); }
}
__device__ __forceinline__ void tp_store(const TpRegs& t, bf16* __restrict__ dst, LAS float* scr, int lane) {
#pragma unroll
    for (int i = 0; i < 16; ++i) { const int kk = 4 * i + (lane >> 4), nn = 4 * (lane & 15);
        scr[(nn + 0) * 65 + kk] = t.v[i].x; scr[(nn + 1) * 65 + kk] = t.v[i].y; scr[(nn + 2) * 65 + kk] = t.v[i].z; scr[(nn + 3) * 65 + kk] = t.v[i].w; }
    LDS_WAIT(); asm volatile("" ::: "memory");
    const int kc = lane & 7;
#pragma unroll
    for (int i2 = 0; i2 < 8; ++i2) { const int n = (lane >> 3) + 8 * i2; const LAS float* s = scr + n * 65 + 8 * kc;
        v4u o; o.x = pkbf(s[0], s[1]); o.y = pkbf(s[2], s[3]); o.z = pkbf(s[4], s[5]); o.w = pkbf(s[6], s[7]);
        __builtin_nontemporal_store(o, (GAS v4u*)(dst + (size_t)n * DM + 8 * kc)); }
    LDS_WAIT(); asm volatile("" ::: "memory");
}
struct TpItem { const float* src; int ld; bf16* dst; };

struct Ptrs {
    const float *x, *c, *w_in, *fox_f_bias, *hg_lb_logits, *hg_norm_w, *w_branch, *w_out, *ada_w, *ada_b, *ln1_g, *ln1_b, *w_router, *b_router,
                *w_gate, *b_gate, *w_up, *b_up, *w_down, *b_down, *ln2_g, *ln2_b;
    float* out; unsigned char* ws;
};

__device__ __forceinline__ void p0_prologue(const Ptrs& P, LAS unsigned char* lds, int G, const int wv) {
    int tid_ = wv * 64 + (int)__builtin_amdgcn_mbcnt_hi(~0u, __builtin_amdgcn_mbcnt_lo(~0u, 0u)); asm volatile("" : "+v"(tid_)); const int tid = tid_, lane = tid & 63, wave = __builtin_amdgcn_readfirstlane(tid >> 6);
    unsigned char* ws = P.ws;
    {
        LAS float* cact = (LAS float*)(lds);
        LAS float* part = (LAS float*)(lds + 32768);
        for (int idx = tid; idx < NB * DM; idx += 512) { const int b = idx >> 10, k = idx & 1023; const float v = P.c[idx]; cact[k * 8 + b] = v / (1.0f + __expf(-v)); }
        __syncthreads();
        float* MOD = (float*)(ws + WS_MOD);
        for (int u = blockIdx.x; u < NLAYER * 96; u += G) {
            const int l = u / 96, cc = u % 96, col = cc * 64 + lane;
            const float* wp = P.ada_w + ((size_t)l * DM + wave * 128) * 6144 + col;
            float acc[8];
#pragma unroll
            for (int b = 0; b < 8; ++b) acc[b] = 0.f;
#pragma unroll 8
            for (int k = 0; k < 128; ++k) { const float wv = wp[(size_t)k * 6144]; const f32x4 c0 = *(const LAS f32x4*)(cact + (wave * 128 + k) * 8), c1 = *(const LAS f32x4*)(cact + (wave * 128 + k) * 8 + 4);
                acc[0] += c0.x * wv; acc[1] += c0.y * wv; acc[2] += c0.z * wv; acc[3] += c0.w * wv; acc[4] += c1.x * wv; acc[5] += c1.y * wv; acc[6] += c1.z * wv; acc[7] += c1.w * wv; }
#pragma unroll
            for (int b = 0; b < 8; ++b) part[(wave * 8 + b) * 64 + lane] = acc[b];
            __syncthreads();
            { const int b = tid >> 6; float s = 0.f;
#pragma unroll
              for (int w = 0; w < 8; ++w) s += part[(w * 8 + b) * 64 + lane];
              MOD[((size_t)l * NB + b) * 6144 + col] = s + P.ada_b[(size_t)l * 6144 + col]; }
            __syncthreads();
        }
    }
    if (blockIdx.x == G - 1) {
        float* LB = (float*)(ws + WS_LB);
        for (int d = tid; d < DM; d += 512) {
            const float a0 = P.hg_lb_logits[d], a1 = P.hg_lb_logits[DM + d], a2 = P.hg_lb_logits[2 * DM + d], a3 = P.hg_lb_logits[3 * DM + d];
            const float mx = fmaxf(fmaxf(a0, a1), fmaxf(a2, a3));
            const float e0 = expf(a0 - mx), e1 = expf(a1 - mx), e2 = expf(a2 - mx), e3 = expf(a3 - mx), inv = 1.0f / (e0 + e1 + e2 + e3);
            const float p1 = e1 * inv, p2 = e2 * inv, p3 = e3 * inv;
            LB[d] = 0.f; LB[DM + d] = fminf(fmaxf(p1, 0.f), 1.f); LB[2 * DM + d] = fminf(fmaxf(p1 + p2, 0.f), 1.f); LB[3 * DM + d] = fminf(fmaxf(p1 + p2 + p3, 0.f), 1.f);
        }
    }
    {
        bf16* WRT = (bf16*)(ws + WS_WRT); bf16* WAFT = (bf16*)(ws + WS_WAFT);
        for (int idx = blockIdx.x * 512 + tid; idx < NLAYER * (NEXP + 16) * DM; idx += G * 512) {
            const int l = idx / ((NEXP + 16) * DM), r = idx % ((NEXP + 16) * DM), n = r / DM, k = r % DM;
            const float w = n < NEXP ? P.w_router[((size_t)l * DM + k) * NEXP + n] : P.w_in[((size_t)l * DM + k) * PIN + 7168 + (n - NEXP)];
            const unsigned hb = f2bf(w); const float hf = __uint_as_float(hb << 16); const unsigned lb_ = f2bf(w - hf);
            if (n < NEXP) { WRT[(((size_t)l * 2 + 0) * NEXP + n) * DM + k] = (bf16)hb; WRT[(((size_t)l * 2 + 1) * NEXP + n) * DM + k] = (bf16)lb_; }
            else { WAFT[(((size_t)l * 2 + 0) * 16 + (n - NEXP)) * DM + k] = (bf16)hb; WAFT[(((size_t)l * 2 + 1) * 16 + (n - NEXP)) * DM + k] = (bf16)lb_; }
        }
    }
    __syncthreads();
    {
        LAS float* scr = (LAS float*)(lds + wave * SCR_WAVE);
        const int gw = blockIdx.x * 8 + wave, NGW = G * 8;
        constexpr int I_IN1 = 16 * 112, I_IN2 = 16 * 32, I_BR = 2 * 256, I_OUT = 256, I_EXP = 768, I_MOE = NEXP * I_EXP;
        constexpr int I_LAYER = I_IN1 + I_IN2 + I_BR + I_OUT + I_MOE, I_ALL = NLAYER * I_LAYER;
        auto decode = [&](int it) -> TpItem {
            const int l = it / I_LAYER; int r = it % I_LAYER; TpItem t;
            if (r < I_IN1) { const int kb = r / 112, nb = r % 112;
                const int n0 = nb * 64, drow = n0 < 1024 ? 256 * (n0 >> 7) + (n0 & 127) : (n0 < 2048 ? 256 * ((n0 - 1024) >> 7) + 128 + (n0 & 127) : n0);
                t.src = P.w_in + ((size_t)l * DM + kb * 64) * PIN + n0; t.ld = PIN; t.dst = (bf16*)(ws + WS_WIN) + ((size_t)l * NPROJ + drow) * DM + kb * 64; return t; }
            r -= I_IN1;
            if (r < I_IN2) { const int kb = r / 32, nb = r % 32;
                t.src = P.w_in + ((size_t)l * DM + kb * 64) * PIN + 7184 + nb * 64; t.ld = PIN; t.dst = (bf16*)(ws + WS_WIN) + ((size_t)l * NPROJ + 7168 + nb * 64) * DM + kb * 64; return t; }
            r -= I_IN2;
            if (r < I_BR) { const int half = r / 256, q = r % 256, kb = q / 16, nb = q % 16;
                t.src = P.w_branch + ((size_t)l * 2048 + half * 1024 + kb * 64) * DM + nb * 64; t.ld = DM; t.dst = (bf16*)(ws + WS_WBR) + (((size_t)l * 2 + half) * DM + nb * 64) * DM + kb * 64; return t; }
            r -= I_BR;
            if (r < I_OUT) { const int kb = r / 16, nb = r % 16;
                t.src = P.w_out + ((size_t)l * DM + kb * 64) * DM + nb * 64; t.ld = DM; t.dst = (bf16*)(ws + WS_WOUT) + ((size_t)l * DM + nb * 64) * DM + kb * 64; return t; }
            r -= I_OUT;
            const int e = r / I_EXP, q = r % I_EXP, which = q / 256, q2 = q % 256, kb = q2 / 16, nb = q2 % 16;
            const size_t le = (size_t)l * NEXP + e; t.ld = DM;
            if (which == 0) { t.src = P.w_gate + (le * DM + kb * 64) * DM + nb * 64; t.dst = (bf16*)(ws + WS_WGU) + (le * 2048 + 256 * (nb >> 1) + 64 * (nb & 1)) * DM + kb * 64; }
            else if (which == 1) { t.src = P.w_up + (le * DM + kb * 64) * DM + nb * 64; t.dst = (bf16*)(ws + WS_WGU) + (le * 2048 + 256 * (nb >> 1) + 128 + 64 * (nb & 1)) * DM + kb * 64; }
            else { t.src = P.w_down + (le * DM + kb * 64) * DM + nb * 64; t.dst = (bf16*)(ws + WS_WD) + (le * DM + nb * 64) * DM + kb * 64; }
            return t;
        };
        TpRegs cur, nxt; TpItem ci, ni;
        int it = gw;
        if (it < I_ALL) { ci = decode(it); tp_load(cur, ci.src, ci.ld, lane); }
        for (; it < I_ALL; it += NGW) {
            const bool more = it + NGW < I_ALL;
            if (more) { ni = decode(it + NGW); tp_load(nxt, ni.src, ni.ld, lane); }
            tp_store(cur, ci.dst, scr, lane);
            if (more) { cur = nxt; ci = ni; }
        }
    }
    __syncthreads();
}

struct RowV { f32x4 v[4]; };
__device__ __forceinline__ RowV ld_row(const float* p, int lane) { RowV r; const GAS f32x4* q = (const GAS f32x4*)p + lane;
#pragma unroll
    for (int j = 0; j < 4; ++j) r.v[j] = q[64 * j];
    return r; }
struct RowB { u32x2 v[4]; };
__device__ __forceinline__ RowB ld_row_bf16(const bf16* p, int lane) { RowB r; const GAS u32x2* q = (const GAS u32x2*)p + lane;
#pragma unroll
    for (int j = 0; j < 4; ++j) r.v[j] = q[64 * j];
    return r; }
__device__ __forceinline__ RowV row_b2f(const RowB& b) { RowV r;
#pragma unroll
    for (int j = 0; j < 4; ++j) r.v[j] = (f32x4){pg8::bf_lo(b.v[j].x), pg8::bf_hi(b.v[j].x), pg8::bf_lo(b.v[j].y), pg8::bf_hi(b.v[j].y)};
    return r; }
__device__ __forceinline__ void st_row(float* p, int lane, const RowV& r) { GAS f32x4* q = (GAS f32x4*)p + lane;
#pragma unroll
    for (int j = 0; j < 4; ++j) q[64 * j] = r.v[j]; }
__device__ __forceinline__ void st_row_bf16(bf16* p, int lane, const RowV& r) { GAS u32x2* q = (GAS u32x2*)p + lane;
#pragma unroll
    for (int j = 0; j < 4; ++j) { u32x2 w; w.x = pkbf(r.v[j].x, r.v[j].y); w.y = pkbf(r.v[j].z, r.v[j].w); q[64 * j] = w; } }
__device__ __forceinline__ void st_row_lds(LAS float* p, int lane, const RowV& r) { LAS f32x4* q = (LAS f32x4*)p + lane;
#pragma unroll
    for (int j = 0; j < 4; ++j) q[64 * j] = r.v[j]; }
__device__ __forceinline__ void ln_stats(const RowV& r, float& mean, float& rstd, float eps) {
    float s = 0.f;
#pragma unroll
    for (int j = 0; j < 4; ++j) s += (r.v[j].x + r.v[j].y) + (r.v[j].z + r.v[j].w);
    mean = wave_sum(s) * (1.0f / DM); float q = 0.f;
#pragma unroll
    for (int j = 0; j < 4; ++j) { const f32x4 d = r.v[j] - mean; q += (d.x * d.x + d.y * d.y) + (d.z * d.z + d.w * d.w); }
    rstd = 1.0f / sqrtf(wave_sum(q) * (1.0f / DM) + eps);
}
__device__ __forceinline__ float log_sigmoid(float x) { return fminf(x, 0.f) - log1pf(expf(-fabsf(x))); }
template <int NT>
__device__ __forceinline__ void dots_partial(const LAS float* stage0, const bf16* __restrict__ whi, const bf16* __restrict__ wlo, LAS f32x4* part, int wave, int lane) {
    const int rt = wave & 1, kq = wave >> 1, fr = lane & 15, fq = lane >> 4; const LAS float* hp = stage0 + (16 * rt + fr) * SPITCH + 256 * kq + 8 * fq;
    f32x4 acc[NT];
#pragma unroll
    for (int t = 0; t < NT; ++t) acc[t] = (f32x4){0.f, 0.f, 0.f, 0.f};
    const bf16* wh = whi + (size_t)fr * DM + 256 * kq + 8 * fq; const bf16* wl = wlo + (size_t)fr * DM + 256 * kq + 8 * fq;
#pragma unroll
    for (int s = 0; s < 8; ++s) {
        const f32x4 h0 = *(const LAS f32x4*)(hp + 32 * s), h1 = *(const LAS f32x4*)(hp + 32 * s + 4);
        v4u hi; hi.x = pkbf(h0.x, h0.y); hi.y = pkbf(h0.z, h0.w); hi.z = pkbf(h1.x, h1.y); hi.w = pkbf(h1.z, h1.w);
        v4u lo; lo.x = pkbf(h0.x - pg8::bf_lo(hi.x), h0.y - pg8::bf_hi(hi.x)); lo.y = pkbf(h0.z - pg8::bf_lo(hi.y), h0.w - pg8::bf_hi(hi.y));
        lo.z = pkbf(h1.x - pg8::bf_lo(hi.z), h1.y - pg8::bf_hi(hi.z)); lo.w = pkbf(h1.z - pg8::bf_lo(hi.w), h1.w - pg8::bf_hi(hi.w));
        const bf16x8 hhi = __builtin_bit_cast(bf16x8, hi), hlo = __builtin_bit_cast(bf16x8, lo);
#pragma unroll
        for (int t = 0; t < NT; ++t) {
            const bf16x8 a_hi = *(const GAS bf16x8*)(wh + (size_t)t * 16 * DM + 32 * s), a_lo = *(const GAS bf16x8*)(wl + (size_t)t * 16 * DM + 32 * s);
            acc[t] = __builtin_amdgcn_mfma_f32_16x16x32_bf16(a_hi, hhi, acc[t], 0, 0, 0);
            acc[t] = __builtin_amdgcn_mfma_f32_16x16x32_bf16(a_hi, hlo, acc[t], 0, 0, 0);
            acc[t] = __builtin_amdgcn_mfma_f32_16x16x32_bf16(a_lo, hhi, acc[t], 0, 0, 0);
        }
    }
#pragma unroll
    for (int t = 0; t < NT; ++t) part[((kq * 2 + rt) * NT + t) * 64 + lane] = acc[t];
}
template <int NT>
__device__ __forceinline__ void dots_final(const LAS f32x4* part, f32x4 (&out)[NT], int rt, int lane) {
#pragma unroll
    for (int t = 0; t < NT; ++t) { f32x4 a = part[((0 * 2 + rt) * NT + t) * 64 + lane];
#pragma unroll
        for (int kq = 1; kq < 4; ++kq) a += part[((kq * 2 + rt) * NT + t) * 64 + lane];
        out[t] = a; }
}
__device__ __forceinline__ int staged_tok(int j, int it, int RPW) { return (blockIdx.x * 8 + (j >> 2)) * RPW + 4 * it + (j & 3); }
__device__ __forceinline__ void af_block(LAS unsigned char* lds, const bf16* __restrict__ waft, const float* __restrict__ fbias, float* LS, int it, int RPW, int wave, int lane) {
    LAS f32x4* part = (LAS f32x4*)(lds + PART_OFF);
    dots_partial<1>((const LAS float*)lds, waft, waft + 16 * DM, part, wave, lane);
    LDS_BARRIER();
    if (wave < 2) { f32x4 acc[1]; dots_final<1>(part, acc, wave, lane);
        const int fr = lane & 15, fq = lane >> 4; const f32x4 bv = *(const GAS f32x4*)(fbias + 4 * fq);
        *(GAS f32x4*)(LS + (size_t)staged_tok(16 * wave + fr, it, RPW) * 16 + 4 * fq) = (f32x4){log_sigmoid(acc[0].x + bv.x), log_sigmoid(acc[0].y + bv.y), log_sigmoid(acc[0].z + bv.z), log_sigmoid(acc[0].w + bv.w)}; }
}

__device__ __forceinline__ void phase_a0(const Ptrs& P, LAS unsigned char* lds, int G, const int wv) {
    int tid_ = wv * 64 + (int)__builtin_amdgcn_mbcnt_hi(~0u, __builtin_amdgcn_mbcnt_lo(~0u, 0u)); asm volatile("" : "+v"(tid_)); const int tid = tid_, lane = tid & 63, wave = __builtin_amdgcn_readfirstlane(tid >> 6); (void)tid;
    unsigned char* ws = P.ws; const int RPW = NTOK / (G * 8); const int m0 = (blockIdx.x * 8 + wave) * RPW, b = m0 / SEQL;
    const float* MOD = (const float*)(ws + WS_MOD) + (size_t)(0 * NB + b) * 6144;
    const RowV sh1 = ld_row(MOD, lane), sc1 = ld_row(MOD + DM, lane);
    LAS float* stage = (LAS float*)(lds + wave * (4 * SPITCH * 4));
    RowV xnext = ld_row(P.x + (size_t)m0 * DM, lane);
    for (int rg = 0; rg < RPW / 4; ++rg) {
        for (int r = 0; r < 4; ++r) { const int m = m0 + rg * 4 + r; RowV xv = xnext;
            if (rg * 4 + r + 1 < RPW) xnext = ld_row(P.x + (size_t)(m + 1) * DM, lane);
#pragma unroll
            for (int j = 0; j < 4; ++j) xv.v[j] = xv.v[j] * (sc1.v[j] + 1.0f) + sh1.v[j];
            st_row_bf16((bf16*)(ws + WS_HB) + (size_t)m * DM, lane, xv); st_row_lds(stage + r * SPITCH, lane, xv); }
        LDS_BARRIER();
        af_block(lds, (const bf16*)(ws + WS_WAFT), P.fox_f_bias, (float*)(ws + WS_LS), rg, RPW, wave, lane);
        LDS_BARRIER();
    }
}

__device__ __forceinline__ void phase_f(const Ptrs& P, LAS unsigned char* lds, int l, const float* xcur, int G, const int wv, bool build_lists = true) {
    int tid_ = wv * 64 + (int)__builtin_amdgcn_mbcnt_hi(~0u, __builtin_amdgcn_mbcnt_lo(~0u, 0u)); asm volatile("" : "+v"(tid_)); const int tid = tid_, lane = tid & 63, wave = __builtin_amdgcn_readfirstlane(tid >> 6);
    unsigned char* ws = P.ws; const int RPW = NTOK / (G * 8); const int m0 = (blockIdx.x * 8 + wave) * RPW, b = m0 / SEQL;
    LAS int* lcnt = (LAS int*)(lds + T_LCNT); LAS int* gbase = (LAS int*)(lds + T_GBASE);
    LAS int* aE = (LAS int*)(lds + T_ASG); LAS float* aW = (LAS float*)(lds + T_ASG + 2048);
    if (tid < 32) lcnt[tid] = 0;
    __syncthreads();
    {
        const float* MOD = (const float*)(ws + WS_MOD) + (size_t)(l * NB + b) * 6144;
        const RowV g1 = ld_row(MOD + 2 * DM, lane), sh2 = ld_row(MOD + 3 * DM, lane), sc2 = ld_row(MOD + 4 * DM, lane);
        const RowV lng = ld_row(P.ln1_g + (size_t)l * DM, lane), lnb = ld_row(P.ln1_b + (size_t)l * DM, lane);
        LAS float* stage = (LAS float*)(lds + wave * (4 * SPITCH * 4));
        const bf16* wrt = (const bf16*)(ws + WS_WRT) + (size_t)l * 2 * NEXP * DM; const float* br = P.b_router + (size_t)l * NEXP;
        const bf16* Y = (const bf16*)(ws + WS_Y);
        RowV xnext = ld_row(xcur + (size_t)m0 * DM, lane); RowB ynext = ld_row_bf16(Y + (size_t)m0 * DM, lane);
        for (int rg = 0; rg < RPW / 4; ++rg) {
            for (int r = 0; r < 4; ++r) { const int m = m0 + rg * 4 + r;
                RowV xv = xnext; const RowV yv = row_b2f(ynext);
                if (rg * 4 + r + 1 < RPW) { xnext = ld_row(xcur + (size_t)(m + 1) * DM, lane); ynext = ld_row_bf16(Y + (size_t)(m + 1) * DM, lane); }
#pragma unroll
                for (int j = 0; j < 4; ++j) xv.v[j] = xv.v[j] * DN_ALPHA + (g1.v[j] + 1.0f) * yv.v[j];
                float mean, rstd; ln_stats(xv, mean, rstd, 1e-5f);
#pragma unroll
                for (int j = 0; j < 4; ++j) xv.v[j] = (xv.v[j] - mean) * rstd * lng.v[j] + lnb.v[j];
                st_row_bf16((bf16*)(ws + WS_X1) + (size_t)m * DM, lane, xv);
#pragma unroll
                for (int j = 0; j < 4; ++j) xv.v[j] = xv.v[j] * (sc2.v[j] + 1.0f) + sh2.v[j];
                st_row_bf16((bf16*)(ws + WS_HB) + (size_t)m * DM, lane, xv); st_row_lds(stage + r * SPITCH, lane, xv); }
            LDS_BARRIER();
            LAS f32x4* part = (LAS f32x4*)(lds + PART_OFF);
            dots_partial<2>((const LAS float*)lds, wrt, wrt + (size_t)NEXP * DM, part, wave, lane);
            LDS_BARRIER();
            if (wave < 2) {
                f32x4 lg[2]; dots_final<2>(part, lg, wave, lane);
                const int fr = lane & 15, fq = lane >> 4;
                float cv[8]; int ci[8];
                { const f32x4 b0 = *(const GAS f32x4*)(br + 4 * fq), b1 = *(const GAS f32x4*)(br + 16 + 4 * fq);
#pragma unroll
                  for (int i = 0; i < 4; ++i) { cv[i] = lg[0][i] + b0[i]; ci[i] = 4 * fq + i; cv[4 + i] = lg[1][i] + b1[i]; ci[4 + i] = 16 + 4 * fq + i; } }
                float tv[4]; int ti[4];
#pragma unroll
                for (int k = 0; k < 4; ++k) {
                    float bv = cv[0]; int bi = ci[0];
#pragma unroll
                    for (int i = 1; i < 8; ++i) if (cv[i] > bv) { bv = cv[i]; bi = ci[i]; }
                    pair16(bv, bi); pair32(bv, bi);
                    tv[k] = bv; ti[k] = bi;
#pragma unroll
                    for (int i = 0; i < 8; ++i) if (ci[i] == bi) cv[i] = -INFINITY;
                }
                const float e1 = expf(tv[1] - tv[0]), e2 = expf(tv[2] - tv[0]), e3 = expf(tv[3] - tv[0]), inv = 1.0f / (1.0f + e1 + e2 + e3);
                const int slot = rg * 128 + (16 * wave + fr) * 4;
                if (fq == 0) { aE[slot] = ti[0]; aW[slot] = inv; } else if (fq == 1) { aE[slot + 1] = ti[1]; aW[slot + 1] = e1 * inv; }
                else if (fq == 2) { aE[slot + 2] = ti[2]; aW[slot + 2] = e2 * inv; } else { aE[slot + 3] = ti[3]; aW[slot + 3] = e3 * inv; }
            }
            LDS_BARRIER();
        }
    }
    if (!build_lists) { __syncthreads(); return; }
    const int nasg = RPW * 32; int e = 0, lpos = 0; float w = 0.f;
    if (tid < nasg) { e = aE[tid]; w = aW[tid]; lpos = __hip_atomic_fetch_add(lcnt + e, 1, __ATOMIC_RELAXED, __HIP_MEMORY_SCOPE_WORKGROUP); }
    __syncthreads();
    if (tid < 32) { const int n = lcnt[tid]; gbase[tid] = n ? (int)__hip_atomic_fetch_add((unsigned*)(ws + WS_CTL) + CW_CNT + (l * NEXP + tid) * 64, (unsigned)n, __ATOMIC_RELAXED, __HIP_MEMORY_SCOPE_AGENT) : 0; }
    __syncthreads();
    if (tid < nasg) { const int pos = gbase[e] + lpos, tok = staged_tok((tid >> 2) & 31, tid >> 7, RPW);
        ((int*)(ws + WS_LIST))[(size_t)e * NTOK + pos] = tok; ((int*)(ws + WS_ASGE))[(size_t)tok * 4 + (tid & 3)] = (e << 16) | pos; ((float*)(ws + WS_ASGW))[(size_t)tok * 4 + (tid & 3)] = w; }
}

__device__ __forceinline__ int moe_tables(const Ptrs& P, LAS unsigned char* lds, int l, const int wv) {
    int tid_ = wv * 64 + (int)__builtin_amdgcn_mbcnt_hi(~0u, __builtin_amdgcn_mbcnt_lo(~0u, 0u)); asm volatile("" : "+v"(tid_)); const int tid = tid_;
    LAS int* tbase = (LAS int*)(lds + T_TBASE); LAS int* cnt = (LAS int*)(lds + T_CNT); LAS unsigned char* rt2e = (LAS unsigned char*)(lds + T_RT2E);
    __syncthreads();
    if (tid < 32) cnt[tid] = (int)__hip_atomic_load((unsigned*)(P.ws + WS_CTL) + CW_CNT + (l * NEXP + tid) * 64, __ATOMIC_RELAXED, __HIP_MEMORY_SCOPE_AGENT);
    __syncthreads();
    if (tid == 0) { int s = 0; for (int e = 0; e < NEXP; ++e) { tbase[e] = s; s += (cnt[e] + 255) >> 8; } tbase[NEXP] = s; }
    __syncthreads();
    if (tid < 32) { for (int rt = tbase[tid]; rt < tbase[tid + 1]; ++rt) rt2e[rt] = (unsigned char)tid; }
    __syncthreads();
    return tbase[NEXP];
}

__device__ __forceinline__ void phase_j(const Ptrs& P, LAS unsigned char* lds, int l, int G, const int wv) {
    int tid_ = wv * 64 + (int)__builtin_amdgcn_mbcnt_hi(~0u, __builtin_amdgcn_mbcnt_lo(~0u, 0u)); asm volatile("" : "+v"(tid_)); const int tid = tid_, lane = tid & 63, wave = __builtin_amdgcn_readfirstlane(tid >> 6); (void)tid;
    unsigned char* ws = P.ws; const int RPW = NTOK / (G * 8); const int m0 = (blockIdx.x * 8 + wave) * RPW, b = m0 / SEQL;
    const LAS int* tbase = (const LAS int*)(lds + T_TBASE);
    const float* MOD = (const float*)(ws + WS_MOD) + (size_t)(l * NB + b) * 6144;
    const RowV g2 = ld_row(MOD + 5 * DM, lane);
    const RowV lng = ld_row(P.ln2_g + (size_t)l * DM, lane), lnb = ld_row(P.ln2_b + (size_t)l * DM, lane);
    const bool more = l + 1 < NLAYER;
    RowV sh1, sc1;
    { const float* MODN = (const float*)(ws + WS_MOD) + (size_t)((more ? l + 1 : l) * NB + b) * 6144; sh1 = ld_row(MODN, lane); sc1 = ld_row(MODN + DM, lane); }
    LAS float* stage = (LAS float*)(lds + wave * (4 * SPITCH * 4));
    const bf16* YR = (const bf16*)(ws + WS_YR); const bf16* X1 = (const bf16*)(ws + WS_X1);
    const unsigned asge = ((const unsigned*)(ws + WS_ASGE))[(size_t)m0 * 4 + lane]; const float asgw = ((const float*)(ws + WS_ASGW))[(size_t)m0 * 4 + lane];
    struct JRow { u32x2 y[4][4]; RowB x; };
    auto jload = [&](int i, JRow& R) {
#pragma unroll
        for (int k = 0; k < 4; ++k) { const unsigned a = __builtin_amdgcn_readlane(asge, 4 * i + k); const int e = (int)(a >> 16), pos = (int)(a & 0xffffu); const size_t slot = (size_t)tbase[e] * 256 + pos;
            const GAS u32x2* q = (const GAS u32x2*)(YR + slot * DM) + lane;
#pragma unroll
            for (int j = 0; j < 4; ++j) R.y[k][j] = q[64 * j]; }
        R.x = ld_row_bf16(X1 + (size_t)(m0 + i) * DM, lane);
    };
    JRow rnext; jload(0, rnext);
    for (int rg = 0; rg < RPW / 4; ++rg) {
        for (int r = 0; r < 4; ++r) { const int i = rg * 4 + r, m = m0 + i;
            const JRow rc = rnext;
            if (i + 1 < RPW) jload(i + 1, rnext);
            RowV y;
#pragma unroll
            for (int j = 0; j < 4; ++j) y.v[j] = (f32x4){0.f, 0.f, 0.f, 0.f};
#pragma unroll
            for (int k = 0; k < 4; ++k) { const float wk = __uint_as_float(__builtin_amdgcn_readlane(__float_as_uint(asgw), 4 * i + k));
#pragma unroll
                for (int j = 0; j < 4; ++j) { const u32x2 t = rc.y[k][j]; y.v[j].x += wk * pg8::bf_lo(t.x); y.v[j].y += wk * pg8::bf_hi(t.x); y.v[j].z += wk * pg8::bf_lo(t.y); y.v[j].w += wk * pg8::bf_hi(t.y); } }
            RowV xv = row_b2f(rc.x);
#pragma unroll
            for (int j = 0; j < 4; ++j) xv.v[j] = xv.v[j] * DN_ALPHA + (g2.v[j] + 1.0f) * y.v[j];
            float mean, rstd; ln_stats(xv, mean, rstd, 1e-5f);
#pragma unroll
            for (int j = 0; j < 4; ++j) xv.v[j] = (xv.v[j] - mean) * rstd * lng.v[j] + lnb.v[j];
            st_row(P.out + (size_t)m * DM, lane, xv);
            if (more) {
#pragma unroll
                for (int j = 0; j < 4; ++j) xv.v[j] = xv.v[j] * (sc1.v[j] + 1.0f) + sh1.v[j];
                st_row_bf16((bf16*)(ws + WS_HB) + (size_t)m * DM, lane, xv); st_row_lds(stage + r * SPITCH, lane, xv); }
        }
        if (more) {
            LDS_BARRIER();
            af_block(lds, (const bf16*)(ws + WS_WAFT) + (size_t)(l + 1) * 2 * 16 * DM, P.fox_f_bias + (l + 1) * 16, (float*)(ws + WS_LS), rg, RPW, wave, lane);
            LDS_BARRIER();
        }
    }
}

__device__ __forceinline__ void fscan(const Ptrs& P, LAS unsigned char* lds, const int wv) {
    int tid_ = wv * 64 + (int)__builtin_amdgcn_mbcnt_hi(~0u, __builtin_amdgcn_mbcnt_lo(~0u, 0u)); asm volatile("" : "+v"(tid_)); const int tid = tid_, lane = tid & 63, wave = __builtin_amdgcn_readfirstlane(tid >> 6);
    const int bh = blockIdx.x >> 1, hf = blockIdx.x & 1, b = bh >> 4, h = bh & 15;
    const float* LS = (const float*)(P.ws + WS_LS) + ((size_t)b * SEQL + 2048 * hf + 4 * tid) * 16 + h; float* FP = (float*)(P.ws + WS_FP) + (size_t)bh * SEQL + 2048 * hf + 4 * tid;
    LAS float* wt = (LAS float*)(lds);
    float v[4], pre = 0.f;
#pragma unroll
    for (int j = 0; j < 4; ++j) v[j] = LS[j * 16];
    if (hf) { const float* L0 = (const float*)(P.ws + WS_LS) + ((size_t)b * SEQL + 4 * tid) * 16 + h; pre = (L0[0] + L0[16]) + (L0[32] + L0[48]); }
#pragma unroll
    for (int j = 1; j < 4; ++j) v[j] += v[j - 1];
    pre = wave_sum(pre);
    float inc = v[3];
    { const float rs = pg8::row16_scan(inc), rt = pg8::row16_sum(inc);
      const float r0 = __uint_as_float(__builtin_amdgcn_readlane(__float_as_uint(rt), 15)), r1 = __uint_as_float(__builtin_amdgcn_readlane(__float_as_uint(rt), 31)), r2 = __uint_as_float(__builtin_amdgcn_readlane(__float_as_uint(rt), 47));
      inc = rs + (lane >= 16 ? r0 : 0.f) + (lane >= 32 ? r1 : 0.f) + (lane >= 48 ? r2 : 0.f); }
    if (lane == 63) { wt[wave] = inc; wt[8 + wave] = pre; }
    __syncthreads();
    float off = inc - v[3];
    for (int w = 0; w < wave; ++w) off += wt[w];
    for (int w = 0; w < 8; ++w) off += wt[8 + w];
    *(GAS f32x4*)(FP) = (f32x4){(off + v[0]) * LOG2E, (off + v[1]) * LOG2E, (off + v[2]) * LOG2E, (off + v[3]) * LOG2E};
    __syncthreads();
}

namespace hg {
constexpr int L_QP = 0, L_KP = 16384, L_IV = 32768, L_SP = 49152, L_PM = 81920, L_O = 91136, L_TOT = 123904, L_EBM = 128000, L_EBL = 128512;
constexpr int PM_PITCH = 144;
static_assert(L_EBL + 512 <= RING_BYTES, "HGRN LDS map");
__device__ __forceinline__ int off_b(int row, int ch) { return 256 * row + 16 * (ch ^ (((row & 3) << 2) | ((row >> 2) & 3))); }
__device__ __forceinline__ bf16x8 row_frag(const LAS unsigned char* img, int row0, int s, int lane) { return *(const LAS bf16x8*)(img + off_b(row0 + (lane & 31), 2 * s + (lane >> 5))); }
__device__ __forceinline__ bf16x8 tr_frag(const LAS unsigned char* img, int c, int ks, int lane) {
    const int hh = lane >> 5, blk = (lane >> 4) & 1, q = (lane & 15) >> 2, p = lane & 3;
    const LAS unsigned char* a0 = img + off_b(16 * ks + 8 * hh + q, 4 * c + 2 * blk + (p >> 1)) + 8 * (p & 1);
    const LAS unsigned char* a1 = img + off_b(16 * ks + 8 * hh + 4 + q, 4 * c + 2 * blk + (p >> 1)) + 8 * (p & 1);
    const v4i16_t lo = __builtin_amdgcn_ds_read_tr16_b64_v4i16((LAS v4i16_t*)a0), hi = __builtin_amdgcn_ds_read_tr16_b64_v4i16((LAS v4i16_t*)a1);
    return (bf16x8){lo[0], lo[1], lo[2], lo[3], hi[0], hi[1], hi[2], hi[3]};
}
#define HG_MFMA(a, b, c) __builtin_amdgcn_mfma_f32_32x32x16_bf16((a), (b), (c), 0, 0, 0)

__device__ __forceinline__ void hgrn_unit(int b, int h, int seg, bool do_out, int st_slot, const bf16* __restrict__ QS, const float* __restrict__ EB, const bf16* __restrict__ KK, const bf16* __restrict__ IV, const bf16* __restrict__ SG,
                                          const float* __restrict__ nw, bf16* __restrict__ OA, float* __restrict__ HST, float* __restrict__ HTD, LAS unsigned char* lds, const int wv) {
    int tid_ = wv * 64 + (int)__builtin_amdgcn_mbcnt_hi(~0u, __builtin_amdgcn_mbcnt_lo(~0u, 0u)); asm volatile("" : "+v"(tid_));
    const int tid = tid_, lane = tid & 63, wid = __builtin_amdgcn_readfirstlane(tid >> 6);
    const int r = lane & 31, hh = lane >> 5;
    const size_t colb = (size_t)h * 128;
    const size_t hbase = (size_t)h * NTOK * 128;
    const int ct = tid >> 3, cpart = tid & 7;
    float nwv[16];
#pragma unroll
    for (int i = 0; i < 16; ++i) nwv[i] = nw[16 * cpart + i];
    f32x16 Sacc[2];
#pragma unroll
    for (int i = 0; i < 16; ++i) { Sacc[0][i] = 0.f; Sacc[1][i] = 0.f; }
    const int bh8 = b * 8 + h;
    if (do_out && seg > 0) {
        const size_t so = ((size_t)bh8 * 8 + wid) * 2 * 16 * 64 + lane; const size_t slot = (size_t)64 * 8 * 2 * 16 * 64;
        float d1[16], d2[16];
#pragma unroll
        for (int i = 0; i < 16; ++i) { const int d = 32 * (wid >> 1) + (i & 3) + 8 * (i >> 2) + 4 * hh; d1[i] = seg >= 2 ? __expf(HTD[(size_t)bh8 * 128 + d]) : 1.f; d2[i] = seg >= 3 ? __expf(HTD[(size_t)(64 + bh8) * 128 + d]) : 1.f; }
#pragma unroll
        for (int tl = 0; tl < 2; ++tl)
#pragma unroll
            for (int i = 0; i < 16; ++i) { float v = HST[so + (size_t)(tl * 16 + i) * 64];
                if (seg >= 2) v = v * d1[i] + HST[slot + so + (size_t)(tl * 16 + i) * 64];
                if (seg >= 3) v = v * d2[i] + HST[2 * slot + so + (size_t)(tl * 16 + i) * 64];
                Sacc[tl][i] = v; }
    }
    float td0 = 0.f, td1 = 0.f;
    const int cbeg = 16 * seg, cend = 16 * seg + 16;
    v4u qv[2], kv[2], ivr[2], sgr[2]; f32x2 eb0 = {0.f, 0.f}, eb1 = {0.f, 0.f}, eb2 = {0.f, 0.f};
#define HG_LOAD(c) do { const size_t rb_ = (size_t)b * SEQL + (size_t)(c) * 64; \
        _Pragma("unroll") for (int i = 0; i < 2; ++i) { const int idx_ = tid + 512 * i; const size_t o_ = hbase + rb_ * 128 + 8 * (size_t)idx_; \
            if (do_out) qv[i] = *(const GAS v4u*)(QS + o_); kv[i] = *(const GAS v4u*)(KK + o_); ivr[i] = *(const GAS v4u*)(IV + o_); } \
        if (do_out) { _Pragma("unroll") for (int i = 0; i < 2; ++i) sgr[i] = *(const GAS v4u*)(SG + hbase + (rb_ + ct) * 128 + 16 * cpart + 8 * i); } \
        if (wid == 0) { const size_t eo_ = (rb_ >> 6) * DM + colb + 2 * lane; const size_t es_ = (size_t)(NTOK / 64) * DM; \
            eb0 = *(const GAS f32x2*)(EB + eo_); eb1 = *(const GAS f32x2*)(EB + es_ + eo_); eb2 = *(const GAS f32x2*)(EB + 2 * es_ + eo_); } } while (0)
    HG_LOAD(cbeg);
    for (int c = cbeg; c < cend; ++c) {
#pragma unroll
        for (int i = 0; i < 2; ++i) { const int idx_ = tid + 512 * i, o_ = off_b(idx_ >> 4, idx_ & 15);
            *(LAS v4u*)(lds + L_KP + o_) = kv[i]; *(LAS v4u*)(lds + L_IV + o_) = ivr[i];
            if (do_out) *(LAS v4u*)(lds + L_QP + o_) = qv[i]; }
        if (wid == 0) { *(LAS f32x2*)(lds + L_EBM + 8 * lane) = eb0; *(LAS f32x2*)(lds + L_EBL + 8 * lane) = eb1; td0 += eb2.x; td1 += eb2.y; }
        const v4u sg0 = sgr[0], sg1 = sgr[1];
#ifdef HG_REP_LOAD
        if (c + 1 < cend) { HG_LOAD(c + 1); asm volatile("" ::: "memory"); }
#endif
        if (c + 1 < cend) HG_LOAD(c + 1);
        LDS_BARRIER();
        {
            const int db = wid >> 1, vb0 = 2 * (wid & 1);
            float em[16], el[16];
#pragma unroll
            for (int g = 0; g < 4; ++g) { const f32x4 a = *(const LAS f32x4*)(lds + L_EBM + (32 * db + 8 * g + 4 * hh) * 4), e2 = *(const LAS f32x4*)(lds + L_EBL + (32 * db + 8 * g + 4 * hh) * 4);
                em[4 * g] = a.x; em[4 * g + 1] = a.y; em[4 * g + 2] = a.z; em[4 * g + 3] = a.w; el[4 * g] = e2.x; el[4 * g + 1] = e2.y; el[4 * g + 2] = e2.z; el[4 * g + 3] = e2.w; }
#pragma unroll
            for (int tl = 0; tl < 2; ++tl) { const int vb = vb0 + tl;
#pragma unroll
                for (int i = 0; i < 16; ++i) Sacc[tl][i] *= em[i];
                if (do_out) {
#pragma unroll
                for (int g = 0; g < 4; ++g) { u32x2 w; w.x = pkbf(Sacc[tl][4 * g], Sacc[tl][4 * g + 1]); w.y = pkbf(Sacc[tl][4 * g + 2], Sacc[tl][4 * g + 3]);
                    *(LAS u32x2*)(lds + L_SP + off_b(32 * vb + r, 4 * db + g) + 8 * hh) = w; } } }
            if (do_out && wid < 3) {
                const int tb = wid > 0 ? 1 : 0, sb = wid > 1 ? 1 : 0;
                f32x16 sc;
#pragma unroll
                for (int i = 0; i < 16; ++i) sc[i] = 0.f;
#pragma unroll
                for (int s = 0; s < 8; ++s) { const bf16x8 a = row_frag(lds + L_KP, 32 * sb, s, lane), bq = row_frag(lds + L_QP, 32 * tb, s, lane); sc = HG_MFMA(a, bq, sc); }
                const int t = 32 * tb + r;
#pragma unroll
                for (int g = 0; g < 4; ++g) { float x[4];
#pragma unroll
                    for (int j = 0; j < 4; ++j) { const int s_ = 32 * sb + 8 * g + 4 * hh + j; x[j] = s_ <= t ? sc[4 * g + j] : 0.f; }
                    u32x2 w; w.x = pkbf(x[0], x[1]); w.y = pkbf(x[2], x[3]);
                    *(LAS u32x2*)(lds + L_PM + t * PM_PITCH + (32 * sb + 8 * g + 4 * hh) * 2) = w; }
            }
#pragma unroll
            for (int ks = 0; ks < 4; ++ks) { const bf16x8 a = tr_frag(lds + L_KP, db, ks, lane);
#pragma unroll
                for (int tl = 0; tl < 2; ++tl) { const bf16x8 bi = tr_frag(lds + L_IV, vb0 + tl, ks, lane); Sacc[tl] = HG_MFMA(a, bi, Sacc[tl]); } }
#pragma unroll
            for (int tl = 0; tl < 2; ++tl)
#pragma unroll
                for (int i = 0; i < 16; ++i) Sacc[tl][i] *= el[i];
        }
        if (!do_out) continue;
        LDS_BARRIER();
#ifndef HG_REP_B
#define HG_REP_B 1
#endif
#ifndef HG_REP_C
#define HG_REP_C 1
#endif
        for (int rb_ = 0; rb_ < HG_REP_B; ++rb_) {
            const int tb = wid >> 2, vb = wid & 3;
            f32x16 o;
#pragma unroll
            for (int i = 0; i < 16; ++i) o[i] = 0.f;
#pragma unroll
            for (int ks = 0; ks < 4; ++ks) { if (ks < 2 || tb == 1) {
                const bf16x8 a = *(const LAS bf16x8*)(lds + L_PM + (32 * tb + r) * PM_PITCH + (16 * ks + 8 * hh) * 2); const bf16x8 bi = tr_frag(lds + L_IV, vb, ks, lane); o = HG_MFMA(a, bi, o); } }
#pragma unroll
            for (int s = 0; s < 8; ++s) { const bf16x8 a = row_frag(lds + L_QP, 32 * tb, s, lane), bs = row_frag(lds + L_SP, 32 * vb, s, lane); o = HG_MFMA(a, bs, o); }
#pragma unroll
            for (int i = 0; i < 16; ++i) { const int t = 32 * tb + (i & 3) + 8 * (i >> 2) + 4 * hh; *(LAS float*)(lds + L_O + (t * 128 + 32 * vb + r) * 4) = o[i]; }
        }
        LDS_BARRIER();
        for (int rc_ = 0; rc_ < HG_REP_C; ++rc_) {
            float ov[16];
#pragma unroll
            for (int g = 0; g < 4; ++g) { const f32x4 a = *(const LAS f32x4*)(lds + L_O + (ct * 128 + 16 * cpart + 4 * g) * 4); ov[4 * g] = a.x; ov[4 * g + 1] = a.y; ov[4 * g + 2] = a.z; ov[4 * g + 3] = a.w; }
            float ss = 0.f;
#pragma unroll
            for (int i = 0; i < 16; ++i) ss += ov[i] * ov[i];
            ss += pg8::dpp_row<0xB1>(ss); ss += pg8::dpp_row<0x4E>(ss); ss += pg8::dpp_row<0x141>(ss);
            const float rstd = 1.0f / sqrtf(ss * (1.0f / 128.0f) + 1e-6f);
            const unsigned gs[8] = {sg0.x, sg0.y, sg0.z, sg0.w, sg1.x, sg1.y, sg1.z, sg1.w};
            unsigned ow[8];
#pragma unroll
            for (int i = 0; i < 8; ++i) ow[i] = pkbf(ov[2 * i] * rstd * nwv[2 * i] * pg8::bf_lo(gs[i]), ov[2 * i + 1] * rstd * nwv[2 * i + 1] * pg8::bf_hi(gs[i]));
            bf16* op = OA + ((size_t)b * SEQL + (size_t)c * 64 + ct) * DM + colb + 16 * cpart;
            *(GAS v4u*)(op) = (v4u){ow[0], ow[1], ow[2], ow[3]}; *(GAS v4u*)(op + 8) = (v4u){ow[4], ow[5], ow[6], ow[7]};
        }
    }
#undef HG_LOAD
    if (st_slot >= 0) {
        const size_t so = (size_t)st_slot * ((size_t)64 * 8 * 2 * 16 * 64) + ((size_t)bh8 * 8 + wid) * 2 * 16 * 64 + lane;
#pragma unroll
        for (int tl = 0; tl < 2; ++tl)
#pragma unroll
            for (int i = 0; i < 16; ++i) HST[so + (size_t)(tl * 16 + i) * 64] = Sacc[tl][i];
        if (st_slot >= 1 && wid == 0) *(GAS f32x2*)(HTD + ((size_t)(st_slot - 1) * 64 + bh8) * 128 + 2 * lane) = (f32x2){td0, td1};
    }
    LDS_BARRIER();
}
}

#ifndef PH_SKIP
#define PH_SKIP 0u
#endif
struct Args { Ptrs p; };
typedef __attribute__((address_space(4))) const unsigned long long* KArgWords;
__device__ __forceinline__ Ptrs opq_ptrs(KArgWords p) {
    Ptrs r;
#if defined(__HIP_DEVICE_COMPILE__)
    asm volatile("" : "+s"(p));
    unsigned long long* d = (unsigned long long*)&r;
#pragma unroll
    for (int i = 0; i < (int)(sizeof(Ptrs) / 8); ++i) d[i] = p[i];
#else
    (void)p; r = Ptrs{};
#endif
    return r;
}
__global__ void __launch_bounds__(512, 2) mk_fwd(Args args) {
    extern __shared__ __attribute__((aligned(16))) unsigned char lds_raw[];
    LAS unsigned char* lds = (LAS unsigned char*)lds_raw;
    const KArgWords Pk_ = (KArgWords)__builtin_amdgcn_kernarg_segment_ptr();
    (void)args;
#define P (opq_ptrs(Pk_))
    unsigned char* ws = P.ws;
    const int wv = __builtin_amdgcn_readfirstlane((int)threadIdx.x >> 6), G = gridDim.x;
#define tid (wv * 64 + (int)__builtin_amdgcn_mbcnt_hi(~0u, __builtin_amdgcn_mbcnt_lo(~0u, 0u)))
    volatile LAS unsigned* MISC = (volatile LAS unsigned*)(lds + T_MISC);
    gu32* ctl = (gu32*)(ws + WS_CTL);
    for (int u = tid; u < (LDS_BYTES - TAB_OFF) / 4; u += 512) ((LAS unsigned*)(lds + TAB_OFF))[u] = 0u;
    __syncthreads();
    (void)xcd_barrier_post((unsigned*)(ws + WS_CTL) + CW_BAR, MISC + 8);
#define GRID_BAR() do { XcdBarrier bar_; bar_.bar = (unsigned*)(ws + WS_CTL) + CW_BAR; bar_.x = xb_xcc_id(); bar_.st = (volatile LAS unsigned*)(lds + T_MISC) + 8; for (int rb_ = 0; rb_ < NREP(11); ++rb_) xcd_barrier(bar_); } while (0)
#define RUN(k) (((PH_SKIP >> (k)) & 1u) == 0u)
#ifndef PH_REP
#define PH_REP 0u
#endif
#define NREP(k) (1 + (int)((PH_REP >> (k)) & 1u))

    if (RUN(0)) for (int rp = 0; rp < NREP(0); ++rp) p0_prologue(P, lds, G, wv);
    GRID_BAR();
    if (RUN(1)) for (int rp = 0; rp < NREP(1); ++rp) phase_a0(P, lds, G, wv);
    GRID_BAR();

    for (int l = 0; l < NLAYER; ++l) {
        bf16* PROJ = (bf16*)(ws + WS_PROJ);
        if (RUN(2)) for (int rp = 0; rp < NREP(2); ++rp) {
            if (G == 256) fscan(P, lds, wv);
            pg8::Gemm g{(const pg8::bf16_t*)(ws + WS_HB), (const pg8::bf16_t*)(ws + WS_WIN) + (size_t)l * NPROJ * DM, NTOK, NPROJ, DM};
            pg8::StaticOrder S; S.init(NTOK, NPROJ, G, (int)blockIdx.x);
            pg8::EpiInProj E{(pg8::bf16_t*)PROJ, (float*)(ws + WS_EB), (const float*)(ws + WS_LB) + (size_t)l * DM, 0.125f * LOG2E, (unsigned*)(ws + WS_CTL) + CW_NRM + l * 2 * 128 * 128};
            pg8::gemm_phase<pg8::EpiInProj, pg8::StaticOrder, true, true, false>(lds + RING_OFF, g, S, E, wv);
        }
        GRID_BAR();
        if (RUN(3)) for (int rp = 0; rp < NREP(3); ++rp) {
            constexpr int ATT_Q1 = 1152;
            const bf16* aQ = PROJ + 4 * (size_t)NTOK * DM; const bf16* aK = PROJ + 5 * (size_t)NTOK * DM; const bf16* aV = PROJ + 6 * (size_t)NTOK * DM;
#define HG_CALL(bh_, seg_, out_, slot_) hg::hgrn_unit((bh_) >> 3, (bh_) & 7, (seg_), (out_), (slot_), PROJ + 0 * (size_t)NTOK * DM, (const float*)(ws + WS_EB), PROJ + 1 * (size_t)NTOK * DM, PROJ + 2 * (size_t)NTOK * DM, \
                PROJ + 3 * (size_t)NTOK * DM, P.hg_norm_w + (size_t)l * 128, (bf16*)(ws + WS_OAB), (float*)(ws + WS_HST), (float*)(ws + WS_HTD), lds + RING_OFF, wv)
#define AT_CALL(j_) do { const int qb_ = 15 - ((j_) & 15), bh_ = (j_) >> 4;     \
                attn_body::attn_unit<8>(bh_ >> 4, bh_ & 15, qb_, (const attn_body::bf16*)aQ, (const attn_body::bf16*)aK, (const attn_body::bf16*)aV, (attn_body::bf16*)(ws + WS_OAB + SZB), (const float*)(ws + WS_FP), \
                    (const unsigned*)(ws + WS_CTL) + CW_NRM + ((l * 2 + 0) * 128 + bh_) * 128, (const unsigned*)(ws + WS_CTL) + CW_NRM + ((l * 2 + 1) * 128 + bh_) * 128, (unsigned*)wqp_, MISC + 1 + (par_ ^= 1), (char*)lds_raw + RING_OFF, wv); } while (0)
#define WQ_WORD(word_) (ctl + CW_WQ + 64 * ((word_) * 4 + l) + 1024 * rp + 2048 * rx)
#define WQ_NEXT(word_) do { __syncthreads(); if (tid == 0) MISC[0] = __hip_atomic_fetch_add(WQ_WORD(word_), 1u, RLX_AGENT); __syncthreads(); } while (0)
            for (int rx = 0; rx < NREP(10); ++rx) for (;;) { WQ_NEXT(0); const int it = __builtin_amdgcn_readfirstlane((int)MISC[0]); if (it >= 192) break;
                if (it < 64) HG_CALL(it, 0, true, 0); else HG_CALL((it - 64) >> 1, 1 + ((it - 64) & 1), false, 1 + ((it - 64) & 1)); }
            for (int rx = 0; rx < NREP(12); ++rx) { int par_ = 0; gu32* wqp_ = WQ_WORD(1); WQ_NEXT(1); int j = __builtin_amdgcn_readfirstlane((int)MISC[0]);
              while (j < ATT_Q1) { AT_CALL(j); j = __builtin_amdgcn_readfirstlane((int)MISC[1 + par_]); } }
            GRID_BAR();
            for (int rx = 0; rx < NREP(10); ++rx) for (;;) { WQ_NEXT(2); const int it = __builtin_amdgcn_readfirstlane((int)MISC[0]); if (it >= 192) break; HG_CALL(it & 63, 1 + (it >> 6), true, -1); }
            for (int rx = 0; rx < NREP(12); ++rx) { int par_ = 0; gu32* wqp_ = WQ_WORD(3); WQ_NEXT(3); int j = __builtin_amdgcn_readfirstlane((int)MISC[0]) + ATT_Q1;
              while (j < 2048) { AT_CALL(j); j = __builtin_amdgcn_readfirstlane((int)MISC[1 + par_]) + ATT_Q1; } }
#undef HG_CALL
#undef AT_CALL
#undef WQ_NEXT
#undef WQ_WORD
        }
        GRID_BAR();
        if (RUN(4)) for (int rp = 0; rp < NREP(4); ++rp) {
            pg8::Gemm g{(const pg8::bf16_t*)(ws + WS_OAB), (const pg8::bf16_t*)(ws + WS_WBR) + (size_t)l * 2 * DM * DM, 2 * NTOK, 2 * DM, DM};
            pg8::PairOrder S; S.init(G, (int)blockIdx.x);
            pg8::EpiBranch E{(const pg8::bf16_t*)(PROJ + 7 * (size_t)NTOK * DM), (const pg8::bf16_t*)(PROJ + 8 * (size_t)NTOK * DM), (pg8::bf16_t*)(ws + WS_MG)};
            pg8::gemm_phase<pg8::EpiBranch, pg8::PairOrder, true, true, false>(lds + RING_OFF, g, S, E, wv);
        }
        GRID_BAR();
        if (RUN(5)) for (int rp = 0; rp < NREP(5); ++rp) {
            pg8::Gemm g{(const pg8::bf16_t*)(ws + WS_MG), (const pg8::bf16_t*)(ws + WS_WOUT) + (size_t)l * DM * DM, NTOK, DM, DM};
            pg8::StaticOrder S; S.init(NTOK, DM, G, (int)blockIdx.x);
            pg8::EpiBf16Plain E{(pg8::bf16_t*)(ws + WS_Y), DM};
            pg8::gemm_phase<pg8::EpiBf16Plain, pg8::StaticOrder, true, true, false>(lds + RING_OFF, g, S, E, wv);
        }
        GRID_BAR();
        if (RUN(6)) for (int rp = 0; rp < NREP(6); ++rp) phase_f(P, lds, l, l == 0 ? P.x : P.out, G, wv, rp == 0);
        GRID_BAR();
        if (RUN(7)) for (int rp = 0; rp < NREP(7); ++rp) {
            const int ntile = moe_tables(P, lds, l, wv);
            pg8::Gemm g{(const pg8::bf16_t*)(ws + WS_HB), (const pg8::bf16_t*)(ws + WS_WGU) + (size_t)l * NEXP * 2048 * DM, 0, 0, DM};
            pg8::MoeOrder S{G, (int)blockIdx.x, ntile, 8, (const LAS unsigned char*)(lds + T_RT2E), (const LAS int*)(lds + T_TBASE), (const LAS int*)(lds + T_CNT), (const int*)(ws + WS_LIST)};
            pg8::EpiMoe1 E{(pg8::bf16_t*)(ws + WS_ACT), P.b_gate + (size_t)l * NEXP * DM, P.b_up + (size_t)l * NEXP * DM};
            pg8::gemm_phase<pg8::EpiMoe1, pg8::MoeOrder, true, true, true>(lds + RING_OFF, g, S, E, wv);
        }
        GRID_BAR();
        if (RUN(8)) for (int rp = 0; rp < NREP(8); ++rp) {
            const int ntile = moe_tables(P, lds, l, wv);
            pg8::Gemm g{(const pg8::bf16_t*)(ws + WS_ACT), (const pg8::bf16_t*)(ws + WS_WD) + (size_t)l * NEXP * DM * DM, 0, 0, DM};
            pg8::MoeOrder S{G, (int)blockIdx.x, ntile, 4, (const LAS unsigned char*)(lds + T_RT2E), (const LAS int*)(lds + T_TBASE), (const LAS int*)(lds + T_CNT), (const int*)(ws + WS_LIST)};
            pg8::EpiMoe2 E{(pg8::bf16_t*)(ws + WS_YR), P.b_down + (size_t)l * NEXP * DM};
            pg8::gemm_phase<pg8::EpiMoe2, pg8::MoeOrder, true, true, false>(lds + RING_OFF, g, S, E, wv);
        }
        GRID_BAR();
        if (RUN(9)) for (int rp = 0; rp < NREP(9); ++rp) { (void)moe_tables(P, lds, l, wv); phase_j(P, lds, l, G, wv); }
        if (l + 1 < NLAYER) GRID_BAR();
    }
#undef GRID_BAR
#undef RUN
#undef tid
#undef P
#undef NREP
}

extern "C" void kernel_launch(void* const* d_in, const int* in_sizes, int n_in, void* d_out, int out_size, void* d_ws, size_t ws_size, hipStream_t stream) {
    static int grid = 0;
    if (grid == 0) {
        if (n_in != 22 || in_sizes[0] != NTOK * DM || out_size != NTOK * DM || ws_size < WS_END) {
            fprintf(stderr, "kernel_launch: built for 22 inputs, x/out of %d floats, >= %zu bytes of workspace; got n_in %d, in0 %d, out %d, ws %zu; nothing launched\n", NTOK * DM, (size_t)WS_END, n_in, n_in > 0 ? in_sizes[0] : -1, out_size, ws_size);
            grid = -1; return; }
        int dev = 0, cus = 0, per_cu = 0;
        if (hipGetDevice(&dev) != hipSuccess || hipDeviceGetAttribute(&cus, hipDeviceAttributeMultiprocessorCount, dev) != hipSuccess) { fprintf(stderr, "kernel_launch: device query failed\n"); grid = -1; return; }
        if (hipFuncSetAttribute((const void*)mk_fwd, hipFuncAttributeMaxDynamicSharedMemorySize, LDS_BYTES) != hipSuccess) { fprintf(stderr, "kernel_launch: hipFuncSetAttribute failed\n"); grid = -1; return; }
        if (hipOccupancyMaxActiveBlocksPerMultiprocessor(&per_cu, (const void*)mk_fwd, 512, LDS_BYTES) != hipSuccess || per_cu < 1) fprintf(stderr, "kernel_launch: note: occupancy query reports %d workgroups per CU\n", per_cu);
        (void)hipGetLastError();
        grid = cus;
        if (NTOK / (grid * 8) != 16 || NTOK % (grid * 8) != 0) { fprintf(stderr, "kernel_launch: %d CUs: the row-wise phases need NTOK %% (32 * CUs) == 0\n", grid); grid = -1; return; }
    }
    if (grid < 0) return;
    if (hipMemsetAsync((char*)d_ws + WS_CTL, 0, CTL_ZERO_BYTES, stream) != hipSuccess) { fprintf(stderr, "kernel_launch: hipMemsetAsync failed\n"); return; }
    Args a{};
    const float** pp = (const float**)&a.p;
    for (int i = 0; i < 22; ++i) pp[i] = (const float*)d_in[i];
    a.p.out = (float*)d_out; a.p.ws = (unsigned char*)d_ws;
    hipLaunchKernelGGL(mk_fwd, dim3(grid), dim3(512), LDS_BYTES, stream, a);
    const hipError_t le = hipPeekAtLastError();
    if (le != hipSuccess) fprintf(stderr, "kernel_launch: launch failed: %s (grid %d)\n", hipGetErrorName(le), grid);
}
```

```cpp
#include <hip/hip_runtime.h>
#include <hip/hip_bf16.h>
#include <cstdio>
#include <cstdint>
#include <cmath>

constexpr int NTOK = 32768, DM = 1024, NB = 8, SEQL = 4096, NLAYER = 4;
constexpr int NEXP = 32, TOPK = 4;
constexpr int PIN = 9232;
constexpr int NPROJ = 9216;
constexpr float DN_ALPHA = 1.6817928305074290f;
constexpr float LOG2E = 1.4426950408889634f;

namespace pg8 {
#define PG8_LAS __attribute__((address_space(3)))
typedef unsigned short bf16_t;
typedef short bf16x8 __attribute__((ext_vector_type(8)));
typedef float f32x4 __attribute__((ext_vector_type(4)));
typedef unsigned u32x4 __attribute__((ext_vector_type(4)));
constexpr int BM = 256, BK = 64, HALF = 128, HTB = HALF * BK * 2  , STAGE_BYTES = 8 * HTB, NXCD = 8, WGM = 4;

__host__ __device__ __forceinline__ int lds_byte(int r, int c) { const int st = (r >> 4) * 2 + (c >> 5), rr = r & 15, cc = c & 31, ob = rr * 64 + cc * 2; return st * 1024 + (ob ^ (((ob >> 9) & 1) << 5)); }
__host__ __device__ __forceinline__ void stage_rc(int b, int& R, int& C) { const int st = b / 1024, sb = b % 1024, swz = sb ^ (((sb >> 9) & 1) << 5); R = (st >> 1) * 16 + swz / 64; C = (st & 1) * 32 + (swz % 64) / 2; }
__host__ __device__ __forceinline__ int perm32(int rho) { const int n = rho >> 4, i = rho & 15; return 8 * (i >> 2) + 4 * n + (i & 3); }

struct Unit { int pm, pn; };
struct Gemm { const bf16_t* A; const bf16_t* Bt; int M, N, K; };

struct StaticOrder {
    int nM, nN, nwg, G, c;
    __host__ __device__ void init(int M, int N, int G_, int c_) { nM = M / BM; nN = N / BM; nwg = nM * nN; G = G_; c = c_; }
    __host__ __device__ bool map(long L, Unit& u) const {
        if (L >= nwg) return false;
        int wgid = (int)L; { const int q = nwg / NXCD, r = nwg % NXCD, xcd = wgid % NXCD, off = wgid / NXCD; wgid = (xcd < r ? xcd * (q + 1) : r * (q + 1) + (xcd - r) * q) + off; }
        const int nig = WGM * nN, gid = wgid / nig, fm = gid * WGM, gsz = (nM - fm) < WGM ? (nM - fm) : WGM;
        u.pm = fm + ((wgid % nig) % gsz); u.pn = (wgid % nig) / gsz; return true;
    }
    __host__ __device__ bool next(int i, Unit& u) const { return map((long)i * G + c, u); }
    __device__ __forceinline__ int arow(const Unit&, int) const { return 0; }
};
struct PairOrder {
    StaticOrder so;
    __device__ void init(int G_, int c_) { so.init(NTOK, DM, G_, c_); }
    __device__ bool next(int i, Unit& u) const { Unit t; if (!so.map((long)(i >> 1) * so.G + so.c, t)) return false; const int half = i & 1; u.pm = half * (NTOK / BM) + t.pm; u.pn = half * (DM / BM) + t.pn; return true; }
    __device__ __forceinline__ int arow(const Unit&, int) const { return 0; }
};
struct MoeOrder {
    int G, c, ntile, ncol;
    const PG8_LAS unsigned char* rt2e; const PG8_LAS int* tbase; const PG8_LAS int* cnt; const int* list;
    __device__ bool next(int i, Unit& u) const {
        if ((G & 7) != 0 || G < 256) { const long L = (long)i * G + c; if (L >= (long)ntile * ncol) return false; const int rt = (int)(L / ncol), pl = (int)(L % ncol); u.pm = rt; u.pn = (int)rt2e[rt] * ncol + pl; return true; }
        const int x = c & 7, k = c >> 3, per = G >> 5;
        const int nsub = ncol == 8 ? 4 : 8, sub = ncol == 8 ? (x >> 1) : x, pl = (ncol == 8 ? 4 * (x & 1) : 0) + (k & 3);
        const int Q = (ntile + nsub - 1) / nsub;
        const int rl = per * i + (k >> 2), rt = sub * Q + rl;
        if (rl >= Q || rt >= ntile) return false;
        u.pm = rt; u.pn = (int)rt2e[rt] * ncol + pl; return true; }
    __device__ __forceinline__ int arow(const Unit& u, int r) const { const int e = u.pn / ncol; const int pos = (u.pm - tbase[e]) * BM + r; return pos < cnt[e] ? list[e * NTOK + pos] : 0; }
};

__device__ __forceinline__ unsigned cvt_pk_bf16(float lo, float hi) { unsigned r; asm volatile("v_cvt_pk_bf16_f32 %0, %1, %2" : "=v"(r) : "v"(lo), "v"(hi)); return r; }
__device__ __forceinline__ float bf_lo(unsigned w) { return __uint_as_float(w << 16); }
__device__ __forceinline__ float bf_hi(unsigned w) { return __uint_as_float(w & 0xffff0000u); }
__device__ __forceinline__ float fast_sigmoid(float x) { return __builtin_amdgcn_rcpf(1.0f + __expf(-x)); }
template <int CTRL> __device__ __forceinline__ float dpp_row(float v) { return __int_as_float(__builtin_amdgcn_update_dpp(0, __float_as_int(v), CTRL, 0xF, 0xF, true)); }
__device__ __forceinline__ float row16_scan(float v) { v += dpp_row<0x111>(v); v += dpp_row<0x112>(v); v += dpp_row<0x114>(v); v += dpp_row<0x118>(v); return v; }
__device__ __forceinline__ float row16_sum(float v) { v += dpp_row<0x128>(v); v += dpp_row<0x124>(v); v += dpp_row<0x122>(v); v += dpp_row<0x121>(v); return v; }
__device__ __forceinline__ float row16_max(float v) { v = fmaxf(v, dpp_row<0x128>(v)); v = fmaxf(v, dpp_row<0x124>(v)); v = fmaxf(v, dpp_row<0x122>(v)); v = fmaxf(v, dpp_row<0x121>(v)); return v; }
__device__ __forceinline__ float rows4_sum(float v) {
    { auto r = __builtin_amdgcn_permlane32_swap(__float_as_uint(v), __float_as_uint(v), false, false); v = __uint_as_float(r[0]) + __uint_as_float(r[1]); }
    { auto r = __builtin_amdgcn_permlane16_swap(__float_as_uint(v), __float_as_uint(v), false, false); v = __uint_as_float(r[0]) + __uint_as_float(r[1]); }
    return v; }


struct EpiInProj {
    static constexpr bool PERM = true, AFTER_DRAIN = false;
#ifdef EPI_REP_INPROJ
    static constexpr int REPS = EPI_REP_INPROJ;
#else
    static constexpr int REPS = 1;
#endif
    bf16_t* proj; float* eb; const float* lb; float qscale; unsigned* nrm;
    __device__ __forceinline__ void operator()(const f32x4 (&acc)[2][2][4][2], const Unit& u, int wr, int wc, int fr, int fq) const {
        const int grp = u.pn >> 2, row0 = u.pm * BM + wr * 64 + fr, col0 = (u.pn & 3) * BM + wc * 32 + 8 * fq;
        bf16_t* base = proj + (size_t)grp * ((size_t)NTOK * DM);
        if (u.pn < 8) {
            const int hc0 = u.pn * HALF + wc * 32 + 8 * fq;
            bf16_t* qs = proj; bf16_t* kk_ = proj + (size_t)NTOK * DM;
            const f32x4 l0 = *(const f32x4*)(lb + hc0), l1 = *(const f32x4*)(lb + hc0 + 4);
#pragma unroll
            for (int ai = 0; ai < 2; ++ai)
#pragma unroll
                for (int jh = 0; jh < 2; ++jh) {
                    float qpv[4][4], kpv[4][4], ebm[4], ebl[4], blv[4];
#pragma unroll
                    for (int jj = 0; jj < 4; ++jj) {
                        const float lbv = jh == 0 ? l0[jj] : l1[jj];
                        float s[4], kk[4], tt[4];
#pragma unroll
                        for (int m = 0; m < 4; ++m) {
                            float x = acc[ai][1][m][jh][jj];
                            x = fminf(fmaxf(x, -30.f), 30.f);
                            const float e = __expf(-x), inv = __builtin_amdgcn_rcpf(1.0f + e), oms = e * inv;
                            const float f = lbv + (1.0f - lbv) * inv;
                            const float v = __logf(fmaxf(f, 1e-30f)); kk[m] = (1.0f - lbv) * oms;
                            s[m] = row16_scan(v); tt[m] = row16_sum(v);
                        }
                        const float t0 = tt[0], t1 = tt[1], t2 = tt[2], t3 = tt[3];
                        const float R = t0 + t1, BL = (t0 + t1) + (t2 + t3);
                        const float bq[4] = {s[0], s[1] + t0, s[2] + R, s[3] + (R + t2)};
#pragma unroll
                        for (int m = 0; m < 4; ++m) { const float qv = acc[ai][0][m][jh][jj];
                            qpv[m][jj] = qv * fast_sigmoid(qv) * __expf(fminf(bq[m] - R, 80.f)); kpv[m][jj] = kk[m] * __expf(fminf(R - bq[m], 80.f)); }
                        ebm[jj] = __expf(R); ebl[jj] = __expf(BL - R); blv[jj] = BL;
                    }
                    typedef unsigned u32x2_t __attribute__((ext_vector_type(2)));
#pragma unroll
                    for (int m = 0; m < 4; ++m) { const size_t off = ((size_t)u.pn * NTOK + (row0 + ai * HALF + m * 16)) * HALF + (wc * 32 + 8 * fq + 4 * jh);
                        u32x2_t w; w.x = cvt_pk_bf16(kpv[m][0], kpv[m][1]); w.y = cvt_pk_bf16(kpv[m][2], kpv[m][3]); *(u32x2_t*)(kk_ + off) = w;
                        u32x2_t q; q.x = cvt_pk_bf16(qpv[m][0], qpv[m][1]); q.y = cvt_pk_bf16(qpv[m][2], qpv[m][3]); *(u32x2_t*)(qs + off) = q; }
                    if (fr == 0) { const size_t eo = (size_t)((u.pm * BM + ai * HALF + wr * 64) >> 6) * DM + hc0 + 4 * jh; const size_t es = (size_t)(NTOK / 64) * DM;
                        *(f32x4*)(eb + eo) = (f32x4){ebm[0], ebm[1], ebm[2], ebm[3]}; *(f32x4*)(eb + es + eo) = (f32x4){ebl[0], ebl[1], ebl[2], ebl[3]}; *(f32x4*)(eb + 2 * es + eo) = (f32x4){blv[0], blv[1], blv[2], blv[3]}; }
                }
            return;
        }
        const int mode = grp == 3 ? 1 : (grp >= 7 ? 2 : 0);
        const float sc = grp == 4 ? qscale : 1.0f;
        const bool wantn = grp == 4 || grp == 5;
        float mx[2][2] = {{0.f, 0.f}, {0.f, 0.f}};
        size_t hoff[2]; int rstr;
        if (grp <= 3) { rstr = HALF; hoff[0] = (size_t)((u.pn & 3) * 2 + 0) * NTOK * HALF + wc * 32 + 8 * fq; hoff[1] = (size_t)((u.pn & 3) * 2 + 1) * NTOK * HALF + wc * 32 + 8 * fq; }
        else if (grp <= 6) { rstr = 64; hoff[0] = (size_t)((u.pn & 3) * 4 + 0 + (wc >> 1)) * NTOK * 64 + (wc & 1) * 32 + 8 * fq; hoff[1] = (size_t)((u.pn & 3) * 4 + 2 + (wc >> 1)) * NTOK * 64 + (wc & 1) * 32 + 8 * fq; }
        else { rstr = DM; hoff[0] = col0; hoff[1] = col0 + HALF; }
#pragma unroll
        for (int ai = 0; ai < 2; ++ai)
#pragma unroll
            for (int m = 0; m < 4; ++m) { bf16_t* rowp = base + (size_t)(row0 + ai * HALF + m * 16) * rstr;
#pragma unroll
                for (int bj = 0; bj < 2; ++bj) { f32x4 v0 = acc[ai][bj][m][0], v1 = acc[ai][bj][m][1];
                    if (mode != 0) {
#pragma unroll
                        for (int j = 0; j < 4; ++j) { const float s0 = fast_sigmoid(v0[j]), s1 = fast_sigmoid(v1[j]); v0[j] = mode == 1 ? v0[j] * s0 : s0; v1[j] = mode == 1 ? v1[j] * s1 : s1; }
                    } else { v0 = v0 * sc; v1 = v1 * sc; }
                    if (wantn) { float ss = (v0[0] * v0[0] + v0[1] * v0[1]) + (v0[2] * v0[2] + v0[3] * v0[3]) + (v1[0] * v1[0] + v1[1] * v1[1]) + (v1[2] * v1[2] + v1[3] * v1[3]);
                        ss = rows4_sum(ss); mx[ai][bj] = fmaxf(mx[ai][bj], ss); }
                    u32x4 w; w.x = cvt_pk_bf16(v0[0], v0[1]); w.y = cvt_pk_bf16(v0[2], v0[3]); w.z = cvt_pk_bf16(v1[0], v1[1]); w.w = cvt_pk_bf16(v1[2], v1[3]);
                    *(u32x4*)(rowp + hoff[bj]) = w; } }
        if (wantn) {
#pragma unroll
            for (int ai = 0; ai < 2; ++ai)
#pragma unroll
                for (int bj = 0; bj < 2; ++bj) { float v = mx[ai][bj];
                    v = row16_max(v);
                    if (fr == 0 && fq == 0) { const int R = u.pm * BM + ai * HALF + wr * 64, head = ((u.pn & 3) * BM + bj * HALF + wc * 32) >> 6;
                        atomicMax(nrm + ((((grp - 4) * 128 + (R >> 12) * 16 + head) * 64 + ((R & 4095) >> 6)) * 2 + (wc & 1)), __float_as_uint(v)); } }
        }
    }
};
struct EpiBranch {
    static constexpr bool PERM = true, AFTER_DRAIN = false;
    static constexpr int REPS = 1;
    const bf16_t* ga; const bf16_t* gb; bf16_t* mg;
    __device__ __forceinline__ void operator()(const f32x4 (&acc)[2][2][4][2], const Unit& u, int wr, int wc, int fr, int fq) const {
        const int half = u.pm >= (NTOK / BM) ? 1 : 0, pm = u.pm - half * (NTOK / BM), pn = u.pn - half * (DM / BM);
        const int row0 = pm * BM + wr * 64 + fr, col0 = pn * BM + wc * 32 + 8 * fq;
        const bf16_t* gp = half ? gb : ga;
#pragma unroll
        for (int ai = 0; ai < 2; ++ai)
#pragma unroll
            for (int m = 0; m < 4; ++m) { const size_t ro = (size_t)(row0 + ai * HALF + m * 16) * DM + col0;
#pragma unroll
                for (int bj = 0; bj < 2; ++bj) { const f32x4 v0 = acc[ai][bj][m][0], v1 = acc[ai][bj][m][1];
                    const u32x4 gw = *(const u32x4*)(gp + ro + bj * HALF);
                    float o[8];
                    o[0] = bf_lo(gw.x) * v0[0]; o[1] = bf_hi(gw.x) * v0[1]; o[2] = bf_lo(gw.y) * v0[2]; o[3] = bf_hi(gw.y) * v0[3];
                    o[4] = bf_lo(gw.z) * v1[0]; o[5] = bf_hi(gw.z) * v1[1]; o[6] = bf_lo(gw.w) * v1[2]; o[7] = bf_hi(gw.w) * v1[3];
                    if (half) { const u32x4 pw = *(const u32x4*)(mg + ro + bj * HALF);
                        o[0] += bf_lo(pw.x); o[1] += bf_hi(pw.x); o[2] += bf_lo(pw.y); o[3] += bf_hi(pw.y); o[4] += bf_lo(pw.z); o[5] += bf_hi(pw.z); o[6] += bf_lo(pw.w); o[7] += bf_hi(pw.w); }
                    u32x4 w; w.x = cvt_pk_bf16(o[0], o[1]); w.y = cvt_pk_bf16(o[2], o[3]); w.z = cvt_pk_bf16(o[4], o[5]); w.w = cvt_pk_bf16(o[6], o[7]);
                    *(u32x4*)(mg + ro + bj * HALF) = w; } }
    }
};
struct EpiBf16Plain {
    static constexpr bool PERM = true, AFTER_DRAIN = false;
    static constexpr int REPS = 1;
    bf16_t* O; int ldc;
    __device__ __forceinline__ void operator()(const f32x4 (&acc)[2][2][4][2], const Unit& u, int wr, int wc, int fr, int fq) const {
        const int row0 = u.pm * BM + wr * 64 + fr, col0 = u.pn * BM + wc * 32 + 8 * fq;
#pragma unroll
        for (int ai = 0; ai < 2; ++ai)
#pragma unroll
            for (int m = 0; m < 4; ++m) { bf16_t* rowp = O + (size_t)(row0 + ai * HALF + m * 16) * ldc + col0;
#pragma unroll
                for (int bj = 0; bj < 2; ++bj) { const f32x4 v0 = acc[ai][bj][m][0], v1 = acc[ai][bj][m][1];
                    u32x4 w; w.x = cvt_pk_bf16(v0[0], v0[1]); w.y = cvt_pk_bf16(v0[2], v0[3]); w.z = cvt_pk_bf16(v1[0], v1[1]); w.w = cvt_pk_bf16(v1[2], v1[3]);
                    *(u32x4*)(rowp + bj * HALF) = w; } }
    }
};
struct EpiF32 {
    static constexpr bool PERM = true, AFTER_DRAIN = false;
    static constexpr int REPS = 1;
    float* O; int ldc;
    __device__ __forceinline__ void operator()(const f32x4 (&acc)[2][2][4][2], const Unit& u, int wr, int wc, int fr, int fq) const {
        const int row0 = u.pm * BM + wr * 64 + fr, col0 = u.pn * BM + wc * 32 + 8 * fq;
#pragma unroll
        for (int ai = 0; ai < 2; ++ai)
#pragma unroll
            for (int m = 0; m < 4; ++m) { float* rowp = O + (size_t)(row0 + ai * HALF + m * 16) * ldc + col0;
#pragma unroll
                for (int bj = 0; bj < 2; ++bj) { *(f32x4*)(rowp + bj * HALF) = acc[ai][bj][m][0]; *(f32x4*)(rowp + bj * HALF + 4) = acc[ai][bj][m][1]; } }
    }
};
struct EpiMoe1 {
    static constexpr bool PERM = true, AFTER_DRAIN = false;
#ifdef EPI_REP_MOE
    static constexpr int REPS = EPI_REP_MOE;
#else
    static constexpr int REPS = 1;
#endif
    bf16_t* act; const float* bg; const float* bu;
    __device__ __forceinline__ void operator()(const f32x4 (&acc)[2][2][4][2], const Unit& u, int wr, int wc, int fr, int fq) const {
        const int row0 = u.pm * BM + wr * 64 + fr, cl = wc * 32 + 8 * fq, colo = (u.pn & 7) * HALF + cl;
        const size_t bo = (size_t)u.pn * HALF + cl;
        const f32x4 g0 = *(const f32x4*)(bg + bo), g1 = *(const f32x4*)(bg + bo + 4), u0 = *(const f32x4*)(bu + bo), u1 = *(const f32x4*)(bu + bo + 4);
#pragma unroll
        for (int ai = 0; ai < 2; ++ai)
#pragma unroll
            for (int m = 0; m < 4; ++m) {
                float o[8];
#pragma unroll
                for (int j = 0; j < 8; ++j) {
                    float gv = (j < 4 ? acc[ai][0][m][0][j & 3] : acc[ai][0][m][1][j & 3]) + (j < 4 ? g0[j & 3] : g1[j & 3]);
                    float uv = (j < 4 ? acc[ai][1][m][0][j & 3] : acc[ai][1][m][1][j & 3]) + (j < 4 ? u0[j & 3] : u1[j & 3]);
                    gv = fminf(gv, 7.0f); uv = fminf(fmaxf(uv, -7.0f), 7.0f);
                    o[j] = (uv + 1.0f) * (gv * fast_sigmoid(1.702f * gv));
                }
                u32x4 w; w.x = cvt_pk_bf16(o[0], o[1]); w.y = cvt_pk_bf16(o[2], o[3]); w.z = cvt_pk_bf16(o[4], o[5]); w.w = cvt_pk_bf16(o[6], o[7]);
                *(u32x4*)(act + (size_t)(row0 + ai * HALF + m * 16) * DM + colo) = w;
            }
    }
};
struct EpiMoe2 {
    static constexpr bool PERM = true, AFTER_DRAIN = false;
#ifdef EPI_REP_MOE
    static constexpr int REPS = EPI_REP_MOE;
#else
    static constexpr int REPS = 1;
#endif
    bf16_t* yr; const float* bd;
    __device__ __forceinline__ void operator()(const f32x4 (&acc)[2][2][4][2], const Unit& u, int wr, int wc, int fr, int fq) const {
        const int row0 = u.pm * BM + wr * 64 + fr, cl = wc * 32 + 8 * fq, colo = (u.pn & 3) * BM + cl;
        const size_t bo = (size_t)u.pn * BM + cl;
        f32x4 bv[2][2];
#pragma unroll
        for (int bj = 0; bj < 2; ++bj) { bv[bj][0] = *(const f32x4*)(bd + bo + bj * HALF); bv[bj][1] = *(const f32x4*)(bd + bo + bj * HALF + 4); }
#pragma unroll
        for (int ai = 0; ai < 2; ++ai)
#pragma unroll
            for (int m = 0; m < 4; ++m) { bf16_t* rowp = yr + (size_t)(row0 + ai * HALF + m * 16) * DM + colo;
#pragma unroll
                for (int bj = 0; bj < 2; ++bj) { const f32x4 v0 = acc[ai][bj][m][0] + bv[bj][0], v1 = acc[ai][bj][m][1] + bv[bj][1];
                    u32x4 w; w.x = cvt_pk_bf16(v0[0], v0[1]); w.y = cvt_pk_bf16(v0[2], v0[3]); w.z = cvt_pk_bf16(v1[0], v1[1]); w.w = cvt_pk_bf16(v1[2], v1[3]);
                    *(u32x4*)(rowp + bj * HALF) = w; } }
    }
};
template <class Epi, class Sched, bool ALIGN_EPI = false, bool SP2 = false, bool GATHER = false>
__device__ __forceinline__ void gemm_phase(PG8_LAS unsigned char* lds, const Gemm g, const Sched& S, const Epi& E, const int wv  ) {
    int tid_ = wv * 64 + (int)__builtin_amdgcn_mbcnt_hi(~0u, __builtin_amdgcn_mbcnt_lo(~0u, 0u)); asm volatile("" : "+v"(tid_));
    const int tid = tid_, wid = __builtin_amdgcn_readfirstlane(tid >> 6), lane = tid & 63, wr = wid >> 2, wc = wid & 3, fr = lane & 15, fq = lane >> 4;
    const int K = g.K, nt = K / BK;
    unsigned voffA[2], voffB[2]; int rA[2], cA2[2];
#pragma unroll
    for (int i = 0; i < 2; ++i) { int R, C; stage_rc(tid * 16 + i * 8192, R, C); const int Rb = Epi::PERM ? ((R & ~31) + perm32(R & 31)) : R;
        voffA[i] = (unsigned)(R * K + C) * 2u; voffB[i] = (unsigned)(Rb * K + C) * 2u; rA[i] = R; cA2[i] = C * 2; }
    unsigned cvo[2][2], nvo[2][2];
#define PG8_GVO(dst, un) do { _Pragma("unroll") for (int _h = 0; _h < 2; ++_h) _Pragma("unroll") for (int _i = 0; _i < 2; ++_i) \
        dst[_h][_i] = (unsigned)S.arow(un, _h * HALF + rA[_i]) * (unsigned)(K * 2) + (unsigned)cA2[_i]; } while (0)
    const size_t kstep = (size_t)(BK * 2);
    const size_t hstep = (size_t)HALF * K * 2;
    const size_t tstep = 2 * hstep;
    const unsigned ldsw = (unsigned)wid * 1024u;
    const int aoff = lds_byte(wr * 64 + fr, fq * 8), boff = lds_byte(wc * 32 + fr, fq * 8);
#define PG8_SA(b, h) (((b) * 2 + (h)) * HTB)
#define PG8_SB(b, h) ((4 + (b) * 2 + (h)) * HTB)
#define PG8_STAGE(bufoff, gbase, voff) do { _Pragma("unroll") for (int _i = 0; _i < 2; ++_i) \
        __builtin_amdgcn_global_load_lds((const unsigned*)((const char*)(gbase) + (voff)[_i]), (PG8_LAS unsigned*)(lds + (bufoff) + ldsw + _i * 8192), 16, 0, 0); } while (0)
#define PG8_STAGE_A(bufoff, gbase, hh, nx) do { if constexpr (GATHER) { _Pragma("unroll") for (int _i = 0; _i < 2; ++_i) { const unsigned _vo = (nx) ? nvo[hh][_i] : cvo[hh][_i]; \
        __builtin_amdgcn_global_load_lds((const unsigned*)((const char*)(gbase) + _vo), (PG8_LAS unsigned*)(lds + (bufoff) + ldsw + _i * 8192), 16, 0, 0); } } \
        else { PG8_STAGE(bufoff, (gbase) + (hh) * hstep, voffA); } } while (0)
#define PG8_LDA(dst, b, h) do { _Pragma("unroll") for (int m = 0; m < 4; ++m) _Pragma("unroll") for (int k = 0; k < 2; ++k) dst[m][k] = *(const PG8_LAS bf16x8*)(lds + PG8_SA(b, h) + aoff + m * 2048 + k * 1024); } while (0)
#define PG8_LDB(dst, b, h) do { _Pragma("unroll") for (int n = 0; n < 2; ++n) _Pragma("unroll") for (int k = 0; k < 2; ++k) dst[n][k] = *(const PG8_LAS bf16x8*)(lds + PG8_SB(b, h) + boff + n * 2048 + k * 1024); } while (0)
#define PG8_MMA(ai, bj, At, Bt) do { __builtin_amdgcn_s_setprio(1); _Pragma("unroll") for (int m = 0; m < 4; ++m) _Pragma("unroll") for (int n = 0; n < 2; ++n) _Pragma("unroll") for (int k = 0; k < 2; ++k) \
        acc[ai][bj][m][n] = __builtin_amdgcn_mfma_f32_16x16x32_bf16(Bt[n][k], At[m][k], acc[ai][bj][m][n], 0, 0, 0); __builtin_amdgcn_s_setprio(0); } while (0)
#define PG8_WAIT_V(n) asm volatile("s_waitcnt vmcnt(" #n ")" ::: "memory")
#define PG8_WAIT_L(n) asm volatile("s_waitcnt lgkmcnt(" #n ")" ::: "memory")
#define PG8_BAR __builtin_amdgcn_s_barrier()
#define PG8_SCHED __builtin_amdgcn_sched_barrier(0)
    Unit cur, nxt; int ui = 0;
    if (!S.next(0, cur)) return;
    f32x4 acc[2][2][4][2];
#pragma unroll
    for (int a = 0; a < 2; ++a)
#pragma unroll
        for (int b = 0; b < 2; ++b)
#pragma unroll
            for (int m = 0; m < 4; ++m)
#pragma unroll
                for (int n = 0; n < 2; ++n) acc[a][b][m][n] = (f32x4){0.f, 0.f, 0.f, 0.f};
    bf16x8 At[4][2], B0[2][2], B1[2][2];
    const char* cA = (const char*)g.A + (GATHER ? (size_t)0 : (size_t)cur.pm * tstep); const char* cB = (const char*)g.Bt + (size_t)cur.pn * tstep;
    if constexpr (GATHER) { PG8_GVO(cvo, cur); }
    if constexpr (SP2) {
        PG8_STAGE(PG8_SB(0, 0), cB, voffB); PG8_STAGE(PG8_SB(0, 1), cB + hstep, voffB); PG8_STAGE_A(PG8_SA(0, 0), cA, 0, false); PG8_STAGE_A(PG8_SA(0, 1), cA, 1, false);
        if (wr == 1) PG8_BAR;
        PG8_WAIT_V(2); PG8_BAR;
        PG8_STAGE(PG8_SB(1, 0), cB + kstep, voffB); PG8_STAGE_A(PG8_SA(1, 0), cA + kstep, 0, false); PG8_STAGE(PG8_SB(1, 1), cB + hstep + kstep, voffB);
        PG8_WAIT_V(6); PG8_BAR;
    } else {
        PG8_STAGE(PG8_SB(0, 0), cB, voffB); PG8_STAGE_A(PG8_SA(0, 0), cA, 0, false); PG8_STAGE(PG8_SB(0, 1), cB + hstep, voffB); PG8_STAGE_A(PG8_SA(0, 1), cA, 1, false);
        if (wr == 1) PG8_BAR;
        PG8_WAIT_V(4); PG8_BAR;
        PG8_STAGE(PG8_SB(1, 0), cB + kstep, voffB); PG8_STAGE_A(PG8_SA(1, 0), cA + kstep, 0, false); PG8_STAGE(PG8_SB(1, 1), cB + hstep + kstep, voffB);
        PG8_WAIT_V(6); PG8_BAR;
    }
    for (;;) {
        const bool has_next = S.next(ui + 1, nxt);
        const char* nA = GATHER ? cA : (has_next ? (const char*)g.A + (size_t)nxt.pm * tstep : cA); const char* nB = has_next ? (const char*)g.Bt + (size_t)nxt.pn * tstep : cB;
        if constexpr (GATHER) { if (has_next) { PG8_GVO(nvo, nxt); } else { _Pragma("unroll") for (int _h = 0; _h < 2; ++_h) _Pragma("unroll") for (int _i = 0; _i < 2; ++_i) nvo[_h][_i] = cvo[_h][_i]; } }
        for (int t = 0; t < nt; t += 2) {
            const bool last = (t == nt - 2);
            const char* a1 = cA + (size_t)(t + 1) * kstep;
            const char* a2 = last ? nA : cA + (size_t)(t + 2) * kstep; const char* b2 = last ? nB : cB + (size_t)(t + 2) * kstep;
            const char* a3 = a2 + kstep; const char* b3 = b2 + kstep;
            if constexpr (SP2) {
            PG8_LDB(B0, 0, 0); PG8_LDB(B1, 0, 1); PG8_SCHED; PG8_LDA(At, 0, 0); PG8_STAGE_A(PG8_SA(1, 1), a1, 1, false);
            PG8_WAIT_V(8); PG8_WAIT_L(0); PG8_BAR; PG8_MMA(0, 0, At, B0); PG8_MMA(0, 1, At, B1); PG8_BAR; PG8_SCHED;
            PG8_LDA(At, 0, 1); PG8_STAGE(PG8_SB(0, 0), b2, voffB); PG8_STAGE(PG8_SB(0, 1), b2 + hstep, voffB); PG8_STAGE_A(PG8_SA(0, 0), a2, 0, last);
            PG8_WAIT_V(8); PG8_WAIT_L(0); PG8_BAR; PG8_MMA(1, 0, At, B0); PG8_MMA(1, 1, At, B1); PG8_BAR; PG8_SCHED;
            PG8_LDB(B0, 1, 0); PG8_LDB(B1, 1, 1); PG8_SCHED; PG8_LDA(At, 1, 0); PG8_STAGE_A(PG8_SA(0, 1), a2, 1, last);
            PG8_WAIT_V(8); PG8_WAIT_L(0); PG8_BAR; PG8_MMA(0, 0, At, B0); PG8_MMA(0, 1, At, B1); PG8_BAR; PG8_SCHED;
            PG8_LDA(At, 1, 1); PG8_STAGE(PG8_SB(1, 0), b3, voffB); PG8_STAGE(PG8_SB(1, 1), b3 + hstep, voffB); PG8_STAGE_A(PG8_SA(1, 0), a3, 0, last);
            PG8_WAIT_V(8); PG8_WAIT_L(0); PG8_BAR; PG8_MMA(1, 0, At, B0); PG8_MMA(1, 1, At, B1); PG8_BAR; PG8_SCHED;
            } else {
            PG8_LDB(B0, 0, 0); PG8_SCHED; PG8_LDA(At, 0, 0); PG8_STAGE_A(PG8_SA(1, 1), a1, 1, false);
            PG8_WAIT_L(8); PG8_BAR; PG8_WAIT_L(0); PG8_MMA(0, 0, At, B0); PG8_BAR; PG8_SCHED;
            PG8_LDB(B1, 0, 1); PG8_STAGE(PG8_SB(0, 0), b2, voffB);
            PG8_BAR; PG8_WAIT_L(0); PG8_MMA(0, 1, At, B1); PG8_BAR;
            PG8_LDA(At, 0, 1); PG8_STAGE_A(PG8_SA(0, 0), a2, 0, last);
            PG8_BAR; PG8_WAIT_L(0); PG8_MMA(1, 0, At, B0); PG8_BAR; PG8_SCHED;
            PG8_STAGE(PG8_SB(0, 1), b2 + hstep, voffB);
            PG8_WAIT_V(6); PG8_BAR; PG8_MMA(1, 1, At, B1); PG8_BAR;
            PG8_LDB(B0, 1, 0); PG8_SCHED; PG8_LDA(At, 1, 0); PG8_STAGE_A(PG8_SA(0, 1), a2, 1, last);
            PG8_WAIT_L(8); PG8_BAR; PG8_WAIT_L(0); PG8_MMA(0, 0, At, B0); PG8_BAR; PG8_SCHED;
            PG8_LDB(B1, 1, 1); PG8_STAGE(PG8_SB(1, 0), b3, voffB);
            PG8_BAR; PG8_WAIT_L(0); PG8_MMA(0, 1, At, B1); PG8_BAR;
            PG8_LDA(At, 1, 1); PG8_STAGE_A(PG8_SA(1, 0), a3, 0, last);
            PG8_BAR; PG8_WAIT_L(0); PG8_MMA(1, 0, At, B0); PG8_BAR; PG8_SCHED;
            PG8_STAGE(PG8_SB(1, 1), b3 + hstep, voffB);
            PG8_WAIT_V(6); PG8_BAR; PG8_MMA(1, 1, At, B1); PG8_BAR;
            }
        }
        if constexpr (ALIGN_EPI) { if (wr == 0) PG8_BAR; }
        if constexpr (!Epi::AFTER_DRAIN) { E(acc, cur, wr, wc, fr, fq); if constexpr (Epi::REPS > 1) { asm volatile("" ::: "memory"); E(acc, cur, wr, wc, fr, fq); } }
        if (!has_next) break;
#pragma unroll
        for (int a = 0; a < 2; ++a)
#pragma unroll
            for (int b = 0; b < 2; ++b)
#pragma unroll
                for (int m = 0; m < 4; ++m)
#pragma unroll
                    for (int n = 0; n < 2; ++n) acc[a][b][m][n] = (f32x4){0.f, 0.f, 0.f, 0.f};
        cur = nxt; cA = nA; cB = nB; ++ui;
        if constexpr (GATHER) { _Pragma("unroll") for (int _h = 0; _h < 2; ++_h) _Pragma("unroll") for (int _i = 0; _i < 2; ++_i) cvo[_h][_i] = nvo[_h][_i]; }
        if constexpr (ALIGN_EPI) { if (wr == 1) PG8_BAR; }
    }
    PG8_WAIT_V(0);
    if constexpr (!ALIGN_EPI) { if (wr == 0) PG8_BAR; }
    PG8_BAR;
#undef PG8_SA
#undef PG8_SB
#undef PG8_STAGE
#undef PG8_STAGE_A
#undef PG8_GVO
#undef PG8_LDA
#undef PG8_LDB
#undef PG8_MMA
#undef PG8_WAIT_V
#undef PG8_WAIT_L
#undef PG8_BAR
#undef PG8_SCHED
}
}

namespace attn_body {
using bf16=__hip_bfloat16;
using bf16x8=__attribute__((ext_vector_type(8)))short;
using s16x4=__attribute__((ext_vector_type(4)))short;
using f32x16=__attribute__((ext_vector_type(16)))float;
using u32x4=__attribute__((ext_vector_type(4)))unsigned;
constexpr int BATCH=8,NHEAD=16,SEQ=4096,D=64,DM=NHEAD*D;
constexpr long HSTR=(long)BATCH*SEQ*D;
constexpr int NW=8,QBLK=32,QB=QBLK*NW,KVBLK=64,NQB=SEQ/QB;
constexpr int ATTN_PITCH=DM, ATTN_UNIT_ROWS=QB;
__device__ __forceinline__ int crow(int r,int hi){return (r&3)+8*(r>>2)+4*hi;}
#define SBAR() __builtin_amdgcn_sched_barrier(0)
__device__ __forceinline__ void cmask(f32x16&p0,f32x16&p1,int jb,int qrel,int hi){
  const float NEG=-INFINITY; int kb=64*jb+4*hi;
  #pragma unroll
  for(int r=0;r<16;++r){int kv=kb+(r&3)+8*(r>>2); if(kv>qrel)p0[r]=NEG; if(kv+32>qrel)p1[r]=NEG;}
}

constexpr int NSLOT=3, SLOTB=8192;
constexpr int LDS_K=0, LDS_V=NSLOT*SLOTB, LDS_WS=2*NSLOT*SLOTB, LDS_OST=LDS_WS+NW*64*4, LDS_FK=LDS_OST+NW*4096, LDS_BYTES=LDS_FK+SEQ*4;
constexpr float C2=0.125f*1.4426950408889634f;
__device__ __forceinline__ void glds16(const void*gsrc,unsigned lds_dst){unsigned keep;
  asm volatile("s_mov_b32 %0, m0\n\ts_mov_b32 m0, %2\n\ts_nop 0\n\tglobal_load_lds_dwordx4 %1, off\n\ts_mov_b32 m0, %0":"=&s"(keep):"v"(gsrc),"s"(lds_dst):"memory");}
__device__ __forceinline__ float max3f(float a,float b,float c){float r;asm("v_max3_f32 %0, %1, %2, %3":"=v"(r):"v"(a),"v"(b),"v"(c));return r;}
__device__ __forceinline__ float max2f(float a,float b){float r;asm("v_max_f32_e32 %0, %1, %2":"=v"(r):"v"(a),"v"(b));return r;}
__device__ __forceinline__ float fadd_s(float a,float b){float r;asm("v_add_f32_e32 %0, %1, %2":"=v"(r):"v"(a),"v"(b));return r;}
__device__ __forceinline__ float fsub_s(float a,float b){float r;asm("v_sub_f32_e32 %0, %1, %2":"=v"(r):"v"(a),"v"(b));return r;}
typedef float f32x2_t __attribute__((ext_vector_type(2))); typedef __bf16 bf16x2_t __attribute__((ext_vector_type(2)));
__device__ __forceinline__ unsigned cvtpk_s(float lo,float hi){f32x2_t v={lo,hi};bf16x2_t b=__builtin_convertvector(v,bf16x2_t);return __builtin_bit_cast(unsigned,b);}
#define WAIT_BAR(N) asm volatile("s_waitcnt vmcnt(" #N ") lgkmcnt(0)\n\ts_barrier":::"memory")

__device__ __forceinline__ void qkt(f32x16&p0,f32x16&p1,const char*Kslot,const bf16x8*qr,int r32,int hi){
  const char*kb=Kslot+hi*1024+r32*16;
  #pragma unroll
  for(int d0=0;d0<4;++d0){
    const bf16x8 b0=*reinterpret_cast<const bf16x8*>(kb+d0*2048);
    const bf16x8 b1=*reinterpret_cast<const bf16x8*>(kb+d0*2048+512);
    p0=__builtin_amdgcn_mfma_f32_32x32x16_bf16(b0,qr[d0],p0,0,0,0);p1=__builtin_amdgcn_mfma_f32_32x32x16_bf16(b1,qr[d0],p1,0,0,0);}
}
typedef __attribute__((address_space(3))) const char* lds_cptr;
typedef short v4i16_t __attribute__((ext_vector_type(4)));
__device__ __forceinline__ void kload8(bf16x8*kf,lds_cptr kp){
  kf[0]=*(const __attribute__((address_space(3))) bf16x8*)(kp);      kf[1]=*(const __attribute__((address_space(3))) bf16x8*)(kp+512);
  kf[2]=*(const __attribute__((address_space(3))) bf16x8*)(kp+2048); kf[3]=*(const __attribute__((address_space(3))) bf16x8*)(kp+2560);
  kf[4]=*(const __attribute__((address_space(3))) bf16x8*)(kp+4096); kf[5]=*(const __attribute__((address_space(3))) bf16x8*)(kp+4608);
  kf[6]=*(const __attribute__((address_space(3))) bf16x8*)(kp+6144); kf[7]=*(const __attribute__((address_space(3))) bf16x8*)(kp+6656);
}
__device__ __forceinline__ void kload2(bf16x8*kf,lds_cptr kp,int j){ kf[2*j]=*(const __attribute__((address_space(3))) bf16x8*)(kp+j*2048); kf[2*j+1]=*(const __attribute__((address_space(3))) bf16x8*)(kp+j*2048+512); }
__device__ __forceinline__ s16x4 vtr(lds_cptr p){ return __builtin_bit_cast(s16x4,__builtin_amdgcn_ds_read_tr16_b64_v4i16((__attribute__((address_space(3))) v4i16_t*)p)); }
__device__ __forceinline__ float rowmax(const f32x16&p0,const f32x16&p1){
  float a=max3f(p0[0],p0[1],p1[0]),b=max3f(p0[2],p0[3],p1[1]);a=max3f(a,p1[2],p1[3]);
  #pragma unroll
  for(int r=4;r<16;r+=4){a=max3f(a,p0[r],p0[r+1]);b=max3f(b,p0[r+2],p0[r+3]);a=max3f(a,p1[r],p1[r+1]);b=max3f(b,p1[r+2],p1[r+3]);}
  const float m=max2f(a,b);
  auto rr=__builtin_amdgcn_permlane32_swap(__float_as_uint(m),__float_as_uint(m),false,false);
  return max2f(__uint_as_float(rr[0]),__uint_as_float(rr[1]));
}
__device__ __forceinline__ void pv(f32x16*o,int vb,bf16x8 pa0,bf16x8 pa1,bf16x8 pa2,bf16x8 pa3){
  #pragma unroll
  for(int d0=0;d0<2;++d0){s16x4 lo[4],hi[4];
    #pragma unroll
    for(int ks=0;ks<4;++ks){
      asm volatile("ds_read_b64_tr_b16 %0,%1 offset:%c2":"=&v"(lo[ks]):"v"(vb),"i"(d0*4096+ks*1024):"memory");
      asm volatile("ds_read_b64_tr_b16 %0,%1 offset:%c2":"=&v"(hi[ks]):"v"(vb),"i"(d0*4096+ks*1024+512):"memory");}
    asm volatile("s_waitcnt lgkmcnt(0)":::"memory");SBAR();
    #define PK(k) (bf16x8){lo[k][0],lo[k][1],lo[k][2],lo[k][3],hi[k][0],hi[k][1],hi[k][2],hi[k][3]}
    o[d0]=__builtin_amdgcn_mfma_f32_32x32x16_bf16(pa0,PK(0),o[d0],0,0,0);
    o[d0]=__builtin_amdgcn_mfma_f32_32x32x16_bf16(pa1,PK(1),o[d0],0,0,0);
    o[d0]=__builtin_amdgcn_mfma_f32_32x32x16_bf16(pa2,PK(2),o[d0],0,0,0);
    o[d0]=__builtin_amdgcn_mfma_f32_32x32x16_bf16(pa3,PK(3),o[d0],0,0,0);
    #undef PK
  }
}

#ifndef ATTN_STORE16
#define ATTN_STORE16(p,v) (*(u32x4*)(p)=(v))
#endif
template<int THRL> __device__ __forceinline__ void attn_unit(int b,int h,int qb,const bf16*Q,const bf16*__restrict__ K,const bf16*__restrict__ V,bf16*O,const float*__restrict__ FP,const unsigned*__restrict__ NQ,const unsigned*__restrict__ NK,unsigned*wq,volatile __attribute__((address_space(3))) unsigned*wslot,char*shm,const int wv){
  int tid_ = wv * 64 + (int)__builtin_amdgcn_mbcnt_hi(~0u, __builtin_amdgcn_mbcnt_lo(~0u, 0u)); asm volatile("" : "+v"(tid_));
  const int tid=tid_,lane=tid&63,r32=lane&31,hi=lane>>5; const int wid=__builtin_amdgcn_readfirstlane(tid>>6);
  const long rowbase=(long)b*SEQ; const int q0=qb*QB;
  const bf16*Qw=Q+(long)h*HSTR+(rowbase+q0+wid*QBLK)*D;
  unsigned wnext=0u; if(tid==0)wnext=__hip_atomic_fetch_add(wq,1u,__ATOMIC_RELAXED,__HIP_MEMORY_SCOPE_AGENT);
  const float*Fbh=FP+(long)(b*NHEAD+h)*SEQ;
  const int NTfull=(q0+QB)/KVBLK; int jstart;
  { typedef float f32x2_t __attribute__((ext_vector_type(2)));
    const int jt=lane<NTfull?lane:NTfull-1;
    const f32x2_t nk=*reinterpret_cast<const f32x2_t*>(NK+2*jt); const float kn=sqrtf(nk.x+nk.y)*1.02f;
    float qn2=0.f,kd=0.f;
    #pragma unroll
    for(int t=0;t<4;++t){ const f32x2_t a=*reinterpret_cast<const f32x2_t*>(NQ+2*(4*qb+t)); qn2=fmaxf(qn2,a.x+a.y); kd=fmaxf(kd,__uint_as_float(__builtin_amdgcn_readlane(__float_as_uint(kn),4*qb+t))); }
    const float qn=sqrtf(qn2)*1.02f, lbv=-qn*kd, bias=Fbh[q0]-Fbh[64*jt+63];
    const bool need=(lane<NTfull)&&((lane>=NTfull-4)||!(qn*kn+bias<lbv-40.f));
    const unsigned long long bal=__ballot(need);
    jstart=bal?(__ffsll((long long)bal)-1):0; jstart=__builtin_amdgcn_readfirstlane(jstart)&~1; }
  if(tid==0)*wslot=wnext;
  const bf16*Kh=K+(long)h*HSTR+(rowbase+(long)jstart*KVBLK)*D,*Vh=V+(long)h*HSTR+(rowbase+(long)jstart*KVBLK)*D;
  const lds_cptr shm3=(lds_cptr)shm;
  const unsigned lds0=(unsigned)(uintptr_t)shm;
  float*wsf=(float*)(shm+LDS_WS)+wid*64;
  const bf16*ksrc=Kh+(long)lane*D+wid*8;
  const bf16*vsrc=Vh+(long)(16*(wid&3)+(lane>>2))*D+(wid>>2)*32+(lane&3)*8;
  const unsigned kdst=lds0+LDS_K+wid*1024, vdst=lds0+LDS_V+wid*1024;
  #define DMA_K(t,slot) glds16(ksrc+(long)(t)*KVBLK*D,(unsigned)__builtin_amdgcn_readfirstlane(kdst+(slot)))
  #define DMA_V(t,slot) glds16(vsrc+(long)(t)*KVBLK*D,(unsigned)__builtin_amdgcn_readfirstlane(vdst+(slot)))
  const int vb0=(int)(lds0+LDS_V)+((lane>>4)&1)*32+(lane&3)*8+(4*hi+((lane&15)>>2))*64;
  const char*Kbase=shm+LDS_K; bf16x8 kf[8];
  const lds_cptr kp0=shm3+LDS_K+hi*1024+r32*16; const lds_cptr vp0=shm3+LDS_V+((lane>>4)&1)*32+(lane&3)*8+(4*hi+((lane&15)>>2))*64;
  const int NT=NTfull-jstart;
  DMA_K(0,0);DMA_V(0,0);DMA_K(1,SLOTB);
  { typedef float f32x4_t __attribute__((ext_vector_type(4))); __attribute__((address_space(3))) f32x4_t*fdst=(__attribute__((address_space(3))) f32x4_t*)(shm3+LDS_FK);
    for(int i=tid;i<NT*(KVBLK/4);i+=NW*64)fdst[i]=*reinterpret_cast<const f32x4_t*>(Fbh+jstart*KVBLK+4*i); }
  const float fq=Fbh[q0+wid*QBLK+r32];
  const __attribute__((address_space(3))) float*fk3=(const __attribute__((address_space(3))) float*)(shm3+LDS_FK)+4*hi;
  #define FINIT(P0,P1,t) do{ typedef float f32x4_t __attribute__((ext_vector_type(4))); const __attribute__((address_space(3))) float*fk_=fk3+(t)*KVBLK; \
    _Pragma("unroll") for(int g_=0;g_<4;++g_){ const f32x4_t a_=*(const __attribute__((address_space(3))) f32x4_t*)(fk_+8*g_), b_=*(const __attribute__((address_space(3))) f32x4_t*)(fk_+32+8*g_); \
      _Pragma("unroll") for(int j_=0;j_<4;++j_){ P0[4*g_+j_]=tq-a_[j_]; P1[4*g_+j_]=tq-b_[j_]; } } }while(0)
  bf16x8 qr[4];
  #pragma unroll
  for(int d0=0;d0<4;++d0)qr[d0]=*reinterpret_cast<const bf16x8*>(&Qw[(long)r32*D+d0*16+hi*8]);
  float l_reg=0.f;f32x16 o[2];o[0]=f32x16{};o[1]=f32x16{};float tq=fq;
  const int qrel=wid*QBLK+r32;
  #define CMASK(P0,P1,t) do{int jb_=(t)-(NT-4); if(jb_>=0)cmask(P0,P1,jb_,qrel,hi);}while(0)
  bool resc=false;
  #define START(P0,P1) do{ const float rm=rowmax(P0,P1); resc=false; \
    { const float dl=rm; \
      _Pragma("unroll") for(int r=0;r<16;++r){P0[r]=fsub_s(P0[r],dl);P1[r]=fsub_s(P1[r],dl);} \
      tq=fsub_s(tq,dl); } \
    _Pragma("unroll") for(int r=0;r<16;++r)P0[r]=__builtin_amdgcn_exp2f(P0[r]); }while(0)
  #define RESC() do{ if(resc){ asm volatile("s_waitcnt lgkmcnt(0)":::"memory"); \
      _Pragma("unroll") for(int d_=0;d_<2;++d_) _Pragma("unroll") for(int r=0;r<16;++r)o[d_][r]*=wsf[crow(r,hi)]; } }while(0)
  f32x16 pA0,pA1,pB0,pB1;
  int sl_prev=0,sl_cur=0,sl_next=SLOTB;
  #define ROT() do{sl_prev=sl_cur;sl_cur=sl_next;sl_next=(sl_next==(NSLOT-1)*SLOTB)?0:sl_next+SLOTB;}while(0)
  DMA_K(2,2*SLOTB);
  WAIT_BAR(3);
  FINIT(pA0,pA1,0);
  qkt(pA0,pA1,Kbase,qr,r32,hi);asm volatile("s_nop 15\n\ts_nop 7":"+v"(pA0),"+v"(pA1));CMASK(pA0,pA1,0);
  START(pA0,pA1);
  _Pragma("unroll") for(int r=0;r<16;++r)pA1[r]=__builtin_amdgcn_exp2f(pA1[r]);
  WAIT_BAR(0);
  DMA_K(3,0);DMA_V(1,SLOTB);
  ROT();
  kload8(kf,kp0+sl_cur);
  WAIT_BAR(2);
  s16x4 vlo[8],vhi[8]; u32x4 pw0,pw1,pw2,pw3;
  #define PKW(P,B) cvtpk_s(P[B],P[B+1])
  #define PAF(k) __builtin_bit_cast(bf16x8,pw##k)
  #define VFR(i) (bf16x8){vlo[i][0],vlo[i][1],vlo[i][2],vlo[i][3],vhi[i][0],vhi[i][1],vhi[i][2],vhi[i][3]}
  #define PIN(x) asm volatile("":"+v"(x))
  #define MX3(a,b,c) __builtin_fmaxf(__builtin_fmaxf((a),(b)),(c))
  #define GAPA(MF,A0,A1,A2,A3,W0,W1,PW) do{ MF; sacc+=A0; sacc+=A1; sacc+=A2; sacc+=A3; PIN(sacc); W0; W1; PIN(PW); SBAR(); }while(0)
  #define EX(v) __builtin_amdgcn_exp2f(v)
  #define GAPB(MF,X,B) do{ MF; X[B]=EX(X[B]); X[B+1]=EX(X[B+1]); X[B+2]=EX(X[B+2]); X[B+3]=EX(X[B+3]); PIN(X); SBAR(); }while(0)
  #define VRD(i) do{ vlo[i]=vtr(vp_+(((i)>>2)*4096+((i)&3)*1024)); vhi[i]=vtr(vp_+(((i)>>2)*4096+((i)&3)*1024+512)); }while(0)
  #define KRD(G,j) do{ if(G){ kload2(kf,kp0+sl_next,j); SBAR(); } }while(0)
  #define STEP(C0,C1,P0,P1,t,GK,GV,GL) do{ SBAR(); FINIT(C0,C1,t); SBAR(); \
    const lds_cptr vp_=vp0+sl_prev; \
    VRD(0); SBAR(); float sacc=(P0[0]+P0[1]); \
    GAPA(C0=__builtin_amdgcn_mfma_f32_32x32x16_bf16(kf[0],qr[0],C0,0,0,0), P0[2],P0[3],P0[4],P0[5],     pw0[0]=PKW(P0,0), pw0[1]=PKW(P0,2), pw0); \
    VRD(4); SBAR(); GAPA(C1=__builtin_amdgcn_mfma_f32_32x32x16_bf16(kf[1],qr[0],C1,0,0,0), P0[6],P0[7],P0[8],P0[9],     pw0[2]=PKW(P0,4), pw0[3]=PKW(P0,6), pw0); \
    VRD(1); SBAR(); GAPA(C0=__builtin_amdgcn_mfma_f32_32x32x16_bf16(kf[2],qr[1],C0,0,0,0),   P0[10],P0[11],P0[12],P0[13], pw1[0]=PKW(P0,8), pw1[1]=PKW(P0,10), pw1); \
    VRD(5); SBAR(); GAPA(C1=__builtin_amdgcn_mfma_f32_32x32x16_bf16(kf[3],qr[1],C1,0,0,0),   P0[14],P0[15],P1[0],P1[1],   pw1[2]=PKW(P0,12),pw1[3]=PKW(P0,14), pw1); \
    VRD(2); SBAR(); GAPA(C0=__builtin_amdgcn_mfma_f32_32x32x16_bf16(kf[4],qr[2],C0,0,0,0),   P1[2],P1[3],P1[4],P1[5],     pw2[0]=PKW(P1,0), pw2[1]=PKW(P1,2), pw2); \
    VRD(6); SBAR(); GAPA(C1=__builtin_amdgcn_mfma_f32_32x32x16_bf16(kf[5],qr[2],C1,0,0,0),   P1[6],P1[7],P1[8],P1[9],     pw2[2]=PKW(P1,4), pw2[3]=PKW(P1,6), pw2); \
    VRD(3); SBAR(); GAPA(C0=__builtin_amdgcn_mfma_f32_32x32x16_bf16(kf[6],qr[3],C0,0,0,0),   P1[10],P1[11],P1[12],P1[13], pw3[0]=PKW(P1,8), pw3[1]=PKW(P1,10), pw3); \
    VRD(7); SBAR(); GAPA(C1=__builtin_amdgcn_mfma_f32_32x32x16_bf16(kf[7],qr[3],C1,0,0,0),   P1[14],P1[15],0.f,0.f,       pw3[2]=PKW(P1,12),pw3[3]=PKW(P1,14), pw3); \
    l_reg+=sacc; \
    if(GK){DMA_K((t)+3,sl_cur);} if(GV){DMA_V((t)+1,sl_next);} \
    CMASK(C0,C1,t); \
    { float a=MX3(C0[0],C0[1],C1[0]),b=MX3(C0[2],C0[3],C1[1]); a=MX3(a,C1[2],C1[3]); \
      _Pragma("unroll") for(int r=4;r<16;r+=4){a=MX3(a,C0[r],C0[r+1]);b=MX3(b,C0[r+2],C0[r+3]);a=MX3(a,C1[r],C1[r+1]);b=MX3(b,C1[r+2],C1[r+3]);} \
      float rm=__builtin_fmaxf(a,b); { auto rr=__builtin_amdgcn_permlane32_swap(__float_as_uint(rm),__float_as_uint(rm),false,false); rm=__builtin_fmaxf(__uint_as_float(rr[0]),__uint_as_float(rr[1])); } \
      resc=false; \
      if(__builtin_expect(__any(rm>(float)THRL),0)){ const float dl=__builtin_fmaxf(rm,0.f); \
        _Pragma("unroll") for(int r=0;r<16;++r){C0[r]-=dl;C1[r]-=dl;} \
        tq-=dl; \
        const float f=__builtin_amdgcn_exp2f(-dl); l_reg*=f; if(hi==0)wsf[r32]=f; resc=true; } } \
    SBAR(); \
    GAPB(o[0]=__builtin_amdgcn_mfma_f32_32x32x16_bf16(PAF(0),VFR(0),o[0],0,0,0), C0,0); \
    GAPB(o[1]=__builtin_amdgcn_mfma_f32_32x32x16_bf16(PAF(0),VFR(4),o[1],0,0,0), C0,4); \
    KRD(GL,0); GAPB(o[0]=__builtin_amdgcn_mfma_f32_32x32x16_bf16(PAF(1),VFR(1),o[0],0,0,0), C0,8); \
    KRD(GL,1); GAPB(o[1]=__builtin_amdgcn_mfma_f32_32x32x16_bf16(PAF(1),VFR(5),o[1],0,0,0), C0,12); \
    KRD(GL,2); GAPB(o[0]=__builtin_amdgcn_mfma_f32_32x32x16_bf16(PAF(2),VFR(2),o[0],0,0,0), C1,0); \
    KRD(GL,3); GAPB(o[1]=__builtin_amdgcn_mfma_f32_32x32x16_bf16(PAF(2),VFR(6),o[1],0,0,0), C1,4); \
    GAPB(o[0]=__builtin_amdgcn_mfma_f32_32x32x16_bf16(PAF(3),VFR(3),o[0],0,0,0), C1,8); \
    GAPB(o[1]=__builtin_amdgcn_mfma_f32_32x32x16_bf16(PAF(3),VFR(7),o[1],0,0,0), C1,12); \
    }while(0)
  int t=1;
  #undef CMASK
  #define CMASK(P0,P1,t) do{}while(0)
  for(;t+5<NT;t+=2){
    STEP(pB0,pB1,pA0,pA1,t,true,true,true);     WAIT_BAR(2); RESC(); ROT();
    STEP(pA0,pA1,pB0,pB1,t+1,true,true,true);   WAIT_BAR(2); RESC(); ROT();
  }
  #undef CMASK
  #define CMASK(P0,P1,t) do{int jb_=(t)-(NT-4); if(jb_>=0)cmask(P0,P1,jb_,qrel,hi);}while(0)
  #define ENDW(tt) do{ if((tt)+3<NT){WAIT_BAR(2);} else if((tt)+2<NT){WAIT_BAR(1);} else {WAIT_BAR(0);} }while(0)
  for(;t+1<NT;t+=2){
    STEP(pB0,pB1,pA0,pA1,t,(t+3<NT),(t+1<NT),(t+1<NT));       ENDW(t);   RESC(); ROT();
    STEP(pA0,pA1,pB0,pB1,t+1,(t+4<NT),(t+2<NT),(t+2<NT));     ENDW(t+1); RESC(); ROT();
  }
  STEP(pB0,pB1,pA0,pA1,NT-1,false,false,false); RESC();
  { float sacc=pB0[0]+pB0[1]; _Pragma("unroll") for(int r=2;r<16;++r)sacc+=pB0[r]; _Pragma("unroll") for(int r=0;r<16;++r)sacc+=pB1[r]; l_reg+=sacc;
    pw0=(u32x4){PKW(pB0,0),PKW(pB0,2),PKW(pB0,4),PKW(pB0,6)};pw1=(u32x4){PKW(pB0,8),PKW(pB0,10),PKW(pB0,12),PKW(pB0,14)};pw2=(u32x4){PKW(pB1,0),PKW(pB1,2),PKW(pB1,4),PKW(pB1,6)};pw3=(u32x4){PKW(pB1,8),PKW(pB1,10),PKW(pB1,12),PKW(pB1,14)};
    SBAR(); pv(o,vb0+sl_cur,PAF(0),PAF(1),PAF(2),PAF(3)); }
  #undef PKW
  #undef PAF
  #undef VFR
  #undef PIN
  #undef MX3
  #undef GAPA
  #undef GAPB
  #undef EX
  #undef VRD
  #undef KRD
  #undef STEP
  #undef ENDW
  {auto rr=__builtin_amdgcn_permlane32_swap(__float_as_uint(l_reg),__float_as_uint(l_reg),false,false);l_reg=__uint_as_float(rr[0])+__uint_as_float(rr[1]);}
  if(hi==0)wsf[32+r32]=l_reg;asm volatile("s_waitcnt lgkmcnt(0)":::"memory");
  float rli[16];
  #pragma unroll
  for(int r=0;r<16;++r)rli[r]=__builtin_amdgcn_rcpf(wsf[32+crow(r,hi)]);
  bf16*Ow=O+(rowbase+q0+wid*QBLK)*DM+h*D;
  { bf16*stg=(bf16*)(shm+LDS_OST)+wid*2048;
    #pragma unroll
    for(int r=0;r<16;++r){const int orow=crow(r,hi);
      #pragma unroll
      for(int d0=0;d0<2;++d0)stg[orow*64+d0*32+r32]=__float2bfloat16(o[d0][r]*rli[r]);}
    asm volatile("s_waitcnt lgkmcnt(0)":::"memory");
    #pragma unroll
    for(int i=0;i<4;++i){const int row=i*8+(lane>>3),ch=lane&7; const u32x4 v=*(const u32x4*)(stg+row*64+ch*8); ATTN_STORE16(Ow+(long)row*DM+ch*8,v);} }
  asm volatile("s_waitcnt lgkmcnt(0)\n\ts_barrier":::"memory");
  #undef FINIT
  #undef DMA_K
  #undef DMA_V
  #undef CMASK
  #undef START
  #undef RESC
  #undef ROT
}
constexpr int ATTN_LDS_BYTES=LDS_BYTES;
#undef SBAR
#undef WAIT_BAR
}
#define GAS __attribute__((address_space(1)))
#define LAS __attribute__((address_space(3)))
typedef unsigned short bf16;
typedef unsigned v4u __attribute__((ext_vector_type(4)));
typedef float f32x4 __attribute__((ext_vector_type(4)));
typedef short bf16x8 __attribute__((ext_vector_type(8)));
typedef GAS unsigned gu32;
typedef GAS unsigned long long gu64;
#define RLX_AGENT __ATOMIC_RELAXED, __HIP_MEMORY_SCOPE_AGENT
#define LDS_WAIT() asm volatile("s_waitcnt lgkmcnt(0)" ::: "memory")
#define VM_WAIT() asm volatile("s_waitcnt vmcnt(0)" ::: "memory")
__device__ __forceinline__ unsigned long long rt() { return __builtin_amdgcn_s_memrealtime(); }
__device__ __forceinline__ unsigned f2bf(float f) { unsigned u = __builtin_bit_cast(unsigned, f); return (u + 0x7fffu + ((u >> 16) & 1u)) >> 16; }
__device__ __forceinline__ unsigned pk2(float lo, float hi) { return f2bf(lo) | (f2bf(hi) << 16); }

#define XB_TMO      128
#define XB_XCNT(j)  (256  + 64 * (j))
#define XB_XSUB(j)  (1280 + 64 * (j))
#define XB_XGEN(j)  (2304 + 64 * (j))
#define XB_TOP      3328
#define XB_TOPGEN   3392
#define XCD_BAR_WORDS 3456
#define XB_SPIN_CAP (1u << 18)

__device__ __forceinline__ unsigned xb_ld(unsigned* p)              { return __hip_atomic_load(p, __ATOMIC_RELAXED, __HIP_MEMORY_SCOPE_AGENT); }
__device__ __forceinline__ unsigned xb_add(unsigned* p, unsigned v) { return __hip_atomic_fetch_add(p, v, __ATOMIC_RELAXED, __HIP_MEMORY_SCOPE_AGENT); }
__device__ __forceinline__ unsigned xb_xcc_id() { return (unsigned)__builtin_amdgcn_s_getreg((3 << 11) | 20) & 0xFu; }
#define XB_SPIN(cond, bar) do { unsigned _sp = 0; while (cond) { __builtin_amdgcn_s_sleep(1); \
    if ((++_sp & 255u) == 0u) { if (xb_ld(&(bar)[XB_TMO])) break; if (_sp > XB_SPIN_CAP) { atomicAdd(&(bar)[XB_TMO], 1u); break; } } } } while (0)

struct XcdBarrier {
    unsigned* bar; unsigned x;
    volatile LAS unsigned* st;
};

__device__ __forceinline__ XcdBarrier xcd_barrier_post(unsigned* bar, volatile LAS unsigned* st) {
    XcdBarrier b; b.bar = bar; b.x = xb_xcc_id(); b.st = st;
    if (threadIdx.x == 0) (void)xb_add(&bar[XB_XCNT(b.x)], 1u);
    return b;
}
__device__ __forceinline__ void xcd_barrier_complete(unsigned* bar, unsigned x, unsigned& nloc, unsigned& nx) {
    const unsigned G = gridDim.x * gridDim.y * gridDim.z;
    unsigned sum, cnt, mine, sp = 0u;
    for (;;) {
        sum = 0u; cnt = 0u; mine = 0u;
#pragma unroll
        for (unsigned j = 0; j < 16; ++j) { const unsigned c = xb_ld(&bar[XB_XCNT(j)]); sum += c; cnt += (c > 0u) ? 1u : 0u; mine = (j == x) ? c : mine; }
        if (sum == G) break;
        __builtin_amdgcn_s_sleep(1);
        if ((++sp & 255u) == 0u) { if (xb_ld(&bar[XB_TMO])) break; if (sp > XB_SPIN_CAP) { atomicAdd(&bar[XB_TMO], 1u); break; } }
    }
    nloc = mine > 0u ? mine : 1u; nx = cnt > 0u ? cnt : 1u;
}

__device__ __forceinline__ void xcd_barrier(const XcdBarrier& b) {
    asm volatile("s_waitcnt vmcnt(0)" ::: "memory");
    __syncthreads();
    if (threadIdx.x == 0) {
        unsigned* bar = b.bar;
        __builtin_amdgcn_s_waitcnt(0);
        unsigned nloc = b.st[0], nx = b.st[1];
        if (nloc == 0u) { xcd_barrier_complete(bar, b.x, nloc, nx); b.st[0] = nloc; b.st[1] = nx; }
        const unsigned old = xb_add(&bar[XB_XSUB(b.x)], 1u);
        const unsigned gen = old / nloc;
        if (old + 1u == (gen + 1u) * nloc) {
            __builtin_amdgcn_fence(__ATOMIC_RELEASE, "agent");
            asm volatile("s_waitcnt vmcnt(0)" ::: "memory");
            const unsigned og = xb_add(&bar[XB_TOP], 1u);
            const unsigned tg = og / nx;
            if (og + 1u == (tg + 1u) * nx) xb_add(&bar[XB_TOPGEN], 1u);
            else XB_SPIN(xb_ld(&bar[XB_TOPGEN]) == tg, bar);
            __builtin_amdgcn_fence(__ATOMIC_ACQUIRE, "agent");
            xb_add(&bar[XB_XGEN(b.x)], 1u);
            asm volatile("s_waitcnt vmcnt(0)" ::: "memory");
        } else {
            XB_SPIN(xb_ld(&bar[XB_XGEN(b.x)]) == gen, bar);
            __builtin_amdgcn_fence(__ATOMIC_ACQUIRE, "agent");
            asm volatile("s_waitcnt vmcnt(0)" ::: "memory");
        }
    }
    __syncthreads();
}

constexpr size_t MiB = 1u << 20;
constexpr size_t SZB = (size_t)NTOK * DM * 2;
constexpr size_t WS_CTL = 0, CTL_ZERO_BYTES = 1 * MiB;
constexpr size_t WS_MOD = 1 * MiB;
constexpr size_t WS_LB = WS_MOD + 768 * 1024;
constexpr size_t WS_FP = 2 * MiB;
constexpr size_t WS_LS = 4 * MiB;
constexpr size_t WS_LIST = 6 * MiB;
constexpr size_t WS_ASGE = 10 * MiB;
constexpr size_t WS_ASGW = 10 * MiB + 512 * 1024;
constexpr size_t WS_WRT = 11 * MiB;
constexpr size_t WS_WAFT = 11 * MiB + 512 * 1024;
constexpr size_t WS_WIN = 12 * MiB;
constexpr size_t WS_WBR = WS_WIN + 72 * MiB;
constexpr size_t WS_WOUT = WS_WBR + 16 * MiB;
constexpr size_t WS_WGU = WS_WOUT + 8 * MiB;
constexpr size_t WS_WD = WS_WGU + 512 * MiB;
constexpr size_t WS_X1 = WS_WD + 256 * MiB;
constexpr size_t WS_HB = WS_X1 + 128 * MiB;
constexpr size_t WS_PROJ = WS_HB + 64 * MiB;
constexpr size_t WS_LF = WS_PROJ + 576 * MiB;
constexpr size_t WS_OAB = WS_LF + 128 * MiB;
constexpr size_t WS_HST = WS_OAB + 128 * MiB;
constexpr size_t WS_HTD = WS_HST + 12 * MiB;
constexpr size_t WS_EB = WS_HTD + 1 * MiB;
constexpr size_t WS_END = WS_EB + 6 * MiB;
constexpr size_t WS_Y = WS_PROJ;
constexpr size_t WS_MG = WS_PROJ + 2 * SZB;
constexpr int MOE_TILES_MAX = 544;
constexpr size_t WS_ACT = WS_PROJ;
constexpr size_t WS_YR = WS_PROJ + 272 * MiB;
static_assert(WS_YR + 272 * MiB <= WS_LF, "MoE buffers fit over the projection buffers");
static_assert(WS_END <= (size_t)2048 * MiB, "workspace map fits in 2 GiB");
constexpr int CW_BAR = 4096;
constexpr int CW_WQ = 8192;
constexpr int CW_NRM = 131072;
constexpr int CW_CNT = 16384;

constexpr int RING_OFF = 0, RING_BYTES = 131072;
constexpr int SPITCH = 1032;
constexpr int SCR_WAVE = 16640;
constexpr int TAB_OFF = 139264;
constexpr int T_MISC = TAB_OFF;
constexpr int T_TBASE = TAB_OFF + 256;
constexpr int T_CNT = TAB_OFF + 512;
constexpr int T_LCNT = TAB_OFF + 640;
constexpr int T_GBASE = TAB_OFF + 768;
constexpr int T_RT2E = TAB_OFF + 1024;
constexpr int T_ASG = TAB_OFF + 2048;
constexpr int PART_OFF = 147456;
constexpr int LDS_BYTES = 163840;
static_assert(8 * SCR_WAVE <= TAB_OFF && 8 * 4 * SPITCH * 4 <= TAB_OFF && T_ASG + 8 * 512 <= PART_OFF && PART_OFF + 16384 <= LDS_BYTES, "LDS map");

typedef float f32x2 __attribute__((ext_vector_type(2)));
typedef unsigned u32x2 __attribute__((ext_vector_type(2)));
typedef float f32x16 __attribute__((ext_vector_type(16)));
typedef short v4i16_t __attribute__((ext_vector_type(4)));
#define LDS_BARRIER() do { asm volatile("s_waitcnt lgkmcnt(0)" ::: "memory"); __builtin_amdgcn_s_barrier(); asm volatile("" ::: "memory"); } while (0)

__device__ __forceinline__ float wave_sum(float v) { return pg8::rows4_sum(pg8::row16_sum(v)); }
__device__ __forceinline__ void pair32(float& v, int& i) { auto a = __builtin_amdgcn_permlane32_swap(__float_as_uint(v), __float_as_uint(v), false, false); auto b = __builtin_amdgcn_permlane32_swap((unsigned)i, (unsigned)i, false, false);
    const float v0 = __uint_as_float(a[0]), v1 = __uint_as_float(a[1]); const int i0 = (int)b[0], i1 = (int)b[1]; const bool t = v1 > v0 || (v1 == v0 && i1 < i0); v = t ? v1 : v0; i = t ? i1 : i0; }
__device__ __forceinline__ void pair16(float& v, int& i) { auto a = __builtin_amdgcn_permlane16_swap(__float_as_uint(v), __float_as_uint(v), false, false); auto b = __builtin_amdgcn_permlane16_swap((unsigned)i, (unsigned)i, false, false);
    const float v0 = __uint_as_float(a[0]), v1 = __uint_as_float(a[1]); const int i0 = (int)b[0], i1 = (int)b[1]; const bool t = v1 > v0 || (v1 == v0 && i1 < i0); v = t ? v1 : v0; i = t ? i1 : i0; }
__device__ __forceinline__ unsigned pkbf(float lo, float hi) { return pg8::cvt_pk_bf16(lo, hi); }

struct TpRegs { f32x4 v[16]; };
__device__ __forceinline__ void tp_load(TpRegs& t, const float* __restrict__ src, int ld, int lane) {
#pragma unroll
    for (int i = 0; i < 16; ++i) { const int kk = 4 * i + (lane >> 4), nn = 4 * (lane & 15); t.v[i] = __builtin_nontemporal_load((const GAS f32x4*)(src + (size_t)kk * ld + nn)); }
}
__device__ __forceinline__ void tp_store(const TpRegs& t, bf16* __restrict__ dst, LAS float* scr, int lane) {
#pragma unroll
    for (int i = 0; i < 16; ++i) { const int kk = 4 * i + (lane >> 4), nn = 4 * (lane & 15);
        scr[(nn + 0) * 65 + kk] = t.v[i].x; scr[(nn + 1) * 65 + kk] = t.v[i].y; scr[(nn + 2) * 65 + kk] = t.v[i].z; scr[(nn + 3) * 65 + kk] = t.v[i].w; }
    LDS_WAIT(); asm volatile("" ::: "memory");
    const int kc = lane & 7;
#pragma unroll
    for (int i2 = 0; i2 < 8; ++i2) { const int n = (lane >> 3) + 8 * i2; const LAS float* s = scr + n * 65 + 8 * kc;
        v4u o; o.x = pkbf(s[0], s[1]); o.y = pkbf(s[2], s[3]); o.z = pkbf(s[4], s[5]); o.w = pkbf(s[6], s[7]);
        __builtin_nontemporal_store(o, (GAS v4u*)(dst + (size_t)n * DM + 8 * kc)); }
    LDS_WAIT(); asm volatile("" ::: "memory");
}
struct TpItem { const float* src; int ld; bf16* dst; };

struct Ptrs {
    const float *x, *c, *w_in, *fox_f_bias, *hg_lb_logits, *hg_norm_w, *w_branch, *w_out, *ada_w, *ada_b, *ln1_g, *ln1_b, *w_router, *b_router,
                *w_gate, *b_gate, *w_up, *b_up, *w_down, *b_down, *ln2_g, *ln2_b;
    float* out; unsigned char* ws;
};

__device__ __forceinline__ void p0_prologue(const Ptrs& P, LAS unsigned char* lds, int G, const int wv) {
    int tid_ = wv * 64 + (int)__builtin_amdgcn_mbcnt_hi(~0u, __builtin_amdgcn_mbcnt_lo(~0u, 0u)); asm volatile("" : "+v"(tid_)); const int tid = tid_, lane = tid & 63, wave = __builtin_amdgcn_readfirstlane(tid >> 6);
    unsigned char* ws = P.ws;
    {
        LAS float* cact = (LAS float*)(lds);
        LAS float* part = (LAS float*)(lds + 32768);
        for (int idx = tid; idx < NB * DM; idx += 512) { const int b = idx >> 10, k = idx & 1023; const float v = P.c[idx]; cact[k * 8 + b] = v / (1.0f + __expf(-v)); }
        __syncthreads();
        float* MOD = (float*)(ws + WS_MOD);
        for (int u = blockIdx.x; u < NLAYER * 96; u += G) {
            const int l = u / 96, cc = u % 96, col = cc * 64 + lane;
            const float* wp = P.ada_w + ((size_t)l * DM + wave * 128) * 6144 + col;
            float acc[8];
#pragma unroll
            for (int b = 0; b < 8; ++b) acc[b] = 0.f;
#pragma unroll 8
            for (int k = 0; k < 128; ++k) { const float wv = wp[(size_t)k * 6144]; const f32x4 c0 = *(const LAS f32x4*)(cact + (wave * 128 + k) * 8), c1 = *(const LAS f32x4*)(cact + (wave * 128 + k) * 8 + 4);
                acc[0] += c0.x * wv; acc[1] += c0.y * wv; acc[2] += c0.z * wv; acc[3] += c0.w * wv; acc[4] += c1.x * wv; acc[5] += c1.y * wv; acc[6] += c1.z * wv; acc[7] += c1.w * wv; }
#pragma unroll
            for (int b = 0; b < 8; ++b) part[(wave * 8 + b) * 64 + lane] = acc[b];
            __syncthreads();
            { const int b = tid >> 6; float s = 0.f;
#pragma unroll
              for (int w = 0; w < 8; ++w) s += part[(w * 8 + b) * 64 + lane];
              MOD[((size_t)l * NB + b) * 6144 + col] = s + P.ada_b[(size_t)l * 6144 + col]; }
            __syncthreads();
        }
    }
    if (blockIdx.x == G - 1) {
        float* LB = (float*)(ws + WS_LB);
        for (int d = tid; d < DM; d += 512) {
            const float a0 = P.hg_lb_logits[d], a1 = P.hg_lb_logits[DM + d], a2 = P.hg_lb_logits[2 * DM + d], a3 = P.hg_lb_logits[3 * DM + d];
            const float mx = fmaxf(fmaxf(a0, a1), fmaxf(a2, a3));
            const float e0 = expf(a0 - mx), e1 = expf(a1 - mx), e2 = expf(a2 - mx), e3 = expf(a3 - mx), inv = 1.0f / (e0 + e1 + e2 + e3);
            const float p1 = e1 * inv, p2 = e2 * inv, p3 = e3 * inv;
            LB[d] = 0.f; LB[DM + d] = fminf(fmaxf(p1, 0.f), 1.f); LB[2 * DM + d] = fminf(fmaxf(p1 + p2, 0.f), 1.f); LB[3 * DM + d] = fminf(fmaxf(p1 + p2 + p3, 0.f), 1.f);
        }
    }
    {
        bf16* WRT = (bf16*)(ws + WS_WRT); bf16* WAFT = (bf16*)(ws + WS_WAFT);
        for (int idx = blockIdx.x * 512 + tid; idx < NLAYER * (NEXP + 16) * DM; idx += G * 512) {
            const int l = idx / ((NEXP + 16) * DM), r = idx % ((NEXP + 16) * DM), n = r / DM, k = r % DM;
            const float w = n < NEXP ? P.w_router[((size_t)l * DM + k) * NEXP + n] : P.w_in[((size_t)l * DM + k) * PIN + 7168 + (n - NEXP)];
            const unsigned hb = f2bf(w); const float hf = __uint_as_float(hb << 16); const unsigned lb_ = f2bf(w - hf);
            if (n < NEXP) { WRT[(((size_t)l * 2 + 0) * NEXP + n) * DM + k] = (bf16)hb; WRT[(((size_t)l * 2 + 1) * NEXP + n) * DM + k] = (bf16)lb_; }
            else { WAFT[(((size_t)l * 2 + 0) * 16 + (n - NEXP)) * DM + k] = (bf16)hb; WAFT[(((size_t)l * 2 + 1) * 16 + (n - NEXP)) * DM + k] = (bf16)lb_; }
        }
    }
    __syncthreads();
    {
        LAS float* scr = (LAS float*)(lds + wave * SCR_WAVE);
        const int gw = blockIdx.x * 8 + wave, NGW = G * 8;
        constexpr int I_IN1 = 16 * 112, I_IN2 = 16 * 32, I_BR = 2 * 256, I_OUT = 256, I_EXP = 768, I_MOE = NEXP * I_EXP;
        constexpr int I_LAYER = I_IN1 + I_IN2 + I_BR + I_OUT + I_MOE, I_ALL = NLAYER * I_LAYER;
        auto decode = [&](int it) -> TpItem {
            const int l = it / I_LAYER; int r = it % I_LAYER; TpItem t;
            if (r < I_IN1) { const int kb = r / 112, nb = r % 112;
                const int n0 = nb * 64, drow = n0 < 1024 ? 256 * (n0 >> 7) + (n0 & 127) : (n0 < 2048 ? 256 * ((n0 - 1024) >> 7) + 128 + (n0 & 127) : n0);
                t.src = P.w_in + ((size_t)l * DM + kb * 64) * PIN + n0; t.ld = PIN; t.dst = (bf16*)(ws + WS_WIN) + ((size_t)l * NPROJ + drow) * DM + kb * 64; return t; }
            r -= I_IN1;
            if (r < I_IN2) { const int kb = r / 32, nb = r % 32;
                t.src = P.w_in + ((size_t)l * DM + kb * 64) * PIN + 7184 + nb * 64; t.ld = PIN; t.dst = (bf16*)(ws + WS_WIN) + ((size_t)l * NPROJ + 7168 + nb * 64) * DM + kb * 64; return t; }
            r -= I_IN2;
            if (r < I_BR) { const int half = r / 256, q = r % 256, kb = q / 16, nb = q % 16;
                t.src = P.w_branch + ((size_t)l * 2048 + half * 1024 + kb * 64) * DM + nb * 64; t.ld = DM; t.dst = (bf16*)(ws + WS_WBR) + (((size_t)l * 2 + half) * DM + nb * 64) * DM + kb * 64; return t; }
            r -= I_BR;
            if (r < I_OUT) { const int kb = r / 16, nb = r % 16;
                t.src = P.w_out + ((size_t)l * DM + kb * 64) * DM + nb * 64; t.ld = DM; t.dst = (bf16*)(ws + WS_WOUT) + ((size_t)l * DM + nb * 64) * DM + kb * 64; return t; }
            r -= I_OUT;
            const int e = r / I_EXP, q = r % I_EXP, which = q / 256, q2 = q % 256, kb = q2 / 16, nb = q2 % 16;
            const size_t le = (size_t)l * NEXP + e; t.ld = DM;
            if (which == 0) { t.src = P.w_gate + (le * DM + kb * 64) * DM + nb * 64; t.dst = (bf16*)(ws + WS_WGU) + (le * 2048 + 256 * (nb >> 1) + 64 * (nb & 1)) * DM + kb * 64; }
            else if (which == 1) { t.src = P.w_up + (le * DM + kb * 64) * DM + nb * 64; t.dst = (bf16*)(ws + WS_WGU) + (le * 2048 + 256 * (nb >> 1) + 128 + 64 * (nb & 1)) * DM + kb * 64; }
            else { t.src = P.w_down + (le * DM + kb * 64) * DM + nb * 64; t.dst = (bf16*)(ws + WS_WD) + (le * DM + nb * 64) * DM + kb * 64; }
            return t;
        };
        TpRegs cur, nxt; TpItem ci, ni;
        int it = gw;
        if (it < I_ALL) { ci = decode(it); tp_load(cur, ci.src, ci.ld, lane); }
        for (; it < I_ALL; it += NGW) {
            const bool more = it + NGW < I_ALL;
            if (more) { ni = decode(it + NGW); tp_load(nxt, ni.src, ni.ld, lane); }
            tp_store(cur, ci.dst, scr, lane);
            if (more) { cur = nxt; ci = ni; }
        }
    }
    __syncthreads();
}

struct RowV { f32x4 v[4]; };
__device__ __forceinline__ RowV ld_row(const float* p, int lane) { RowV r; const GAS f32x4* q = (const GAS f32x4*)p + lane;
#pragma unroll
    for (int j = 0; j < 4; ++j) r.v[j] = q[64 * j];
    return r; }
struct RowB { u32x2 v[4]; };
__device__ __forceinline__ RowB ld_row_bf16(const bf16* p, int lane) { RowB r; const GAS u32x2* q = (const GAS u32x2*)p + lane;
#pragma unroll
    for (int j = 0; j < 4; ++j) r.v[j] = q[64 * j];
    return r; }
__device__ __forceinline__ RowV row_b2f(const RowB& b) { RowV r;
#pragma unroll
    for (int j = 0; j < 4; ++j) r.v[j] = (f32x4){pg8::bf_lo(b.v[j].x), pg8::bf_hi(b.v[j].x), pg8::bf_lo(b.v[j].y), pg8::bf_hi(b.v[j].y)};
    return r; }
__device__ __forceinline__ RowV ld_row_nt(const float* p, int lane) { RowV r; const GAS f32x4* q = (const GAS f32x4*)p + lane;
#pragma unroll
    for (int j = 0; j < 4; ++j) r.v[j] = __builtin_nontemporal_load(q + 64 * j);
    return r; }
__device__ __forceinline__ RowB ld_row_bf16_nt(const bf16* p, int lane) { RowB r; const GAS u32x2* q = (const GAS u32x2*)p + lane;
#pragma unroll
    for (int j = 0; j < 4; ++j) r.v[j] = __builtin_nontemporal_load(q + 64 * j);
    return r; }
__device__ __forceinline__ void st_row_nt(float* p, int lane, const RowV& r) { GAS f32x4* q = (GAS f32x4*)p + lane;
#pragma unroll
    for (int j = 0; j < 4; ++j) __builtin_nontemporal_store(r.v[j], q + 64 * j); }
__device__ __forceinline__ void st_row_bf16_nt(bf16* p, int lane, const RowV& r) { GAS u32x2* q = (GAS u32x2*)p + lane;
#pragma unroll
    for (int j = 0; j < 4; ++j) { u32x2 w; w.x = pkbf(r.v[j].x, r.v[j].y); w.y = pkbf(r.v[j].z, r.v[j].w); __builtin_nontemporal_store(w, q + 64 * j); } }
__device__ __forceinline__ void st_row(float* p, int lane, const RowV& r) { GAS f32x4* q = (GAS f32x4*)p + lane;
#pragma unroll
    for (int j = 0; j < 4; ++j) q[64 * j] = r.v[j]; }
__device__ __forceinline__ void st_row_bf16(bf16* p, int lane, const RowV& r) { GAS u32x2* q = (GAS u32x2*)p + lane;
#pragma unroll
    for (int j = 0; j < 4; ++j) { u32x2 w; w.x = pkbf(r.v[j].x, r.v[j].y); w.y = pkbf(r.v[j].z, r.v[j].w); q[64 * j] = w; } }
__device__ __forceinline__ void st_row_lds(LAS float* p, int lane, const RowV& r) { LAS f32x4* q = (LAS f32x4*)p + lane;
#pragma unroll
    for (int j = 0; j < 4; ++j) q[64 * j] = r.v[j]; }
__device__ __forceinline__ void ln_stats(const RowV& r, float& mean, float& rstd, float eps) {
    float s = 0.f;
#pragma unroll
    for (int j = 0; j < 4; ++j) s += (r.v[j].x + r.v[j].y) + (r.v[j].z + r.v[j].w);
    mean = wave_sum(s) * (1.0f / DM); float q = 0.f;
#pragma unroll
    for (int j = 0; j < 4; ++j) { const f32x4 d = r.v[j] - mean; q += (d.x * d.x + d.y * d.y) + (d.z * d.z + d.w * d.w); }
    rstd = 1.0f / sqrtf(wave_sum(q) * (1.0f / DM) + eps);
}
__device__ __forceinline__ float log_sigmoid(float x) { return fminf(x, 0.f) - log1pf(expf(-fabsf(x))); }
template <int NT>
__device__ __forceinline__ void dots_partial(const LAS float* stage0, const bf16* __restrict__ whi, const bf16* __restrict__ wlo, LAS f32x4* part, int wave, int lane) {
    const int rt = wave & 1, kq = wave >> 1, fr = lane & 15, fq = lane >> 4; const LAS float* hp = stage0 + (16 * rt + fr) * SPITCH + 256 * kq + 8 * fq;
    f32x4 acc[NT];
#pragma unroll
    for (int t = 0; t < NT; ++t) acc[t] = (f32x4){0.f, 0.f, 0.f, 0.f};
    const bf16* wh = whi + (size_t)fr * DM + 256 * kq + 8 * fq; const bf16* wl = wlo + (size_t)fr * DM + 256 * kq + 8 * fq;
#pragma unroll
    for (int s = 0; s < 8; ++s) {
        const f32x4 h0 = *(const LAS f32x4*)(hp + 32 * s), h1 = *(const LAS f32x4*)(hp + 32 * s + 4);
        v4u hi; hi.x = pkbf(h0.x, h0.y); hi.y = pkbf(h0.z, h0.w); hi.z = pkbf(h1.x, h1.y); hi.w = pkbf(h1.z, h1.w);
        v4u lo; lo.x = pkbf(h0.x - pg8::bf_lo(hi.x), h0.y - pg8::bf_hi(hi.x)); lo.y = pkbf(h0.z - pg8::bf_lo(hi.y), h0.w - pg8::bf_hi(hi.y));
        lo.z = pkbf(h1.x - pg8::bf_lo(hi.z), h1.y - pg8::bf_hi(hi.z)); lo.w = pkbf(h1.z - pg8::bf_lo(hi.w), h1.w - pg8::bf_hi(hi.w));
        const bf16x8 hhi = __builtin_bit_cast(bf16x8, hi), hlo = __builtin_bit_cast(bf16x8, lo);
#pragma unroll
        for (int t = 0; t < NT; ++t) {
            const bf16x8 a_hi = *(const GAS bf16x8*)(wh + (size_t)t * 16 * DM + 32 * s), a_lo = *(const GAS bf16x8*)(wl + (size_t)t * 16 * DM + 32 * s);
            acc[t] = __builtin_amdgcn_mfma_f32_16x16x32_bf16(a_hi, hhi, acc[t], 0, 0, 0);
            acc[t] = __builtin_amdgcn_mfma_f32_16x16x32_bf16(a_hi, hlo, acc[t], 0, 0, 0);
            acc[t] = __builtin_amdgcn_mfma_f32_16x16x32_bf16(a_lo, hhi, acc[t], 0, 0, 0);
        }
    }
#pragma unroll
    for (int t = 0; t < NT; ++t) part[((kq * 2 + rt) * NT + t) * 64 + lane] = acc[t];
}
template <int NT>
__device__ __forceinline__ void dots_final(const LAS f32x4* part, f32x4 (&out)[NT], int rt, int lane) {
#pragma unroll
    for (int t = 0; t < NT; ++t) { f32x4 a = part[((0 * 2 + rt) * NT + t) * 64 + lane];
#pragma unroll
        for (int kq = 1; kq < 4; ++kq) a += part[((kq * 2 + rt) * NT + t) * 64 + lane];
        out[t] = a; }
}
__device__ __forceinline__ int staged_tok(int j, int it, int RPW) { return (blockIdx.x * 8 + (j >> 2)) * RPW + 4 * it + (j & 3); }
__device__ __forceinline__ void af_block(LAS unsigned char* lds, const bf16* __restrict__ waft, const float* __restrict__ fbias, float* LS, int it, int RPW, int wave, int lane) {
    LAS f32x4* part = (LAS f32x4*)(lds + PART_OFF);
    dots_partial<1>((const LAS float*)lds, waft, waft + 16 * DM, part, wave, lane);
    LDS_BARRIER();
    if (wave < 2) { f32x4 acc[1]; dots_final<1>(part, acc, wave, lane);
        const int fr = lane & 15, fq = lane >> 4; const f32x4 bv = *(const GAS f32x4*)(fbias + 4 * fq);
        *(GAS f32x4*)(LS + (size_t)staged_tok(16 * wave + fr, it, RPW) * 16 + 4 * fq) = (f32x4){log_sigmoid(acc[0].x + bv.x), log_sigmoid(acc[0].y + bv.y), log_sigmoid(acc[0].z + bv.z), log_sigmoid(acc[0].w + bv.w)}; }
}

__device__ __forceinline__ void phase_a0(const Ptrs& P, LAS unsigned char* lds, int G, const int wv) {
    int tid_ = wv * 64 + (int)__builtin_amdgcn_mbcnt_hi(~0u, __builtin_amdgcn_mbcnt_lo(~0u, 0u)); asm volatile("" : "+v"(tid_)); const int tid = tid_, lane = tid & 63, wave = __builtin_amdgcn_readfirstlane(tid >> 6); (void)tid;
    unsigned char* ws = P.ws; const int RPW = NTOK / (G * 8); const int m0 = (blockIdx.x * 8 + wave) * RPW, b = m0 / SEQL;
    const float* MOD = (const float*)(ws + WS_MOD) + (size_t)(0 * NB + b) * 6144;
    const RowV sh1 = ld_row(MOD, lane), sc1 = ld_row(MOD + DM, lane);
    LAS float* stage = (LAS float*)(lds + wave * (4 * SPITCH * 4));
    RowV xnext = ld_row_nt(P.x + (size_t)m0 * DM, lane);
    for (int rg = 0; rg < RPW / 4; ++rg) {
        for (int r = 0; r < 4; ++r) { const int m = m0 + rg * 4 + r; RowV xv = xnext;
            if (rg * 4 + r + 1 < RPW) xnext = ld_row_nt(P.x + (size_t)(m + 1) * DM, lane);
#pragma unroll
            for (int j = 0; j < 4; ++j) xv.v[j] = xv.v[j] * (sc1.v[j] + 1.0f) + sh1.v[j];
            st_row_bf16((bf16*)(ws + WS_HB) + (size_t)m * DM, lane, xv); st_row_lds(stage + r * SPITCH, lane, xv); }
        LDS_BARRIER();
        af_block(lds, (const bf16*)(ws + WS_WAFT), P.fox_f_bias, (float*)(ws + WS_LS), rg, RPW, wave, lane);
        LDS_BARRIER();
    }
}

__device__ __forceinline__ void phase_f(const Ptrs& P, LAS unsigned char* lds, int l, const float* xcur, int G, const int wv, bool build_lists = true) {
    int tid_ = wv * 64 + (int)__builtin_amdgcn_mbcnt_hi(~0u, __builtin_amdgcn_mbcnt_lo(~0u, 0u)); asm volatile("" : "+v"(tid_)); const int tid = tid_, lane = tid & 63, wave = __builtin_amdgcn_readfirstlane(tid >> 6);
    unsigned char* ws = P.ws; const int RPW = NTOK / (G * 8); const int m0 = (blockIdx.x * 8 + wave) * RPW, b = m0 / SEQL;
    LAS int* lcnt = (LAS int*)(lds + T_LCNT); LAS int* gbase = (LAS int*)(lds + T_GBASE);
    LAS int* aE = (LAS int*)(lds + T_ASG); LAS float* aW = (LAS float*)(lds + T_ASG + 2048);
    if (tid < 32) lcnt[tid] = 0;
    __syncthreads();
    {
        const float* MOD = (const float*)(ws + WS_MOD) + (size_t)(l * NB + b) * 6144;
        const RowV g1 = ld_row(MOD + 2 * DM, lane), sh2 = ld_row(MOD + 3 * DM, lane), sc2 = ld_row(MOD + 4 * DM, lane);
        const RowV lng = ld_row(P.ln1_g + (size_t)l * DM, lane), lnb = ld_row(P.ln1_b + (size_t)l * DM, lane);
        LAS float* stage = (LAS float*)(lds + wave * (4 * SPITCH * 4));
        const bf16* wrt = (const bf16*)(ws + WS_WRT) + (size_t)l * 2 * NEXP * DM; const float* br = P.b_router + (size_t)l * NEXP;
        const bf16* Y = (const bf16*)(ws + WS_Y);
        RowV xnext = ld_row_nt(xcur + (size_t)m0 * DM, lane); RowB ynext = ld_row_bf16_nt(Y + (size_t)m0 * DM, lane);
        for (int rg = 0; rg < RPW / 4; ++rg) {
            for (int r = 0; r < 4; ++r) { const int m = m0 + rg * 4 + r;
                RowV xv = xnext; const RowV yv = row_b2f(ynext);
                if (rg * 4 + r + 1 < RPW) { xnext = ld_row_nt(xcur + (size_t)(m + 1) * DM, lane); ynext = ld_row_bf16_nt(Y + (size_t)(m + 1) * DM, lane); }
#pragma unroll
                for (int j = 0; j < 4; ++j) xv.v[j] = xv.v[j] * DN_ALPHA + (g1.v[j] + 1.0f) * yv.v[j];
                float mean, rstd; ln_stats(xv, mean, rstd, 1e-5f);
#pragma unroll
                for (int j = 0; j < 4; ++j) xv.v[j] = (xv.v[j] - mean) * rstd * lng.v[j] + lnb.v[j];
                st_row_bf16_nt((bf16*)(ws + WS_X1) + (size_t)m * DM, lane, xv);
#pragma unroll
                for (int j = 0; j < 4; ++j) xv.v[j] = xv.v[j] * (sc2.v[j] + 1.0f) + sh2.v[j];
                st_row_bf16((bf16*)(ws + WS_HB) + (size_t)m * DM, lane, xv); st_row_lds(stage + r * SPITCH, lane, xv); }
            LDS_BARRIER();
            LAS f32x4* part = (LAS f32x4*)(lds + PART_OFF);
            dots_partial<2>((const LAS float*)lds, wrt, wrt + (size_t)NEXP * DM, part, wave, lane);
            LDS_BARRIER();
            if (wave < 2) {
                f32x4 lg[2]; dots_final<2>(part, lg, wave, lane);
                const int fr = lane & 15, fq = lane >> 4;
                float cv[8]; int ci[8];
                { const f32x4 b0 = *(const GAS f32x4*)(br + 4 * fq), b1 = *(const GAS f32x4*)(br + 16 + 4 * fq);
#pragma unroll
                  for (int i = 0; i < 4; ++i) { cv[i] = lg[0][i] + b0[i]; ci[i] = 4 * fq + i; cv[4 + i] = lg[1][i] + b1[i]; ci[4 + i] = 16 + 4 * fq + i; } }
                float tv[4]; int ti[4];
#pragma unroll
                for (int k = 0; k < 4; ++k) {
                    float bv = cv[0]; int bi = ci[0];
#pragma unroll
                    for (int i = 1; i < 8; ++i) if (cv[i] > bv) { bv = cv[i]; bi = ci[i]; }
                    pair16(bv, bi); pair32(bv, bi);
                    tv[k] = bv; ti[k] = bi;
#pragma unroll
                    for (int i = 0; i < 8; ++i) if (ci[i] == bi) cv[i] = -INFINITY;
                }
                const float e1 = expf(tv[1] - tv[0]), e2 = expf(tv[2] - tv[0]), e3 = expf(tv[3] - tv[0]), inv = 1.0f / (1.0f + e1 + e2 + e3);
                const int slot = rg * 128 + (16 * wave + fr) * 4;
                if (fq == 0) { aE[slot] = ti[0]; aW[slot] = inv; } else if (fq == 1) { aE[slot + 1] = ti[1]; aW[slot + 1] = e1 * inv; }
                else if (fq == 2) { aE[slot + 2] = ti[2]; aW[slot + 2] = e2 * inv; } else { aE[slot + 3] = ti[3]; aW[slot + 3] = e3 * inv; }
            }
            LDS_BARRIER();
        }
    }
    if (!build_lists) { __syncthreads(); return; }
    const int nasg = RPW * 32; int e = 0, lpos = 0; float w = 0.f;
    if (tid < nasg) { e = aE[tid]; w = aW[tid]; lpos = __hip_atomic_fetch_add(lcnt + e, 1, __ATOMIC_RELAXED, __HIP_MEMORY_SCOPE_WORKGROUP); }
    __syncthreads();
    if (tid < 32) { const int n = lcnt[tid]; gbase[tid] = n ? (int)__hip_atomic_fetch_add((unsigned*)(ws + WS_CTL) + CW_CNT + (l * NEXP + tid) * 64, (unsigned)n, __ATOMIC_RELAXED, __HIP_MEMORY_SCOPE_AGENT) : 0; }
    __syncthreads();
    if (tid < nasg) { const int pos = gbase[e] + lpos, tok = staged_tok((tid >> 2) & 31, tid >> 7, RPW);
        ((int*)(ws + WS_LIST))[(size_t)e * NTOK + pos] = tok; ((int*)(ws + WS_ASGE))[(size_t)tok * 4 + (tid & 3)] = (e << 16) | pos; ((float*)(ws + WS_ASGW))[(size_t)tok * 4 + (tid & 3)] = w; }
}

__device__ __forceinline__ int moe_tables(const Ptrs& P, LAS unsigned char* lds, int l, const int wv) {
    int tid_ = wv * 64 + (int)__builtin_amdgcn_mbcnt_hi(~0u, __builtin_amdgcn_mbcnt_lo(~0u, 0u)); asm volatile("" : "+v"(tid_)); const int tid = tid_;
    LAS int* tbase = (LAS int*)(lds + T_TBASE); LAS int* cnt = (LAS int*)(lds + T_CNT); LAS unsigned char* rt2e = (LAS unsigned char*)(lds + T_RT2E);
    __syncthreads();
    if (tid < 32) cnt[tid] = (int)__hip_atomic_load((unsigned*)(P.ws + WS_CTL) + CW_CNT + (l * NEXP + tid) * 64, __ATOMIC_RELAXED, __HIP_MEMORY_SCOPE_AGENT);
    __syncthreads();
    if (tid == 0) { int s = 0; for (int e = 0; e < NEXP; ++e) { tbase[e] = s; s += (cnt[e] + 255) >> 8; } tbase[NEXP] = s; }
    __syncthreads();
    if (tid < 32) { for (int rt = tbase[tid]; rt < tbase[tid + 1]; ++rt) rt2e[rt] = (unsigned char)tid; }
    __syncthreads();
    return tbase[NEXP];
}

__device__ __forceinline__ void phase_j(const Ptrs& P, LAS unsigned char* lds, int l, int G, const int wv) {
    int tid_ = wv * 64 + (int)__builtin_amdgcn_mbcnt_hi(~0u, __builtin_amdgcn_mbcnt_lo(~0u, 0u)); asm volatile("" : "+v"(tid_)); const int tid = tid_, lane = tid & 63, wave = __builtin_amdgcn_readfirstlane(tid >> 6); (void)tid;
    unsigned char* ws = P.ws; const int RPW = NTOK / (G * 8); const int m0 = (blockIdx.x * 8 + wave) * RPW, b = m0 / SEQL;
    const LAS int* tbase = (const LAS int*)(lds + T_TBASE);
    const float* MOD = (const float*)(ws + WS_MOD) + (size_t)(l * NB + b) * 6144;
    const RowV g2 = ld_row(MOD + 5 * DM, lane);
    const RowV lng = ld_row(P.ln2_g + (size_t)l * DM, lane), lnb = ld_row(P.ln2_b + (size_t)l * DM, lane);
    const bool more = l + 1 < NLAYER;
    RowV sh1, sc1;
    { const float* MODN = (const float*)(ws + WS_MOD) + (size_t)((more ? l + 1 : l) * NB + b) * 6144; sh1 = ld_row(MODN, lane); sc1 = ld_row(MODN + DM, lane); }
    LAS float* stage = (LAS float*)(lds + wave * (4 * SPITCH * 4));
    const bf16* YR = (const bf16*)(ws + WS_YR); const bf16* X1 = (const bf16*)(ws + WS_X1);
    const unsigned asge = ((const unsigned*)(ws + WS_ASGE))[(size_t)m0 * 4 + lane]; const float asgw = ((const float*)(ws + WS_ASGW))[(size_t)m0 * 4 + lane];
    struct JRow { u32x2 y[4][4]; RowB x; };
    auto jload = [&](int i, JRow& R) {
#pragma unroll
        for (int k = 0; k < 4; ++k) { const unsigned a = __builtin_amdgcn_readlane(asge, 4 * i + k); const int e = (int)(a >> 16), pos = (int)(a & 0xffffu); const size_t slot = (size_t)tbase[e] * 256 + pos;
            const GAS u32x2* q = (const GAS u32x2*)(YR + slot * DM) + lane;
#pragma unroll
            for (int j = 0; j < 4; ++j) R.y[k][j] = __builtin_nontemporal_load(q + 64 * j); }
        R.x = ld_row_bf16_nt(X1 + (size_t)(m0 + i) * DM, lane);
    };
    JRow rnext; jload(0, rnext);
    for (int rg = 0; rg < RPW / 4; ++rg) {
        for (int r = 0; r < 4; ++r) { const int i = rg * 4 + r, m = m0 + i;
            const JRow rc = rnext;
            if (i + 1 < RPW) jload(i + 1, rnext);
            RowV y;
#pragma unroll
            for (int j = 0; j < 4; ++j) y.v[j] = (f32x4){0.f, 0.f, 0.f, 0.f};
#pragma unroll
            for (int k = 0; k < 4; ++k) { const float wk = __uint_as_float(__builtin_amdgcn_readlane(__float_as_uint(asgw), 4 * i + k));
#pragma unroll
                for (int j = 0; j < 4; ++j) { const u32x2 t = rc.y[k][j]; y.v[j].x += wk * pg8::bf_lo(t.x); y.v[j].y += wk * pg8::bf_hi(t.x); y.v[j].z += wk * pg8::bf_lo(t.y); y.v[j].w += wk * pg8::bf_hi(t.y); } }
            RowV xv = row_b2f(rc.x);
#pragma unroll
            for (int j = 0; j < 4; ++j) xv.v[j] = xv.v[j] * DN_ALPHA + (g2.v[j] + 1.0f) * y.v[j];
            float mean, rstd; ln_stats(xv, mean, rstd, 1e-5f);
#pragma unroll
            for (int j = 0; j < 4; ++j) xv.v[j] = (xv.v[j] - mean) * rstd * lng.v[j] + lnb.v[j];
            st_row_nt(P.out + (size_t)m * DM, lane, xv);
            if (more) {
#pragma unroll
                for (int j = 0; j < 4; ++j) xv.v[j] = xv.v[j] * (sc1.v[j] + 1.0f) + sh1.v[j];
                st_row_bf16((bf16*)(ws + WS_HB) + (size_t)m * DM, lane, xv); st_row_lds(stage + r * SPITCH, lane, xv); }
        }
        if (more) {
            LDS_BARRIER();
            af_block(lds, (const bf16*)(ws + WS_WAFT) + (size_t)(l + 1) * 2 * 16 * DM, P.fox_f_bias + (l + 1) * 16, (float*)(ws + WS_LS), rg, RPW, wave, lane);
            LDS_BARRIER();
        }
    }
}

__device__ __forceinline__ void fscan(const Ptrs& P, LAS unsigned char* lds, const int wv) {
    int tid_ = wv * 64 + (int)__builtin_amdgcn_mbcnt_hi(~0u, __builtin_amdgcn_mbcnt_lo(~0u, 0u)); asm volatile("" : "+v"(tid_)); const int tid = tid_, lane = tid & 63, wave = __builtin_amdgcn_readfirstlane(tid >> 6);
    const int bh = blockIdx.x >> 1, hf = blockIdx.x & 1, b = bh >> 4, h = bh & 15;
    const float* LS = (const float*)(P.ws + WS_LS) + ((size_t)b * SEQL + 2048 * hf + 4 * tid) * 16 + h; float* FP = (float*)(P.ws + WS_FP) + (size_t)bh * SEQL + 2048 * hf + 4 * tid;
    LAS float* wt = (LAS float*)(lds);
    float v[4], pre = 0.f;
#pragma unroll
    for (int j = 0; j < 4; ++j) v[j] = LS[j * 16];
    if (hf) { const float* L0 = (const float*)(P.ws + WS_LS) + ((size_t)b * SEQL + 4 * tid) * 16 + h; pre = (L0[0] + L0[16]) + (L0[32] + L0[48]); }
#pragma unroll
    for (int j = 1; j < 4; ++j) v[j] += v[j - 1];
    pre = wave_sum(pre);
    float inc = v[3];
    { const float rs = pg8::row16_scan(inc), rt = pg8::row16_sum(inc);
      const float r0 = __uint_as_float(__builtin_amdgcn_readlane(__float_as_uint(rt), 15)), r1 = __uint_as_float(__builtin_amdgcn_readlane(__float_as_uint(rt), 31)), r2 = __uint_as_float(__builtin_amdgcn_readlane(__float_as_uint(rt), 47));
      inc = rs + (lane >= 16 ? r0 : 0.f) + (lane >= 32 ? r1 : 0.f) + (lane >= 48 ? r2 : 0.f); }
    if (lane == 63) { wt[wave] = inc; wt[8 + wave] = pre; }
    __syncthreads();
    float off = inc - v[3];
    for (int w = 0; w < wave; ++w) off += wt[w];
    for (int w = 0; w < 8; ++w) off += wt[8 + w];
    *(GAS f32x4*)(FP) = (f32x4){(off + v[0]) * LOG2E, (off + v[1]) * LOG2E, (off + v[2]) * LOG2E, (off + v[3]) * LOG2E};
    __syncthreads();
}

namespace hg {
constexpr int L_QP = 0, L_KP = 16384, L_IV = 32768, L_SP = 49152, L_PM = 81920, L_O = 91136, L_TOT = 123904, L_EBM = 128000, L_EBL = 128512;
constexpr int PM_PITCH = 144;
static_assert(L_EBL + 512 <= RING_BYTES, "HGRN LDS map");
__device__ __forceinline__ int off_b(int row, int ch) { return 256 * row + 16 * (ch ^ (((row & 3) << 2) | ((row >> 2) & 3))); }
__device__ __forceinline__ bf16x8 row_frag(const LAS unsigned char* img, int row0, int s, int lane) { return *(const LAS bf16x8*)(img + off_b(row0 + (lane & 31), 2 * s + (lane >> 5))); }
__device__ __forceinline__ bf16x8 tr_frag(const LAS unsigned char* img, int c, int ks, int lane) {
    const int hh = lane >> 5, blk = (lane >> 4) & 1, q = (lane & 15) >> 2, p = lane & 3;
    const LAS unsigned char* a0 = img + off_b(16 * ks + 8 * hh + q, 4 * c + 2 * blk + (p >> 1)) + 8 * (p & 1);
    const LAS unsigned char* a1 = img + off_b(16 * ks + 8 * hh + 4 + q, 4 * c + 2 * blk + (p >> 1)) + 8 * (p & 1);
    const v4i16_t lo = __builtin_amdgcn_ds_read_tr16_b64_v4i16((LAS v4i16_t*)a0), hi = __builtin_amdgcn_ds_read_tr16_b64_v4i16((LAS v4i16_t*)a1);
    return (bf16x8){lo[0], lo[1], lo[2], lo[3], hi[0], hi[1], hi[2], hi[3]};
}
#define HG_MFMA(a, b, c) __builtin_amdgcn_mfma_f32_32x32x16_bf16((a), (b), (c), 0, 0, 0)

__device__ __forceinline__ void hgrn_unit(int b, int h, int seg, bool do_out, int st_slot, const bf16* __restrict__ QS, const float* __restrict__ EB, const bf16* __restrict__ KK, const bf16* __restrict__ IV, const bf16* __restrict__ SG,
                                          const float* __restrict__ nw, bf16* __restrict__ OA, float* __restrict__ HST, float* __restrict__ HTD, LAS unsigned char* lds, const int wv) {
    int tid_ = wv * 64 + (int)__builtin_amdgcn_mbcnt_hi(~0u, __builtin_amdgcn_mbcnt_lo(~0u, 0u)); asm volatile("" : "+v"(tid_));
    const int tid = tid_, lane = tid & 63, wid = __builtin_amdgcn_readfirstlane(tid >> 6);
    const int r = lane & 31, hh = lane >> 5;
    const size_t colb = (size_t)h * 128;
    const size_t hbase = (size_t)h * NTOK * 128;
    const int ct = tid >> 3, cpart = tid & 7;
    float nwv[16];
#pragma unroll
    for (int i = 0; i < 16; ++i) nwv[i] = nw[16 * cpart + i];
    f32x16 Sacc[2];
#pragma unroll
    for (int i = 0; i < 16; ++i) { Sacc[0][i] = 0.f; Sacc[1][i] = 0.f; }
    const int bh8 = b * 8 + h;
    if (do_out && seg > 0) {
        const size_t so = ((size_t)bh8 * 8 + wid) * 2 * 16 * 64 + lane; const size_t slot = (size_t)64 * 8 * 2 * 16 * 64;
        float d1[16], d2[16];
#pragma unroll
        for (int i = 0; i < 16; ++i) { const int d = 32 * (wid >> 1) + (i & 3) + 8 * (i >> 2) + 4 * hh; d1[i] = seg >= 2 ? __expf(HTD[(size_t)bh8 * 128 + d]) : 1.f; d2[i] = seg >= 3 ? __expf(HTD[(size_t)(64 + bh8) * 128 + d]) : 1.f; }
#pragma unroll
        for (int tl = 0; tl < 2; ++tl)
#pragma unroll
            for (int i = 0; i < 16; ++i) { float v = HST[so + (size_t)(tl * 16 + i) * 64];
                if (seg >= 2) v = v * d1[i] + HST[slot + so + (size_t)(tl * 16 + i) * 64];
                if (seg >= 3) v = v * d2[i] + HST[2 * slot + so + (size_t)(tl * 16 + i) * 64];
                Sacc[tl][i] = v; }
    }
    float td0 = 0.f, td1 = 0.f;
    const int cbeg = 16 * seg, cend = 16 * seg + 16;
    v4u qv[2], kv[2], ivr[2], sgr[2]; f32x2 eb0 = {0.f, 0.f}, eb1 = {0.f, 0.f}, eb2 = {0.f, 0.f};
#define HG_LOAD(c) do { const size_t rb_ = (size_t)b * SEQL + (size_t)(c) * 64; \
        _Pragma("unroll") for (int i = 0; i < 2; ++i) { const int idx_ = tid + 512 * i; const size_t o_ = hbase + rb_ * 128 + 8 * (size_t)idx_; \
            if (do_out) qv[i] = __builtin_nontemporal_load((const GAS v4u*)(QS + o_)); kv[i] = __builtin_nontemporal_load((const GAS v4u*)(KK + o_)); ivr[i] = __builtin_nontemporal_load((const GAS v4u*)(IV + o_)); } \
        if (do_out) { _Pragma("unroll") for (int i = 0; i < 2; ++i) sgr[i] = __builtin_nontemporal_load((const GAS v4u*)(SG + hbase + (rb_ + ct) * 128 + 16 * cpart + 8 * i)); } \
        if (wid == 0) { const size_t eo_ = (rb_ >> 6) * DM + colb + 2 * lane; const size_t es_ = (size_t)(NTOK / 64) * DM; \
            eb0 = *(const GAS f32x2*)(EB + eo_); eb1 = *(const GAS f32x2*)(EB + es_ + eo_); eb2 = *(const GAS f32x2*)(EB + 2 * es_ + eo_); } } while (0)
    HG_LOAD(cbeg);
    for (int c = cbeg; c < cend; ++c) {
#pragma unroll
        for (int i = 0; i < 2; ++i) { const int idx_ = tid + 512 * i, o_ = off_b(idx_ >> 4, idx_ & 15);
            *(LAS v4u*)(lds + L_KP + o_) = kv[i]; *(LAS v4u*)(lds + L_IV + o_) = ivr[i];
            if (do_out) *(LAS v4u*)(lds + L_QP + o_) = qv[i]; }
        if (wid == 0) { *(LAS f32x2*)(lds + L_EBM + 8 * lane) = eb0; *(LAS f32x2*)(lds + L_EBL + 8 * lane) = eb1; td0 += eb2.x; td1 += eb2.y; }
        const v4u sg0 = sgr[0], sg1 = sgr[1];
#ifdef HG_REP_LOAD
        if (c + 1 < cend) { HG_LOAD(c + 1); asm volatile("" ::: "memory"); }
#endif
        if (c + 1 < cend) HG_LOAD(c + 1);
        LDS_BARRIER();
        {
            const int db = wid >> 1, vb0 = 2 * (wid & 1);
            float em[16], el[16];
#pragma unroll
            for (int g = 0; g < 4; ++g) { const f32x4 a = *(const LAS f32x4*)(lds + L_EBM + (32 * db + 8 * g + 4 * hh) * 4), e2 = *(const LAS f32x4*)(lds + L_EBL + (32 * db + 8 * g + 4 * hh) * 4);
                em[4 * g] = a.x; em[4 * g + 1] = a.y; em[4 * g + 2] = a.z; em[4 * g + 3] = a.w; el[4 * g] = e2.x; el[4 * g + 1] = e2.y; el[4 * g + 2] = e2.z; el[4 * g + 3] = e2.w; }
#pragma unroll
            for (int tl = 0; tl < 2; ++tl) { const int vb = vb0 + tl;
#pragma unroll
                for (int i = 0; i < 16; ++i) Sacc[tl][i] *= em[i];
                if (do_out) {
#pragma unroll
                for (int g = 0; g < 4; ++g) { u32x2 w; w.x = pkbf(Sacc[tl][4 * g], Sacc[tl][4 * g + 1]); w.y = pkbf(Sacc[tl][4 * g + 2], Sacc[tl][4 * g + 3]);
                    *(LAS u32x2*)(lds + L_SP + off_b(32 * vb + r, 4 * db + g) + 8 * hh) = w; } } }
            if (do_out && wid < 3) {
                const int tb = wid > 0 ? 1 : 0, sb = wid > 1 ? 1 : 0;
                f32x16 sc;
#pragma unroll
                for (int i = 0; i < 16; ++i) sc[i] = 0.f;
#pragma unroll
                for (int s = 0; s < 8; ++s) { const bf16x8 a = row_frag(lds + L_KP, 32 * sb, s, lane), bq = row_frag(lds + L_QP, 32 * tb, s, lane); sc = HG_MFMA(a, bq, sc); }
                const int t = 32 * tb + r;
#pragma unroll
                for (int g = 0; g < 4; ++g) { float x[4];
#pragma unroll
                    for (int j = 0; j < 4; ++j) { const int s_ = 32 * sb + 8 * g + 4 * hh + j; x[j] = s_ <= t ? sc[4 * g + j] : 0.f; }
                    u32x2 w; w.x = pkbf(x[0], x[1]); w.y = pkbf(x[2], x[3]);
                    *(LAS u32x2*)(lds + L_PM + t * PM_PITCH + (32 * sb + 8 * g + 4 * hh) * 2) = w; }
            }
#pragma unroll
            for (int ks = 0; ks < 4; ++ks) { const bf16x8 a = tr_frag(lds + L_KP, db, ks, lane);
#pragma unroll
                for (int tl = 0; tl < 2; ++tl) { const bf16x8 bi = tr_frag(lds + L_IV, vb0 + tl, ks, lane); Sacc[tl] = HG_MFMA(a, bi, Sacc[tl]); } }
#pragma unroll
            for (int tl = 0; tl < 2; ++tl)
#pragma unroll
                for (int i = 0; i < 16; ++i) Sacc[tl][i] *= el[i];
        }
        if (!do_out) continue;
        LDS_BARRIER();
#ifndef HG_REP_B
#define HG_REP_B 1
#endif
#ifndef HG_REP_C
#define HG_REP_C 1
#endif
        for (int rb_ = 0; rb_ < HG_REP_B; ++rb_) {
            const int tb = wid >> 2, vb = wid & 3;
            f32x16 o;
#pragma unroll
            for (int i = 0; i < 16; ++i) o[i] = 0.f;
#pragma unroll
            for (int ks = 0; ks < 4; ++ks) { if (ks < 2 || tb == 1) {
                const bf16x8 a = *(const LAS bf16x8*)(lds + L_PM + (32 * tb + r) * PM_PITCH + (16 * ks + 8 * hh) * 2); const bf16x8 bi = tr_frag(lds + L_IV, vb, ks, lane); o = HG_MFMA(a, bi, o); } }
#pragma unroll
            for (int s = 0; s < 8; ++s) { const bf16x8 a = row_frag(lds + L_QP, 32 * tb, s, lane), bs = row_frag(lds + L_SP, 32 * vb, s, lane); o = HG_MFMA(a, bs, o); }
#pragma unroll
            for (int i = 0; i < 16; ++i) { const int t = 32 * tb + (i & 3) + 8 * (i >> 2) + 4 * hh; *(LAS float*)(lds + L_O + (t * 128 + 32 * vb + r) * 4) = o[i]; }
        }
        LDS_BARRIER();
        for (int rc_ = 0; rc_ < HG_REP_C; ++rc_) {
            float ov[16];
#pragma unroll
            for (int g = 0; g < 4; ++g) { const f32x4 a = *(const LAS f32x4*)(lds + L_O + (ct * 128 + 16 * cpart + 4 * g) * 4); ov[4 * g] = a.x; ov[4 * g + 1] = a.y; ov[4 * g + 2] = a.z; ov[4 * g + 3] = a.w; }
            float ss = 0.f;
#pragma unroll
            for (int i = 0; i < 16; ++i) ss += ov[i] * ov[i];
            ss += pg8::dpp_row<0xB1>(ss); ss += pg8::dpp_row<0x4E>(ss); ss += pg8::dpp_row<0x141>(ss);
            const float rstd = 1.0f / sqrtf(ss * (1.0f / 128.0f) + 1e-6f);
            const unsigned gs[8] = {sg0.x, sg0.y, sg0.z, sg0.w, sg1.x, sg1.y, sg1.z, sg1.w};
            unsigned ow[8];
#pragma unroll
            for (int i = 0; i < 8; ++i) ow[i] = pkbf(ov[2 * i] * rstd * nwv[2 * i] * pg8::bf_lo(gs[i]), ov[2 * i + 1] * rstd * nwv[2 * i + 1] * pg8::bf_hi(gs[i]));
            bf16* op = OA + ((size_t)b * SEQL + (size_t)c * 64 + ct) * DM + colb + 16 * cpart;
            *(GAS v4u*)(op) = (v4u){ow[0], ow[1], ow[2], ow[3]}; *(GAS v4u*)(op + 8) = (v4u){ow[4], ow[5], ow[6], ow[7]};
        }
    }
#undef HG_LOAD
    if (st_slot >= 0) {
        const size_t so = (size_t)st_slot * ((size_t)64 * 8 * 2 * 16 * 64) + ((size_t)bh8 * 8 + wid) * 2 * 16 * 64 + lane;
#pragma unroll
        for (int tl = 0; tl < 2; ++tl)
#pragma unroll
            for (int i = 0; i < 16; ++i) HST[so + (size_t)(tl * 16 + i) * 64] = Sacc[tl][i];
        if (st_slot >= 1 && wid == 0) *(GAS f32x2*)(HTD + ((size_t)(st_slot - 1) * 64 + bh8) * 128 + 2 * lane) = (f32x2){td0, td1};
    }
    LDS_BARRIER();
}
}

#ifndef PH_SKIP
#define PH_SKIP 0u
#endif
struct Args { Ptrs p; };
typedef __attribute__((address_space(4))) const unsigned long long* KArgWords;
__device__ __forceinline__ Ptrs opq_ptrs(KArgWords p) {
    Ptrs r;
#if defined(__HIP_DEVICE_COMPILE__)
    asm volatile("" : "+s"(p));
    unsigned long long* d = (unsigned long long*)&r;
#pragma unroll
    for (int i = 0; i < (int)(sizeof(Ptrs) / 8); ++i) d[i] = p[i];
#else
    (void)p; r = Ptrs{};
#endif
    return r;
}
__global__ void __launch_bounds__(512, 2) mk_fwd(Args args) {
    extern __shared__ __attribute__((aligned(16))) unsigned char lds_raw[];
    LAS unsigned char* lds = (LAS unsigned char*)lds_raw;
    const KArgWords Pk_ = (KArgWords)__builtin_amdgcn_kernarg_segment_ptr();
    (void)args;
#define P (opq_ptrs(Pk_))
    unsigned char* ws = P.ws;
    const int wv = __builtin_amdgcn_readfirstlane((int)threadIdx.x >> 6), G = gridDim.x;
#define tid (wv * 64 + (int)__builtin_amdgcn_mbcnt_hi(~0u, __builtin_amdgcn_mbcnt_lo(~0u, 0u)))
    volatile LAS unsigned* MISC = (volatile LAS unsigned*)(lds + T_MISC);
    gu32* ctl = (gu32*)(ws + WS_CTL);
    for (int u = tid; u < (LDS_BYTES - TAB_OFF) / 4; u += 512) ((LAS unsigned*)(lds + TAB_OFF))[u] = 0u;
    __syncthreads();
    (void)xcd_barrier_post((unsigned*)(ws + WS_CTL) + CW_BAR, MISC + 8);
#define GRID_BAR() do { XcdBarrier bar_; bar_.bar = (unsigned*)(ws + WS_CTL) + CW_BAR; bar_.x = xb_xcc_id(); bar_.st = (volatile LAS unsigned*)(lds + T_MISC) + 8; for (int rb_ = 0; rb_ < NREP(11); ++rb_) xcd_barrier(bar_); } while (0)
#define RUN(k) (((PH_SKIP >> (k)) & 1u) == 0u)
#ifndef PH_REP
#define PH_REP 0u
#endif
#define NREP(k) (1 + (int)((PH_REP >> (k)) & 1u))

    if (RUN(0)) for (int rp = 0; rp < NREP(0); ++rp) p0_prologue(P, lds, G, wv);
    GRID_BAR();
    if (RUN(1)) for (int rp = 0; rp < NREP(1); ++rp) phase_a0(P, lds, G, wv);
    GRID_BAR();

    for (int l = 0; l < NLAYER; ++l) {
        bf16* PROJ = (bf16*)(ws + WS_PROJ);
        if (RUN(2)) for (int rp = 0; rp < NREP(2); ++rp) {
            if (G == 256) fscan(P, lds, wv);
            pg8::Gemm g{(const pg8::bf16_t*)(ws + WS_HB), (const pg8::bf16_t*)(ws + WS_WIN) + (size_t)l * NPROJ * DM, NTOK, NPROJ, DM};
            pg8::StaticOrder S; S.init(NTOK, NPROJ, G, (int)blockIdx.x);
            pg8::EpiInProj E{(pg8::bf16_t*)PROJ, (float*)(ws + WS_EB), (const float*)(ws + WS_LB) + (size_t)l * DM, 0.125f * LOG2E, (unsigned*)(ws + WS_CTL) + CW_NRM + l * 2 * 128 * 128};
            pg8::gemm_phase<pg8::EpiInProj, pg8::StaticOrder, true, true, false>(lds + RING_OFF, g, S, E, wv);
        }
        GRID_BAR();
        if (RUN(3)) for (int rp = 0; rp < NREP(3); ++rp) {
            constexpr int ATT_Q1 = 1152;
            const bf16* aQ = PROJ + 4 * (size_t)NTOK * DM; const bf16* aK = PROJ + 5 * (size_t)NTOK * DM; const bf16* aV = PROJ + 6 * (size_t)NTOK * DM;
#define HG_CALL(bh_, seg_, out_, slot_) hg::hgrn_unit((bh_) >> 3, (bh_) & 7, (seg_), (out_), (slot_), PROJ + 0 * (size_t)NTOK * DM, (const float*)(ws + WS_EB), PROJ + 1 * (size_t)NTOK * DM, PROJ + 2 * (size_t)NTOK * DM, \
                PROJ + 3 * (size_t)NTOK * DM, P.hg_norm_w + (size_t)l * 128, (bf16*)(ws + WS_OAB), (float*)(ws + WS_HST), (float*)(ws + WS_HTD), lds + RING_OFF, wv)
#define AT_CALL(j_) do { const int qb_ = 15 - ((j_) & 15), bh_ = (j_) >> 4;     \
                attn_body::attn_unit<8>(bh_ >> 4, bh_ & 15, qb_, (const attn_body::bf16*)aQ, (const attn_body::bf16*)aK, (const attn_body::bf16*)aV, (attn_body::bf16*)(ws + WS_OAB + SZB), (const float*)(ws + WS_FP), \
                    (const unsigned*)(ws + WS_CTL) + CW_NRM + ((l * 2 + 0) * 128 + bh_) * 128, (const unsigned*)(ws + WS_CTL) + CW_NRM + ((l * 2 + 1) * 128 + bh_) * 128, (unsigned*)wqp_, MISC + 1 + (par_ ^= 1), (char*)lds_raw + RING_OFF, wv); } while (0)
#define WQ_WORD(word_) (ctl + CW_WQ + 64 * ((word_) * 4 + l) + 1024 * rp + 2048 * rx)
#define WQ_NEXT(word_) do { __syncthreads(); if (tid == 0) MISC[0] = __hip_atomic_fetch_add(WQ_WORD(word_), 1u, RLX_AGENT); __syncthreads(); } while (0)
            for (int rx = 0; rx < NREP(10); ++rx) for (;;) { WQ_NEXT(0); const int it = __builtin_amdgcn_readfirstlane((int)MISC[0]); if (it >= 192) break;
                if (it < 64) HG_CALL(it, 0, true, 0); else HG_CALL((it - 64) >> 1, 1 + ((it - 64) & 1), false, 1 + ((it - 64) & 1)); }
            for (int rx = 0; rx < NREP(12); ++rx) { int par_ = 0; gu32* wqp_ = WQ_WORD(1); WQ_NEXT(1); int j = __builtin_amdgcn_readfirstlane((int)MISC[0]);
              while (j < ATT_Q1) { AT_CALL(j); j = __builtin_amdgcn_readfirstlane((int)MISC[1 + par_]); } }
            GRID_BAR();
            for (int rx = 0; rx < NREP(10); ++rx) for (;;) { WQ_NEXT(2); const int it = __builtin_amdgcn_readfirstlane((int)MISC[0]); if (it >= 192) break; HG_CALL(it & 63, 1 + (it >> 6), true, -1); }
            for (int rx = 0; rx < NREP(12); ++rx) { int par_ = 0; gu32* wqp_ = WQ_WORD(3); WQ_NEXT(3); int j = __builtin_amdgcn_readfirstlane((int)MISC[0]) + ATT_Q1;
              while (j < 2048) { AT_CALL(j); j = __builtin_amdgcn_readfirstlane((int)MISC[1 + par_]) + ATT_Q1; } }
#undef HG_CALL
#undef AT_CALL
#undef WQ_NEXT
#undef WQ_WORD
        }
        GRID_BAR();
        if (RUN(4)) for (int rp = 0; rp < NREP(4); ++rp) {
            pg8::Gemm g{(const pg8::bf16_t*)(ws + WS_OAB), (const pg8::bf16_t*)(ws + WS_WBR) + (size_t)l * 2 * DM * DM, 2 * NTOK, 2 * DM, DM};
            pg8::PairOrder S; S.init(G, (int)blockIdx.x);
            pg8::EpiBranch E{(const pg8::bf16_t*)(PROJ + 7 * (size_t)NTOK * DM), (const pg8::bf16_t*)(PROJ + 8 * (size_t)NTOK * DM), (pg8::bf16_t*)(ws + WS_MG)};
            pg8::gemm_phase<pg8::EpiBranch, pg8::PairOrder, true, true, false>(lds + RING_OFF, g, S, E, wv);
        }
        GRID_BAR();
        if (RUN(5)) for (int rp = 0; rp < NREP(5); ++rp) {
            pg8::Gemm g{(const pg8::bf16_t*)(ws + WS_MG), (const pg8::bf16_t*)(ws + WS_WOUT) + (size_t)l * DM * DM, NTOK, DM, DM};
            pg8::StaticOrder S; S.init(NTOK, DM, G, (int)blockIdx.x);
            pg8::EpiBf16Plain E{(pg8::bf16_t*)(ws + WS_Y), DM};
            pg8::gemm_phase<pg8::EpiBf16Plain, pg8::StaticOrder, true, true, false>(lds + RING_OFF, g, S, E, wv);
        }
        GRID_BAR();
        if (RUN(6)) for (int rp = 0; rp < NREP(6); ++rp) phase_f(P, lds, l, l == 0 ? P.x : P.out, G, wv, rp == 0);
        GRID_BAR();
        if (RUN(7)) for (int rp = 0; rp < NREP(7); ++rp) {
            const int ntile = moe_tables(P, lds, l, wv);
            pg8::Gemm g{(const pg8::bf16_t*)(ws + WS_HB), (const pg8::bf16_t*)(ws + WS_WGU) + (size_t)l * NEXP * 2048 * DM, 0, 0, DM};
            pg8::MoeOrder S{G, (int)blockIdx.x, ntile, 8, (const LAS unsigned char*)(lds + T_RT2E), (const LAS int*)(lds + T_TBASE), (const LAS int*)(lds + T_CNT), (const int*)(ws + WS_LIST)};
            pg8::EpiMoe1 E{(pg8::bf16_t*)(ws + WS_ACT), P.b_gate + (size_t)l * NEXP * DM, P.b_up + (size_t)l * NEXP * DM};
            pg8::gemm_phase<pg8::EpiMoe1, pg8::MoeOrder, true, true, true>(lds + RING_OFF, g, S, E, wv);
        }
        GRID_BAR();
        if (RUN(8)) for (int rp = 0; rp < NREP(8); ++rp) {
            const int ntile = moe_tables(P, lds, l, wv);
            pg8::Gemm g{(const pg8::bf16_t*)(ws + WS_ACT), (const pg8::bf16_t*)(ws + WS_WD) + (size_t)l * NEXP * DM * DM, 0, 0, DM};
            pg8::MoeOrder S{G, (int)blockIdx.x, ntile, 4, (const LAS unsigned char*)(lds + T_RT2E), (const LAS int*)(lds + T_TBASE), (const LAS int*)(lds + T_CNT), (const int*)(ws + WS_LIST)};
            pg8::EpiMoe2 E{(pg8::bf16_t*)(ws + WS_YR), P.b_down + (size_t)l * NEXP * DM};
            pg8::gemm_phase<pg8::EpiMoe2, pg8::MoeOrder, true, true, false>(lds + RING_OFF, g, S, E, wv);
        }
        GRID_BAR();
        if (RUN(9)) for (int rp = 0; rp < NREP(9); ++rp) { (void)moe_tables(P, lds, l, wv); phase_j(P, lds, l, G, wv); }
        if (l + 1 < NLAYER) GRID_BAR();
    }
#undef GRID_BAR
#undef RUN
#undef tid
#undef P
#undef NREP
}

extern "C" void kernel_launch(void* const* d_in, const int* in_sizes, int n_in, void* d_out, int out_size, void* d_ws, size_t ws_size, hipStream_t stream) {
    static int grid = 0;
    if (grid == 0) {
        if (n_in != 22 || in_sizes[0] != NTOK * DM || out_size != NTOK * DM || ws_size < WS_END) {
            fprintf(stderr, "kernel_launch: built for 22 inputs, x/out of %d floats, >= %zu bytes of workspace; got n_in %d, in0 %d, out %d, ws %zu; nothing launched\n", NTOK * DM, (size_t)WS_END, n_in, n_in > 0 ? in_sizes[0] : -1, out_size, ws_size);
            grid = -1; return; }
        int dev = 0, cus = 0, per_cu = 0;
        if (hipGetDevice(&dev) != hipSuccess || hipDeviceGetAttribute(&cus, hipDeviceAttributeMultiprocessorCount, dev) != hipSuccess) { fprintf(stderr, "kernel_launch: device query failed\n"); grid = -1; return; }
        if (hipFuncSetAttribute((const void*)mk_fwd, hipFuncAttributeMaxDynamicSharedMemorySize, LDS_BYTES) != hipSuccess) { fprintf(stderr, "kernel_launch: hipFuncSetAttribute failed\n"); grid = -1; return; }
        if (hipOccupancyMaxActiveBlocksPerMultiprocessor(&per_cu, (const void*)mk_fwd, 512, LDS_BYTES) != hipSuccess || per_cu < 1) fprintf(stderr, "kernel_launch: note: occupancy query reports %d workgroups per CU\n", per_cu);
        (void)hipGetLastError();
        grid = cus;
        if (NTOK / (grid * 8) != 16 || NTOK % (grid * 8) != 0) { fprintf(stderr, "kernel_launch: %d CUs: the row-wise phases need NTOK %% (32 * CUs) == 0\n", grid); grid = -1; return; }
    }
    if (grid < 0) return;
    if (hipMemsetAsync((char*)d_ws + WS_CTL, 0, CTL_ZERO_BYTES, stream) != hipSuccess) { fprintf(stderr, "kernel_launch: hipMemsetAsync failed\n"); return; }
    Args a{};
    const float** pp = (const float**)&a.p;
    for (int i = 0; i < 22; ++i) pp[i] = (const float*)d_in[i];
    a.p.out = (float*)d_out; a.p.ws = (unsigned char*)d_ws;
    hipLaunchKernelGGL(mk_fwd, dim3(grid), dim3(512), LDS_BYTES, stream, a);
    const hipError_t le = hipPeekAtLastError();
    if (le != hipSuccess) fprintf(stderr, "kernel_launch: launch failed: %s (grid %d)\n", hipGetErrorName(le), grid);
}
```
